# Optimizing an MI355X kernel written in HIP

```python
import math
import jax, jax.numpy as jnp
from jax import lax
import numpy as np

D_MODEL = 2048
BATCH = 4
SEQ = 2048
DEPTH = 2

HEAD_DIM = 128
ATTN_Q_HEADS = 16
ATTN_KV_HEADS = 4
ATTN_GROUP = ATTN_Q_HEADS // ATTN_KV_HEADS
IDX_HEADS = 16
IDX_DIM = 64
TOPK_MAX = 256
Q_BLOCK = 128
RET_HEADS = 8
RET_QK_DIM = 128
RET_V_DIM = 256
RET_CHUNK = 128
ROPE_BASE = 10000.0
D_FF = 4 * D_MODEL
EPS = 1e-6

ATTN_W = ATTN_Q_HEADS * HEAD_DIM
KV_W = ATTN_KV_HEADS * HEAD_DIM
IDX_Q_W = IDX_HEADS * IDX_DIM
RET_QK_W = RET_HEADS * RET_QK_DIM
RET_V_W = RET_HEADS * RET_V_DIM
IN_SPLITS = (ATTN_W, KV_W, KV_W, IDX_Q_W, IDX_DIM, IDX_HEADS,
             RET_QK_W, RET_QK_W, RET_V_W, RET_V_W, D_MODEL, D_MODEL)
D_IN = ATTN_W + 2 * KV_W + IDX_Q_W + IDX_DIM + IDX_HEADS + 2 * RET_QK_W + 2 * RET_V_W + 2 * D_MODEL

kernel_name = "hybrid_dsa_retention_gated_block"


def split_offsets():
    return np.cumsum(np.array(IN_SPLITS))[:-1].tolist()


def rms_norm(x, g):
    xf = x.astype(jnp.float32)
    r = lax.rsqrt(jnp.mean(xf * xf, axis=-1, keepdims=True) + EPS)
    return (xf * r).astype(x.dtype) * g


def rotary_tables(S, dtype):
    pos = jnp.arange(S, dtype=jnp.float32)
    inv_freq = ROPE_BASE ** (-jnp.arange(0, RET_QK_DIM, 2, dtype=jnp.float32) / RET_QK_DIM)
    ang = pos[:, None] * inv_freq[None, :]
    return jnp.cos(ang)[:, None, :].astype(dtype), jnp.sin(ang)[:, None, :].astype(dtype)


def rotate(x, cos, sin):
    x1, x2 = jnp.split(x, 2, axis=-1)
    return jnp.concatenate([x1 * cos - x2 * sin, x2 * cos + x1 * sin], axis=-1)


def dsa_attention(q, k, v, iq, ik, iw, topk):
    B, S = q.shape[0], q.shape[1]
    n_blocks = S // Q_BLOCK
    scale = HEAD_DIM ** -0.5
    kpos = jnp.arange(S)
    gather = jax.vmap(lambda t, i: t[i])

    def block(i):
        start = i * Q_BLOCK
        qb = lax.dynamic_slice_in_dim(q, start, Q_BLOCK, axis=1)
        iqb = lax.dynamic_slice_in_dim(iq, start, Q_BLOCK, axis=1)
        iwb = lax.dynamic_slice_in_dim(iw, start, Q_BLOCK, axis=1)
        qpos = start + jnp.arange(Q_BLOCK)
        logits = jnp.einsum('bqhd,bsd->bqhs', iqb, ik)
        score = jnp.einsum('bqh,bqhs->bqs', iwb, jax.nn.relu(logits)).astype(jnp.float32)
        causal = kpos[None, :] <= qpos[:, None]
        score = jnp.where(causal[None], score, -jnp.inf)
        _, idx = lax.top_k(score, topk)
        valid = idx <= qpos[None, :, None]
        kg = gather(k, idx)
        vg = gather(v, idx)
        qg = qb.reshape(B, Q_BLOCK, ATTN_KV_HEADS, ATTN_GROUP, HEAD_DIM)
        s = jnp.einsum('bqgrd,bqkgd->bqgrk', qg, kg).astype(jnp.float32) * scale
        s = jnp.where(valid[:, :, None, None, :], s, -jnp.inf)
        p = jax.nn.softmax(s, axis=-1).astype(v.dtype)
        o = jnp.einsum('bqgrk,bqkgd->bqgrd', p, vg)
        return o.reshape(B, Q_BLOCK, ATTN_W)

    out = lax.map(block, jnp.arange(n_blocks))
    return jnp.moveaxis(out, 0, 1).reshape(B, S, ATTN_W)


def retention_chunkwise(q, k, v, log_gamma):
    B, S, H, Dk = q.shape
    Dv = v.shape[-1]
    C = RET_CHUNK
    n = S // C
    dt = v.dtype

    def chunks(t):
        return t.reshape(B, n, C, H, t.shape[-1]).transpose(0, 1, 3, 2, 4)

    qc, kc, vc = chunks(q), chunks(k), chunks(v)
    pos = jnp.arange(C, dtype=jnp.float32)
    lg = log_gamma.astype(jnp.float32)
    diff = pos[:, None] - pos[None, :]
    decay = jnp.where(diff[None] >= 0, jnp.exp(lg[:, None, None] * jnp.maximum(diff, 0.0)[None]), 0.0)
    xi = jnp.exp(lg[:, None] * (pos[None, :] + 1.0))
    zeta = jnp.exp(lg[:, None] * (C - 1.0 - pos[None, :]))
    chunk_decay = jnp.exp(lg * C).astype(dt)

    inner = jnp.einsum('bnhid,bnhjd->bnhij', qc, kc) * decay.astype(dt)
    inner = jnp.einsum('bnhij,bnhje->bnhie', inner, vc)
    upd = jnp.einsum('bnhjd,bnhje->bnhde', kc * zeta[..., None].astype(dt), vc)

    def step(R, u):
        return u + chunk_decay[:, None, None] * R, R

    R0 = jnp.zeros((B, H, Dk, Dv), dt)
    _, R_prev = lax.scan(step, R0, jnp.moveaxis(upd, 1, 0))
    R_prev = jnp.moveaxis(R_prev, 0, 1)
    cross = jnp.einsum('bnhid,bnhde->bnhie', qc, R_prev) * xi[..., None].astype(dt)
    out = inner + cross
    return out.transpose(0, 1, 3, 2, 4).reshape(B, S, H, Dv)


def group_norm_heads(y, g, b):
    B, S = y.shape[0], y.shape[1]
    yf = y.astype(jnp.float32)
    mu = jnp.mean(yf, axis=-1, keepdims=True)
    var = jnp.mean(jnp.square(yf - mu), axis=-1, keepdims=True)
    yn = ((yf - mu) * lax.rsqrt(var + EPS)).astype(y.dtype)
    return yn.reshape(B, S, -1) * g + b


def setup_inputs(seed: int = 0) -> dict:
    key = jax.random.key(seed)
    ks = jax.random.split(key, 14)

    def w(k, shape, fan_in):
        return jax.random.normal(k, shape, jnp.float32) * fan_in ** -0.5

    def gain(k, shape):
        return 1.0 + 0.02 * jax.random.normal(k, shape, jnp.float32)

    return {
        "x": jax.random.normal(ks[0], (BATCH, SEQ, D_MODEL), jnp.float32),
        "ln1_g": gain(ks[1], (DEPTH, D_MODEL)),
        "w_in": w(ks[2], (DEPTH, D_MODEL, D_IN), D_MODEL),
        "q_norm_g": gain(ks[3], (DEPTH, HEAD_DIM)),
        "k_norm_g": gain(ks[4], (DEPTH, HEAD_DIM)),
        "ret_gn_g": gain(ks[5], (DEPTH, RET_V_W)),
        "ret_gn_b": 0.02 * jax.random.normal(ks[6], (DEPTH, RET_V_W), jnp.float32),
        "w_up_attn": w(ks[7], (DEPTH, ATTN_W, D_MODEL), ATTN_W),
        "w_up_ret": w(ks[8], (DEPTH, RET_V_W, D_MODEL), RET_V_W),
        "w_out": w(ks[9], (DEPTH, D_MODEL, D_MODEL), D_MODEL),
        "ln2_g": gain(ks[10], (DEPTH, D_MODEL)),
        "w_ff1": w(ks[11], (DEPTH, D_MODEL, D_FF), D_MODEL),
        "w_ff2": w(ks[12], (DEPTH, D_FF, D_MODEL), D_FF),
    }


def reference(x, ln1_g, w_in, q_norm_g, k_norm_g, ret_gn_g, ret_gn_b,
              w_up_attn, w_up_ret, w_out, ln2_g, w_ff1, w_ff2):
    B, S, _ = x.shape
    topk = min(TOPK_MAX, S // 4)
    cos, sin = rotary_tables(S, x.dtype)
    log_gamma = jnp.log(1.0 - jnp.exp2(-5.0 - jnp.arange(RET_HEADS, dtype=jnp.float32)))
    offsets = split_offsets()

    for l in range(DEPTH):
        h = rms_norm(x, ln1_g[l])
        proj = h @ w_in[l]
        aq, ak, av, iq, ik, iw, rq, rk, rv, rg, ga, gb = jnp.split(proj, offsets, axis=-1)

        aq = rms_norm(aq.reshape(B, S, ATTN_Q_HEADS, HEAD_DIM), q_norm_g[l])
        ak = rms_norm(ak.reshape(B, S, ATTN_KV_HEADS, HEAD_DIM), k_norm_g[l])
        av = av.reshape(B, S, ATTN_KV_HEADS, HEAD_DIM)
        iq = iq.reshape(B, S, IDX_HEADS, IDX_DIM)
        iw = iw * IDX_HEADS ** -0.5
        o_attn = dsa_attention(aq, ak, av, iq, ik, iw, topk)

        rq = rotate(rq.reshape(B, S, RET_HEADS, RET_QK_DIM), cos, sin)
        rk = rotate(rk.reshape(B, S, RET_HEADS, RET_QK_DIM), cos, sin) * RET_QK_DIM ** -0.5
        rv = rv.reshape(B, S, RET_HEADS, RET_V_DIM)
        y_ret = retention_chunkwise(rq, rk, rv, log_gamma)
        o_ret = jax.nn.silu(rg) * group_norm_heads(y_ret, ret_gn_g[l], ret_gn_b[l])

        merged = jax.nn.sigmoid(ga) * (o_attn @ w_up_attn[l]) + jax.nn.sigmoid(gb) * (o_ret @ w_up_ret[l])
        x = x + merged @ w_out[l]

        h2 = rms_norm(x, ln2_g[l])
        x = x + jnp.square(jax.nn.relu(h2 @ w_ff1[l])) @ w_ff2[l]
    return x
```

```cpp
#include <hip/hip_runtime.h>
#include <hip/hip_cooperative_groups.h>
#include <cstdio>
#include <cstdint>
#ifndef REP_PRO
#define REP_PRO 1
#endif
#ifndef REP_P2
#define REP_P2 1
#endif
#ifndef REP_P3
#define REP_P3 1
#endif
#ifndef REP_P4
#define REP_P4 1
#endif
#ifndef GA_
#define GA_ true
#define GS_ true
#endif
namespace cg = cooperative_groups;
namespace pg8 {
#define PG8_LAS __attribute__((address_space(3)))
typedef unsigned short bf16_t;
typedef short bf16x8 __attribute__((ext_vector_type(8)));
typedef float f32x4 __attribute__((ext_vector_type(4)));
typedef unsigned u32x4 __attribute__((ext_vector_type(4)));
constexpr int BM = 256, BK = 64, HALF = 128, HTB = HALF * BK * 2  , STAGE_BYTES = 8 * HTB, NXCD = 8, WGM = 8;

__host__ __device__ __forceinline__ int lds_byte(int r, int c) { const int st = (r >> 4) * 2 + (c >> 5), rr = r & 15, cc = c & 31, ob = rr * 64 + cc * 2; return st * 1024 + (ob ^ (((ob >> 9) & 1) << 5)); }
__host__ __device__ __forceinline__ void stage_rc(int b, int& R, int& C) { const int st = b / 1024, sb = b % 1024, swz = sb ^ (((sb >> 9) & 1) << 5); R = (st >> 1) * 16 + swz / 64; C = (st & 1) * 32 + (swz % 64) / 2; }
__host__ __device__ __forceinline__ int perm32(int rho) { const int n = rho >> 4, i = rho & 15; return 8 * (i >> 2) + 4 * n + (i & 3); }

struct Unit { int pm, pn; };
struct Gemm { const bf16_t* A; const bf16_t* Bt; int M, N, K; };

struct StaticOrder {
    int nM, nN, nwg, G, c;
    __host__ __device__ void init(int M, int N, int G_, int c_) { nM = M / BM; nN = N / BM; nwg = nM * nN; G = G_; c = c_; }
    __host__ __device__ bool next(int i, Unit& u) const {
        const long L = (long)i * G + c; if (L >= nwg) return false;
        int wgid = (int)L; { const int q = nwg / NXCD, r = nwg % NXCD, xcd = wgid % NXCD, off = wgid / NXCD; wgid = (xcd < r ? xcd * (q + 1) : r * (q + 1) + (xcd - r) * q) + off; }
        const int nig = WGM * nN, gid = wgid / nig, fm = gid * WGM, gsz = (nM - fm) < WGM ? (nM - fm) : WGM;
        u.pm = fm + ((wgid % nig) % gsz); u.pn = (wgid % nig) / gsz; return true;
    }
    __device__ __forceinline__ void a_ready(const Unit&) const {}
    __device__ __forceinline__ void done(const Unit&) const {}
};

__device__ __forceinline__ unsigned cvt_pk_bf16(float lo, float hi) { unsigned r; asm volatile("v_cvt_pk_bf16_f32 %0, %1, %2" : "=v"(r) : "v"(lo), "v"(hi)); return r; }
template <class Epi, class Sched, bool ALIGN_EPI = false, bool SP2 = false>
__device__ __forceinline__ void gemm_phase(PG8_LAS unsigned char* lds, const Gemm g, const Sched& S, const Epi& E) {
    int tid_ = threadIdx.x; asm volatile("" : "+v"(tid_)); const int tid = tid_, wid = __builtin_amdgcn_readfirstlane(tid >> 6), lane = tid & 63, wr = wid >> 2, wc = wid & 3, fr = lane & 15, fq = lane >> 4;
    const int K = g.K, nt = K / BK;
    unsigned voffA[2], voffB[2];
#pragma unroll
    for (int i = 0; i < 2; ++i) { int R, C; stage_rc(tid * 16 + i * 8192, R, C); const int Rb = Epi::PERM ? ((R & ~31) + perm32(R & 31)) : R;
        voffA[i] = (unsigned)(R * K + C) * 2u; voffB[i] = (unsigned)(Rb * K + C) * 2u; }
    const size_t kstep = (size_t)(BK * 2);
    const size_t hstep = (size_t)HALF * K * 2;
    const size_t tstep = 2 * hstep;
    const unsigned ldsw = (unsigned)wid * 1024u;
    const int aoff = lds_byte(wr * 64 + fr, fq * 8), boff = lds_byte(wc * 32 + fr, fq * 8);
#define PG8_SA(b, h) (((b) * 2 + (h)) * HTB)
#define PG8_SB(b, h) ((4 + (b) * 2 + (h)) * HTB)
#define PG8_STAGE(bufoff, gbase, voff) do { _Pragma("unroll") for (int _i = 0; _i < 2; ++_i) \
        __builtin_amdgcn_global_load_lds((const unsigned*)((const char*)(gbase) + (voff)[_i]), (PG8_LAS unsigned*)(lds + (bufoff) + ldsw + _i * 8192), 16, 0, 0); } while (0)
#define PG8_LDA(dst, b, h) do { _Pragma("unroll") for (int m = 0; m < 4; ++m) _Pragma("unroll") for (int k = 0; k < 2; ++k) dst[m][k] = *(const PG8_LAS bf16x8*)(lds + PG8_SA(b, h) + aoff + m * 2048 + k * 1024); } while (0)
#define PG8_LDB(dst, b, h) do { _Pragma("unroll") for (int n = 0; n < 2; ++n) _Pragma("unroll") for (int k = 0; k < 2; ++k) dst[n][k] = *(const PG8_LAS bf16x8*)(lds + PG8_SB(b, h) + boff + n * 2048 + k * 1024); } while (0)
#define PG8_MMA(ai, bj, At, Bt) do { __builtin_amdgcn_s_setprio(1); _Pragma("unroll") for (int m = 0; m < 4; ++m) _Pragma("unroll") for (int n = 0; n < 2; ++n) _Pragma("unroll") for (int k = 0; k < 2; ++k) \
        acc[ai][bj][m][n] = __builtin_amdgcn_mfma_f32_16x16x32_bf16(Bt[n][k], At[m][k], acc[ai][bj][m][n], 0, 0, 0); __builtin_amdgcn_s_setprio(0); } while (0)
#define PG8_WAIT_V(n) asm volatile("s_waitcnt vmcnt(" #n ")" ::: "memory")
#define PG8_WAIT_L(n) asm volatile("s_waitcnt lgkmcnt(" #n ")" ::: "memory")
#define PG8_BAR __builtin_amdgcn_s_barrier()
#define PG8_SCHED __builtin_amdgcn_sched_barrier(0)
    Unit cur, nxt; int ui = 0;
    if (!S.next(0, cur)) return;
    f32x4 acc[2][2][4][2];
#pragma unroll
    for (int a = 0; a < 2; ++a)
#pragma unroll
        for (int b = 0; b < 2; ++b)
#pragma unroll
            for (int m = 0; m < 4; ++m)
#pragma unroll
                for (int n = 0; n < 2; ++n) acc[a][b][m][n] = (f32x4){0.f, 0.f, 0.f, 0.f};
    bf16x8 At[4][2], B0[2][2], B1[2][2];
    const char* cA = (const char*)g.A + (size_t)cur.pm * tstep; const char* cB = (const char*)g.Bt + (size_t)cur.pn * tstep;
    S.a_ready(cur);
    if constexpr (SP2) {
        PG8_STAGE(PG8_SB(0, 0), cB, voffB); PG8_STAGE(PG8_SB(0, 1), cB + hstep, voffB); PG8_STAGE(PG8_SA(0, 0), cA, voffA); PG8_STAGE(PG8_SA(0, 1), cA + hstep, voffA);
        if (wr == 1) PG8_BAR;
        PG8_WAIT_V(2); PG8_BAR;
        PG8_STAGE(PG8_SB(1, 0), cB + kstep, voffB); PG8_STAGE(PG8_SA(1, 0), cA + kstep, voffA); PG8_STAGE(PG8_SB(1, 1), cB + hstep + kstep, voffB);
        PG8_WAIT_V(6); PG8_BAR;
    } else {
        PG8_STAGE(PG8_SB(0, 0), cB, voffB); PG8_STAGE(PG8_SA(0, 0), cA, voffA); PG8_STAGE(PG8_SB(0, 1), cB + hstep, voffB); PG8_STAGE(PG8_SA(0, 1), cA + hstep, voffA);
        if (wr == 1) PG8_BAR;
        PG8_WAIT_V(4); PG8_BAR;
        PG8_STAGE(PG8_SB(1, 0), cB + kstep, voffB); PG8_STAGE(PG8_SA(1, 0), cA + kstep, voffA); PG8_STAGE(PG8_SB(1, 1), cB + hstep + kstep, voffB);
        PG8_WAIT_V(6); PG8_BAR;
    }
    for (;;) {
        const bool has_next = S.next(ui + 1, nxt);
        const char* nA = has_next ? (const char*)g.A + (size_t)nxt.pm * tstep : cA; const char* nB = has_next ? (const char*)g.Bt + (size_t)nxt.pn * tstep : cB;
        for (int t = 0; t < nt; t += 2) {
            if constexpr (Epi::MID_HOOK) { if (t == (nt >> 1)) E.mid(acc, cur, wr, wc, fr, fq); }
            const bool last = (t == nt - 2);
            const char* a1 = cA + (size_t)(t + 1) * kstep;
            const char* a2 = last ? nA : cA + (size_t)(t + 2) * kstep; const char* b2 = last ? nB : cB + (size_t)(t + 2) * kstep;
            const char* a3 = a2 + kstep; const char* b3 = b2 + kstep;
            if (last && has_next) S.a_ready(nxt);
            if constexpr (SP2) {
            PG8_LDB(B0, 0, 0); PG8_LDB(B1, 0, 1); PG8_SCHED; PG8_LDA(At, 0, 0); PG8_STAGE(PG8_SA(1, 1), a1 + hstep, voffA);
            PG8_WAIT_V(8); PG8_WAIT_L(0); PG8_BAR; PG8_MMA(0, 0, At, B0); PG8_MMA(0, 1, At, B1); PG8_BAR; PG8_SCHED;
            PG8_LDA(At, 0, 1); PG8_STAGE(PG8_SB(0, 0), b2, voffB); PG8_STAGE(PG8_SB(0, 1), b2 + hstep, voffB); PG8_STAGE(PG8_SA(0, 0), a2, voffA);
            PG8_WAIT_V(8); PG8_WAIT_L(0); PG8_BAR; PG8_MMA(1, 0, At, B0); PG8_MMA(1, 1, At, B1); PG8_BAR; PG8_SCHED;
            PG8_LDB(B0, 1, 0); PG8_LDB(B1, 1, 1); PG8_SCHED; PG8_LDA(At, 1, 0); PG8_STAGE(PG8_SA(0, 1), a2 + hstep, voffA);
            PG8_WAIT_V(8); PG8_WAIT_L(0); PG8_BAR; PG8_MMA(0, 0, At, B0); PG8_MMA(0, 1, At, B1); PG8_BAR; PG8_SCHED;
            PG8_LDA(At, 1, 1); PG8_STAGE(PG8_SB(1, 0), b3, voffB); PG8_STAGE(PG8_SB(1, 1), b3 + hstep, voffB); PG8_STAGE(PG8_SA(1, 0), a3, voffA);
            PG8_WAIT_V(8); PG8_WAIT_L(0); PG8_BAR; PG8_MMA(1, 0, At, B0); PG8_MMA(1, 1, At, B1); PG8_BAR; PG8_SCHED;
            } else {
            PG8_LDB(B0, 0, 0); PG8_SCHED; PG8_LDA(At, 0, 0); PG8_STAGE(PG8_SA(1, 1), a1 + hstep, voffA);
            PG8_WAIT_L(8); PG8_BAR; PG8_WAIT_L(0); PG8_MMA(0, 0, At, B0); PG8_BAR; PG8_SCHED;
            PG8_LDB(B1, 0, 1); PG8_STAGE(PG8_SB(0, 0), b2, voffB);
            PG8_BAR; PG8_WAIT_L(0); PG8_MMA(0, 1, At, B1); PG8_BAR;
            PG8_LDA(At, 0, 1); PG8_STAGE(PG8_SA(0, 0), a2, voffA);
            PG8_BAR; PG8_WAIT_L(0); PG8_MMA(1, 0, At, B0); PG8_BAR; PG8_SCHED;
            PG8_STAGE(PG8_SB(0, 1), b2 + hstep, voffB);
            PG8_WAIT_V(6); PG8_BAR; PG8_MMA(1, 1, At, B1); PG8_BAR;
            PG8_LDB(B0, 1, 0); PG8_SCHED; PG8_LDA(At, 1, 0); PG8_STAGE(PG8_SA(0, 1), a2 + hstep, voffA);
            PG8_WAIT_L(8); PG8_BAR; PG8_WAIT_L(0); PG8_MMA(0, 0, At, B0); PG8_BAR; PG8_SCHED;
            PG8_LDB(B1, 1, 1); PG8_STAGE(PG8_SB(1, 0), b3, voffB);
            PG8_BAR; PG8_WAIT_L(0); PG8_MMA(0, 1, At, B1); PG8_BAR;
            PG8_LDA(At, 1, 1); PG8_STAGE(PG8_SA(1, 0), a3, voffA);
            PG8_BAR; PG8_WAIT_L(0); PG8_MMA(1, 0, At, B0); PG8_BAR; PG8_SCHED;
            PG8_STAGE(PG8_SB(1, 1), b3 + hstep, voffB);
            PG8_WAIT_V(6); PG8_BAR; PG8_MMA(1, 1, At, B1); PG8_BAR;
            }
        }
        if constexpr (ALIGN_EPI) { if (wr == 0) PG8_BAR; }
        if constexpr (!Epi::AFTER_DRAIN) { E(acc, cur, wr, wc, fr, fq); S.done(cur); }
        if (!has_next) break;
#pragma unroll
        for (int a = 0; a < 2; ++a)
#pragma unroll
            for (int b = 0; b < 2; ++b)
#pragma unroll
                for (int m = 0; m < 4; ++m)
#pragma unroll
                    for (int n = 0; n < 2; ++n) acc[a][b][m][n] = (f32x4){0.f, 0.f, 0.f, 0.f};
        cur = nxt; cA = nA; cB = nB; ++ui;
        if constexpr (ALIGN_EPI) { if (wr == 1) PG8_BAR; }
    }
    PG8_WAIT_V(0);
    if constexpr (!ALIGN_EPI) { if (wr == 0) PG8_BAR; }
    PG8_BAR;
    if constexpr (Epi::AFTER_DRAIN) { E.fused(acc, cur, wr, wc, fr, fq, lds, wid, lane); S.done(cur); }
#undef PG8_SA
#undef PG8_SB
#undef PG8_STAGE
#undef PG8_LDA
#undef PG8_LDB
#undef PG8_MMA
#undef PG8_WAIT_V
#undef PG8_WAIT_L
#undef PG8_BAR
#undef PG8_SCHED
}
}

namespace mk {
using pg8::bf16_t; using pg8::bf16x8; using pg8::f32x4; using pg8::u32x4; using pg8::Unit;
typedef float f32x16 __attribute__((ext_vector_type(16)));
typedef unsigned u32x2 __attribute__((ext_vector_type(2)));
#define LAS __attribute__((address_space(3)))

constexpr int NB = 4, SEQ = 2048, DM = 2048, NTOK = NB * SEQ, NL = 2, DIN = 14416, NPAD = 14592, DFF = 8192;
constexpr int NTHR = 512, NWAVE = 8, NMAIN = 14336;
constexpr size_t MiB = 1u << 20;
constexpr size_t WS_WIN = 0;
constexpr size_t WS_WUPA = 114 * MiB;
constexpr size_t WS_WUPR = 130 * MiB;
constexpr size_t WS_WOUT = 146 * MiB;
constexpr size_t WS_WFF1 = 162 * MiB;
constexpr size_t WS_WFF2 = 226 * MiB;
constexpr size_t WS_XB = 290 * MiB;
constexpr size_t WS_PROJ = 322 * MiB;
constexpr size_t WS_Q = WS_PROJ, WS_KRAW = WS_Q + 32 * MiB, WS_KN = WS_KRAW + 8 * MiB, WS_VT = WS_KN + 8 * MiB, WS_IQ = WS_VT + 8 * MiB,
                 WS_RQ = WS_IQ + 16 * MiB, WS_RK = WS_RQ + 16 * MiB, WS_RKT = WS_RK + 16 * MiB, WS_RVT = WS_RKT + 16 * MiB, WS_SRG = WS_RVT + 32 * MiB,
                 WS_SGA = WS_SRG + 32 * MiB, WS_SGB = WS_SGA + 32 * MiB, WS_IK = WS_SGB + 32 * MiB, WS_IW = WS_IK + 1 * MiB;
constexpr size_t WS_HFF = WS_PROJ;
constexpr size_t WS_MASK = 572 * MiB;
constexpr size_t WS_U = 574 * MiB;
constexpr size_t WS_MBUF = WS_U;
constexpr size_t WS_RP = 638 * MiB;
constexpr size_t WS_OATT = 670 * MiB;
constexpr size_t WS_ORET = 702 * MiB;
constexpr size_t WS_MERGED = 734 * MiB;
constexpr size_t WS_ROPE = 766 * MiB;
constexpr size_t WS_RSS = 767 * MiB;
constexpr size_t WS_BAR = 767 * MiB + 512 * 1024;
constexpr size_t WS_END = 768 * MiB;
static_assert(WS_IW + 1 * MiB <= WS_MASK, "proj region");

struct Params {
    const float* x; const float* ln1_g; const float* w_in; const float* qn_g; const float* kn_g; const float* gn_g; const float* gn_b;
    const float* w_upa; const float* w_upr; const float* w_out; const float* ln2_g; const float* w_ff1; const float* w_ff2;
    float* out; unsigned char* ws;
};

typedef const __attribute__((address_space(4))) Params* CP;
__device__ __forceinline__ CP getP() { auto k = __builtin_amdgcn_kernarg_segment_ptr(); asm volatile("" : "+s"(k)); return (CP)k; }
__device__ __forceinline__ float bf2f(unsigned h) { return __uint_as_float(h << 16); }
__device__ __forceinline__ unsigned pk2(float lo, float hi) { return pg8::cvt_pk_bf16(lo, hi); }
__device__ __forceinline__ void st4bf(bf16_t* p, f32x4 v) { *(u32x2*)p = (u32x2){pk2(v[0], v[1]), pk2(v[2], v[3])}; }
__device__ __forceinline__ float shx(float v, int o, int lane) { return __int_as_float(__builtin_amdgcn_ds_bpermute((lane ^ o) << 2, __float_as_int(v))); }
__device__ __forceinline__ int shxi(int v, int o, int lane) { return __builtin_amdgcn_ds_bpermute((lane ^ o) << 2, v); }
__device__ __forceinline__ float x32sum(float v) { auto rr = __builtin_amdgcn_permlane32_swap(__float_as_uint(v), __float_as_uint(v), false, false); return __uint_as_float(rr[0]) + __uint_as_float(rr[1]); }
__device__ __forceinline__ float wave_sum(float v, int lane) {
#pragma unroll
    for (int o = 1; o < 32; o <<= 1) v += shx(v, o, lane);
    return x32sum(v);
}
__device__ __forceinline__ int crow(int r, int hi) { return (r & 3) + 8 * (r >> 2) + 4 * hi; }
__device__ __forceinline__ int kperm(int m) { const int a = m & 3, h1 = (m >> 2) & 1, c = m >> 3; return 16 * (c >> 1) + 8 * h1 + 4 * (c & 1) + a; }
#define MFMA32(a, b, c) __builtin_amdgcn_mfma_f32_32x32x16_bf16((a), (b), (c), 0, 0, 0)
__device__ __forceinline__ bf16x8 pack8(const float* f) { u32x4 w; w.x = pk2(f[0], f[1]); w.y = pk2(f[2], f[3]); w.z = pk2(f[4], f[5]); w.w = pk2(f[6], f[7]); return __builtin_bit_cast(bf16x8, w); }

struct MapIdent { __device__ __forceinline__ int operator()(int n) const { return n; } };
struct MapWin {
    __device__ __forceinline__ int operator()(int n) const {
        if (n < 4096) return n;
        if (n < 6144) { const int t = n - 4096, which = t >> 10, tt = t & 1023, h = tt >> 7, lc = tt & 127; return (which ? 5200 : 4176) + h * 128 + (lc >> 1) + 64 * (lc & 1); }
        if (n < 8192) return 6224 + (n - 6144);
        if (n < 10240) return 8272 + (n - 8192);
        if (n < 12288) return 10320 + (n - 10240);
        if (n < 14336) return 12368 + (n - 12288);
        if (n < 14416) return 4096 + (n - 14336);
        return -1;
    }
};
__device__ __forceinline__ void transpose64(const float* __restrict__ W, int K, int N, bf16_t* WT, const float* __restrict__ gk, int k0, int c0, int ncols, int d0, int ds, LAS float* scr, int lane, int ldk = 0, int fragn0 = -1) {
    if (ldk == 0) ldk = K;
    const int lr = lane >> 4, lc4 = (lane & 15) * 4;
    f32x4 v[16];
#pragma unroll
    for (int i = 0; i < 16; ++i) { const int kk = 4 * i + lr; v[i] = (lc4 < ncols) ? __builtin_nontemporal_load((const f32x4*)(W + (size_t)(k0 + kk) * N + c0 + lc4)) : (f32x4){0.f, 0.f, 0.f, 0.f}; }
#pragma unroll
    for (int i = 0; i < 16; ++i) { const int kk = 4 * i + lr; const float g = gk ? gk[k0 + kk] : 1.0f; LAS float* d = scr + kk * 65 + lc4; d[0] = v[i][0] * g; d[1] = v[i][1] * g; d[2] = v[i][2] * g; d[3] = v[i][3] * g; }
    asm volatile("s_waitcnt lgkmcnt(0)" ::: "memory");
    const int c = lane & 7;
#pragma unroll
    for (int j = 0; j < 8; ++j) { const int n = (lane >> 3) + 8 * j; const LAS float* sp = scr + (8 * c) * 65 + n;
        u32x4 o; o.x = pk2(sp[0 * 65], sp[1 * 65]); o.y = pk2(sp[2 * 65], sp[3 * 65]); o.z = pk2(sp[4 * 65], sp[5 * 65]); o.w = pk2(sp[6 * 65], sp[7 * 65]);
        if (fragn0 < 0) { if (n < ncols) __builtin_nontemporal_store(o, (u32x4*)(WT + (size_t)(d0 + ds * n) * ldk + k0 + 8 * c)); }
        else if (n < 32) { const int nn = fragn0 + n, kq = k0 + 8 * c; if (n >= ncols) o = (u32x4){0u, 0u, 0u, 0u};
            *(u32x4*)(WT + ((size_t)(((nn >> 5) * (K >> 4) + (kq >> 4)) * 2 + ((kq >> 3) & 1)) * 32 + (nn & 31)) * 8) = o; } }
    asm volatile("s_waitcnt lgkmcnt(0)" ::: "memory");
}

__device__ __forceinline__ void prologue(CP pp, LAS unsigned char* lds, int gw, int NGW, int wave, int lane) {
    Params P; P.x = pp->x; P.ln1_g = pp->ln1_g; P.w_in = pp->w_in; P.w_upa = pp->w_upa; P.w_upr = pp->w_upr; P.w_out = pp->w_out; P.ln2_g = pp->ln2_g; P.w_ff1 = pp->w_ff1; P.w_ff2 = pp->w_ff2; P.ws = pp->ws; unsigned char* ws = P.ws;
    LAS float* scr = (LAS float*)(lds + wave * 16640);
    constexpr int T_IN = 226, I_IN = 32 * T_IN, I_SQ = 32 * 32, I_F1 = 32 * 128, I_F2 = 128 * 32, I_L = I_IN + 3 * I_SQ + I_F1 + I_F2;
    for (int it = gw; it < NL * I_L; it += NGW) {
        const int itr = NL * I_L - 1 - it;
        const int l = itr / I_L; int r = itr % I_L;
        if (r < I_IN) {
            const int kb = r / T_IN, t = r % T_IN; int c0, d0, ds = 1, nc = 64;
            if (t < 64) { c0 = 64 * t; d0 = c0; }
            else if (t == 64 || t == 65) {
                bf16_t* wt = (bf16_t*)(ws + WS_WIN + l * 57 * MiB) + (size_t)NMAIN * DM;
                transpose64(P.w_in + (size_t)l * DM * DIN, DM, DIN, wt, P.ln1_g + l * DM, 64 * kb, t == 64 ? 4096 : 4160, t == 64 ? 64 : 16, 0, 1, scr, lane, 0, t == 64 ? 0 : 64);
                if (t == 64) transpose64(P.w_in + (size_t)l * DM * DIN, DM, DIN, wt, P.ln1_g + l * DM, 64 * kb, 4096 + 32, 32, 0, 1, scr, lane, 0, 32);
                continue; }
            else if (t < 98) { const int q = t - 66, which = q >> 4, rr = q & 15, h = rr >> 1, half = rr & 1; c0 = (which ? 5200 : 4176) + h * 128 + 64 * half; d0 = (which ? 5120 : 4096) + h * 128 + half; ds = 2; }
            else { const int q = t - 98; c0 = 6224 + 64 * q; d0 = 6144 + 64 * q; }
            transpose64(P.w_in + (size_t)l * DM * DIN, DM, DIN, (bf16_t*)(ws + WS_WIN + l * 57 * MiB), P.ln1_g + l * DM, 64 * kb, c0, nc, d0, ds, scr, lane); continue; }
        r -= I_IN;
        if (r < 3 * I_SQ) { const int w = r / I_SQ, q = r % I_SQ, kb = q >> 5, t = q & 31; const float* src = (w == 0 ? P.w_upa : (w == 1 ? P.w_upr : P.w_out)) + (size_t)l * DM * DM;
            bf16_t* dst = (w == 2) ? (bf16_t*)(ws + WS_WOUT + l * 8 * MiB) : (bf16_t*)(ws + WS_WUPA + l * 16 * MiB) + (w == 1 ? DM : 0);
            transpose64(src, DM, DM, dst, nullptr, 64 * kb, 64 * t, 64, 64 * t, 1, scr, lane, (w == 2) ? DM : 2 * DM); continue; }
        r -= 3 * I_SQ;
        if (r < I_F1) { const int kb = r >> 7, t = r & 127; transpose64(P.w_ff1 + (size_t)l * DM * DFF, DM, DFF, (bf16_t*)(ws + WS_WFF1 + l * 32 * MiB), P.ln2_g + l * DM, 64 * kb, 64 * t, 64, 64 * t, 1, scr, lane); continue; }
        r -= I_F1;
        { const int kb = r >> 5, t = r & 31; transpose64(P.w_ff2 + (size_t)l * DFF * DM, DFF, DM, (bf16_t*)(ws + WS_WFF2 + l * 32 * MiB), nullptr, 64 * kb, 64 * t, 64, 64 * t, 1, scr, lane); }
    }
    bf16_t* XB = (bf16_t*)(ws + WS_XB); float* RSS = (float*)(ws + WS_RSS);
    for (int m = gw; m < NTOK; m += NGW) {
        const f32x4* xr = (const f32x4*)(P.x + (size_t)m * DM) + lane; float ss = 0.f;
#pragma unroll
        for (int j = 0; j < 8; ++j) { const f32x4 v = xr[64 * j]; ss += (v[0] * v[0] + v[1] * v[1]) + (v[2] * v[2] + v[3] * v[3]); st4bf(XB + (size_t)m * DM + 4 * lane + 256 * j, v); }
        ss = wave_sum(ss, lane);
        if (lane == 0) RSS[m] = ss;
    }
    for (int i = gw * 64 + lane; i < 3 * NTOK; i += NGW * 64) RSS[NTOK + i] = 0.f;
    float* rope = (float*)(ws + WS_ROPE);
    for (int i = gw * 64 + lane; i < SEQ * 64; i += NGW * 64) {
        const int pos = i >> 6, fi = i & 63;
        const float invf = (float)exp(-(double)fi * (9.210340371976184 / 64.0));
        const float angf = (float)pos * invf;
        const double a = (double)angf; const double k = rint(a * 0.15915494309189535); const double r = a - k * 6.283185307179586477;
        const double r2 = r * r; double ts = r, ss = r, tc = 1.0, cc = 1.0;
#pragma unroll
        for (int n = 1; n <= 14; ++n) { ts *= -r2 * (1.0 / (double)((2 * n) * (2 * n + 1))); ss += ts; tc *= -r2 * (1.0 / (double)((2 * n - 1) * (2 * n))); cc += tc; }
        rope[2 * i] = (float)cc; rope[2 * i + 1] = (float)ss;
    }
}

#define EPI_ROWS(...) _Pragma("unroll") for (int ai = 0; ai < 2; ++ai) _Pragma("unroll") for (int m = 0; m < 4; ++m) { int row_ = u.pm * 256 + ai * 128 + wr * 64 + m * 16 + fr; asm volatile("" : "+v"(row_) :: "memory"); const int row = row_; __VA_ARGS__ }
#define EPI_COLS8(...) _Pragma("unroll") for (int bj = 0; bj < 2; ++bj) { const int lc = bj * 128 + wc * 32 + 8 * fq; const f32x4 a0 = acc[ai][bj][m][0], a1 = acc[ai][bj][m][1]; __VA_ARGS__ }

__device__ __forceinline__ float sigm(float x) { return __builtin_amdgcn_rcpf(1.0f + __builtin_amdgcn_exp2f(-1.4426950408889634f * x)); }
__device__ __forceinline__ f32x4 sigm4(f32x4 v) { return (f32x4){sigm(v[0]), sigm(v[1]), sigm(v[2]), sigm(v[3])}; }
__device__ __forceinline__ void st8bf(bf16_t* p, f32x4 v0, f32x4 v1) { *(u32x4*)p = (u32x4){pk2(v0[0], v0[1]), pk2(v0[2], v0[3]), pk2(v1[0], v1[1]), pk2(v1[2], v1[3])}; }
__device__ __forceinline__ void st8col(bf16_t* d, int stride, f32x4 v0, f32x4 v1) {
    d[0] = (bf16_t)pk2(v0[0], 0.f); d[stride] = (bf16_t)pk2(v0[1], 0.f); d[2 * stride] = (bf16_t)pk2(v0[2], 0.f); d[3 * stride] = (bf16_t)pk2(v0[3], 0.f);
    d[4 * stride] = (bf16_t)pk2(v1[0], 0.f); d[5 * stride] = (bf16_t)pk2(v1[1], 0.f); d[6 * stride] = (bf16_t)pk2(v1[2], 0.f); d[7 * stride] = (bf16_t)pk2(v1[3], 0.f);
}
__device__ __forceinline__ f32x4 bflo4(u32x4 w) { return (f32x4){bf2f(w.x & 0xffffu), bf2f(w.x >> 16), bf2f(w.y & 0xffffu), bf2f(w.y >> 16)}; }
__device__ __forceinline__ f32x4 bfhi4(u32x4 w) { return (f32x4){bf2f(w.z & 0xffffu), bf2f(w.z >> 16), bf2f(w.w & 0xffffu), bf2f(w.w >> 16)}; }

struct EpiIn {
    static constexpr bool PERM = true, AFTER_DRAIN = false, MID_HOOK = false;
    const float* rss; unsigned char* ws;
    __device__ __forceinline__ void operator()(const f32x4 (&acc)[2][2][4][2], const Unit& u, int wr, int wc, int fr, int fq) const {
        asm volatile("" : "+v"(fr), "+v"(fq));
        const int pn = u.pn;
        bf16_t* Q = (bf16_t*)(ws + WS_Q); bf16_t* KR = (bf16_t*)(ws + WS_KRAW); bf16_t* VT = (bf16_t*)(ws + WS_VT); bf16_t* IQ = (bf16_t*)(ws + WS_IQ);
        bf16_t* RQ = (bf16_t*)(ws + WS_RQ); bf16_t* RK = (bf16_t*)(ws + WS_RK); bf16_t* RKT = (bf16_t*)(ws + WS_RKT); bf16_t* RVT = (bf16_t*)(ws + WS_RVT);
        bf16_t* SRG = (bf16_t*)(ws + WS_SRG); bf16_t* SGA = (bf16_t*)(ws + WS_SGA); bf16_t* SGB = (bf16_t*)(ws + WS_SGB);
        const float* rope = (const float*)(ws + WS_ROPE);
#define RS const float rs = __builtin_amdgcn_rsqf(rss[row] * (1.0f / 2048.0f) + 1e-6f);
        if (pn < 8) { EPI_ROWS(RS EPI_COLS8(st8bf(Q + (size_t)row * 2048 + pn * 256 + lc, a0 * rs, a1 * rs);)) }
        else if (pn < 10) { EPI_ROWS(RS EPI_COLS8(st8bf(KR + (size_t)row * 512 + (pn - 8) * 256 + lc, a0 * rs, a1 * rs);)) }
        else if (pn < 12) { EPI_ROWS(RS const int b = row >> 11, s = row & 2047; EPI_COLS8(const int c = (pn - 10) * 256 + lc;
                st8col(VT + ((((size_t)(b * 4 + (c >> 7)) * 32 + (s >> 6)) * 128 + (c & 127)) * 64 + (s & 63)), 64, a0 * rs, a1 * rs);)) }
        else if (pn < 16) { EPI_ROWS(RS EPI_COLS8(st8bf(IQ + (size_t)row * 1024 + (pn - 12) * 256 + lc, a0 * rs, a1 * rs);)) }
        else if (pn < 24) { const bool isk = pn >= 20; const int cb = (pn - (isk ? 20 : 16)) * 256; const float scl = isk ? 0.08838834764831845f : 1.0f;
            EPI_ROWS(RS const int b = row >> 11, s = row & 2047; EPI_COLS8(const f32x4 v0 = a0 * (rs * scl), v1 = a1 * (rs * scl);
                const float* rp = rope + ((size_t)s * 64 + ((lc & 127) >> 1)) * 2; const f32x4 cA = *(const f32x4*)rp, cB = *(const f32x4*)(rp + 4);
                f32x4 o0, o1; o0[0] = v0[0] * cA[0] - v0[1] * cA[1]; o0[1] = v0[1] * cA[0] + v0[0] * cA[1]; o0[2] = v0[2] * cA[2] - v0[3] * cA[3]; o0[3] = v0[3] * cA[2] + v0[2] * cA[3];
                o1[0] = v1[0] * cB[0] - v1[1] * cB[1]; o1[1] = v1[1] * cB[0] + v1[0] * cB[1]; o1[2] = v1[2] * cB[2] - v1[3] * cB[3]; o1[3] = v1[3] * cB[2] + v1[2] * cB[3];
                const int c = cb + lc, dd = c & 127, ii = s & 127;
                const size_t ub = ((size_t)(b * 8 + (c >> 7)) * 16 + (s >> 7)) * 16384;
                const size_t fo = ub + (ii >> 5) * 4096 + (((dd >> 4) * 2 + ((dd >> 3) & 1)) * 32 + (ii & 31)) * 8;
                if (!isk) st8bf(RQ + fo, o0, o1);
                else { st8bf(RK + fo, o0, o1); st8col(RKT + ub + (dd >> 5) * 4096 + (((ii >> 4) * 2 + ((ii >> 3) & 1)) * 32 + (dd & 31)) * 8 + (ii & 7), 8, o0, o1); })) }
        else if (pn < 32) { EPI_ROWS(RS const int b = row >> 11, s = row & 2047; EPI_COLS8(const int c = (pn - 24) * 256 + lc, ee = c & 255, ii = s & 127;
                st8col(RVT + ((size_t)(b * 8 + (c >> 8)) * 16 + (s >> 7)) * 32768 + (ee >> 5) * 4096 + (((ii >> 4) * 2 + ((ii >> 3) & 1)) * 32 + (ee & 31)) * 8 + (ii & 7), 8, a0 * rs, a1 * rs);)) }
        else if (pn < 40) { EPI_ROWS(RS const int b = row >> 11, s = row & 2047; EPI_COLS8(f32x4 v0 = a0 * rs, v1 = a1 * rs; v0 = v0 * sigm4(v0); v1 = v1 * sigm4(v1);
                const int c = (pn - 32) * 256 + lc, e = c & 255, i = s & 127;
                bf16_t* d = SRG + ((size_t)(b * 8 + (c >> 8)) * 16 + (s >> 7)) * 32768 + (i >> 5) * 8192 + (e >> 7) * 4096 + ((e >> 3) & 15) * 256 + (i & 31) * 4;
                st4bf(d, v0); st4bf(d + 128, v1);)) }
        else { bf16_t* G = (pn < 48) ? SGA : SGB; const int cb = (pn - (pn < 48 ? 40 : 48)) * 256;
            EPI_ROWS(RS EPI_COLS8(st8bf(G + (size_t)row * 2048 + cb + lc, sigm4(a0 * rs), sigm4(a1 * rs));)) }
#undef RS
    }
};
struct EpiGate {
    static constexpr bool PERM = true, AFTER_DRAIN = false, MID_HOOK = true;
    const bf16_t* GA; const bf16_t* GB; bf16_t* merged;
    __device__ __forceinline__ void mid(f32x4 (&acc)[2][2][4][2], const Unit& u, int wr, int wc, int fr, int fq) const {
        asm volatile("s_waitcnt vmcnt(0)" : "+v"(fr), "+v"(fq) :: "memory");
        EPI_ROWS(_Pragma("unroll") for (int bj = 0; bj < 2; ++bj) { const int lc = bj * 128 + wc * 32 + 8 * fq; const size_t off = (size_t)row * 2048 + u.pn * 256 + lc;
            const u32x4 ga = *(const u32x4*)(GA + off); const u32x4 gb = *(const u32x4*)(GB + off);
            const f32x4 gb0 = bflo4(gb), gb1 = bfhi4(gb); f32x4 r0 = bflo4(ga), r1 = bfhi4(ga);
            _Pragma("unroll") for (int k = 0; k < 4; ++k) { r0[k] *= __builtin_amdgcn_rcpf(fmaxf(gb0[k], 1e-30f)); r1[k] *= __builtin_amdgcn_rcpf(fmaxf(gb1[k], 1e-30f)); }
            acc[ai][bj][m][0] = acc[ai][bj][m][0] * r0; acc[ai][bj][m][1] = acc[ai][bj][m][1] * r1; })
        asm volatile("s_waitcnt vmcnt(0)" ::: "memory");
    }
    __device__ __forceinline__ void operator()(const f32x4 (&acc)[2][2][4][2], const Unit& u, int wr, int wc, int fr, int fq) const {
        asm volatile("" : "+v"(fr), "+v"(fq));
        EPI_ROWS(EPI_COLS8(const size_t off = (size_t)row * 2048 + u.pn * 256 + lc; const u32x4 g = *(const u32x4*)(GB + off); st8bf(merged + off, a0 * bflo4(g), a1 * bfhi4(g));))
    }
};
struct EpiRes {
    static constexpr bool PERM = true, AFTER_DRAIN = false, MID_HOOK = false;
    const float* xin; float* xout; bf16_t* xb; float* rss;
    __device__ __forceinline__ void operator()(const f32x4 (&acc)[2][2][4][2], const Unit& u, int wr, int wc, int fr, int fq) const {
        asm volatile("" : "+v"(fr), "+v"(fq));
        EPI_ROWS(float ss = 0.f; EPI_COLS8(const size_t off = (size_t)row * 2048 + u.pn * 256 + lc; const f32x4 o0 = *(const f32x4*)(xin + off) + a0, o1 = *(const f32x4*)(xin + off + 4) + a1;
                *(f32x4*)(xout + off) = o0; *(f32x4*)(xout + off + 4) = o1; if (xb) st8bf(xb + off, o0, o1);
                ss += ((o0[0] * o0[0] + o0[1] * o0[1]) + (o0[2] * o0[2] + o0[3] * o0[3])) + ((o1[0] * o1[0] + o1[1] * o1[1]) + (o1[2] * o1[2] + o1[3] * o1[3]));)
            if (rss) { ss += shx(ss, 16, fr + 16 * fq); ss = x32sum(ss); if (fq == 0) atomicAdd(rss + row, ss); })
    }
};
struct EpiFF1 {
    static constexpr bool PERM = true, AFTER_DRAIN = false, MID_HOOK = false;
    const float* rss; bf16_t* H;
    __device__ __forceinline__ void operator()(const f32x4 (&acc)[2][2][4][2], const Unit& u, int wr, int wc, int fr, int fq) const {
        asm volatile("" : "+v"(fr), "+v"(fq));
        EPI_ROWS(const float rs = __builtin_amdgcn_rsqf(rss[row] * (1.0f / 2048.0f) + 1e-6f); EPI_COLS8(f32x4 v0 = a0 * rs, v1 = a1 * rs;
            v0[0] = fmaxf(v0[0], 0.f); v0[1] = fmaxf(v0[1], 0.f); v0[2] = fmaxf(v0[2], 0.f); v0[3] = fmaxf(v0[3], 0.f); v1[0] = fmaxf(v1[0], 0.f); v1[1] = fmaxf(v1[1], 0.f); v1[2] = fmaxf(v1[2], 0.f); v1[3] = fmaxf(v1[3], 0.f);
            st8bf(H + (size_t)row * DFF + u.pn * 256 + lc, v0 * v0, v1 * v1);))
    }
};

__device__ __forceinline__ void tail_block(unsigned char* ws, const bf16_t* Wt, const float* rss, LAS unsigned char* lds, int rb, int wave, int lane) {
    const bf16_t* XB = (const bf16_t*)(ws + WS_XB); bf16_t* IK = (bf16_t*)(ws + WS_IK); float* IW = (float*)(ws + WS_IW);
    const int hi = lane >> 5, l32 = lane & 31, tid = wave * 64 + lane;
    const bf16_t* ap = XB + (size_t)(32 * rb + l32) * 2048 + 256 * wave + 8 * hi;
    const bf16_t* bp = Wt + (size_t)(16 * wave) * 512 + lane * 8;
    f32x16 acc[3];
#pragma unroll
    for (int nb = 0; nb < 3; ++nb) acc[nb] = (f32x16){0.f, 0.f, 0.f, 0.f, 0.f, 0.f, 0.f, 0.f, 0.f, 0.f, 0.f, 0.f, 0.f, 0.f, 0.f, 0.f};
#pragma unroll
    for (int kb = 0; kb < 4; ++kb) {
        bf16x8 af[4], bfr[3][4];
#pragma unroll
        for (int k4 = 0; k4 < 4; ++k4) { af[k4] = *(const bf16x8*)(ap + 16 * (4 * kb + k4));
#pragma unroll
            for (int nb = 0; nb < 3; ++nb) bfr[nb][k4] = *(const bf16x8*)(bp + (size_t)(nb * 128 + 4 * kb + k4) * 512); }
        __builtin_amdgcn_sched_barrier(0);
#pragma unroll
        for (int k4 = 0; k4 < 4; ++k4)
#pragma unroll
            for (int nb = 0; nb < 3; ++nb) acc[nb] = MFMA32(af[k4], bfr[nb][k4], acc[nb]);
        __builtin_amdgcn_sched_barrier(0);
    }
    LAS float* part = (LAS float*)lds;
#pragma unroll
    for (int nb = 0; nb < 3; ++nb)
#pragma unroll
        for (int r = 0; r < 16; ++r) part[wave * 3072 + crow(r, hi) * 96 + 32 * nb + l32] = acc[nb][r];
    __syncthreads();
#pragma unroll
    for (int i = 0; i < 6; ++i) {
        const int idx = tid + 512 * i, row = idx / 96, col = idx % 96;
        float v = 0.f;
#pragma unroll
        for (int w = 0; w < 8; ++w) v += part[w * 3072 + idx];
        const int grow = 32 * rb + row;
        v *= rsqrtf(rss[grow] * (1.0f / 2048.0f) + 1e-6f);
        if (col < 64) IK[(size_t)grow * 64 + col] = (bf16_t)pk2(v, 0.f);
        else if (col < 80) IW[(size_t)grow * 16 + (col - 64)] = v * 0.25f;
    }
    __syncthreads();
}

__device__ __forceinline__ void indexer_group(unsigned char* ws, LAS unsigned char* lds, int grp, int wave, int lane) {
    const bf16_t* IQ = (const bf16_t*)(ws + WS_IQ); const bf16_t* IK = (const bf16_t*)(ws + WS_IK); const float* IW = (const float*)(ws + WS_IW); unsigned* MASK = (unsigned*)(ws + WS_MASK);
    const int b = grp >> 7, T0 = (grp & 127) * 16, t0 = T0 + 2 * wave, hi = lane >> 5, l32 = lane & 31, tid = wave * 64 + lane;
    const size_t rowbase = (size_t)b * SEQ;
    const int atok = (l32 >> 2) & 1, ahead = 4 * (l32 >> 3) + (l32 & 3);
    const bf16_t* ap = IQ + (rowbase + t0 + atok) * 1024 + ahead * 64 + 8 * hi;
    bf16x8 af[4];
#pragma unroll
    for (int kk = 0; kk < 4; ++kk) af[kk] = *(const bf16x8*)(ap + 16 * kk);
    float w[16];
#pragma unroll
    for (int i = 0; i < 4; ++i) { const f32x4 t = *(const f32x4*)(IW + (rowbase + t0 + hi) * 16 + 4 * i); w[4 * i] = t[0]; w[4 * i + 1] = t[1]; w[4 * i + 2] = t[2]; w[4 * i + 3] = t[3]; }
    const int tq = t0 + hi, nj = (t0 + 1) / 32 + 1, nchunk = ((T0 + 15) / 32 + 1 + 7) / 8;
    u32x4 stg[4];
#define IDX_LOAD(c) do { _Pragma("unroll") for (int i = 0; i < 4; ++i) { const int p = tid + 512 * i; stg[i] = *(const u32x4*)(IK + (rowbase + 256 * (c) + (p >> 3)) * 64 + 8 * (p & 7)); } } while (0)
    IDX_LOAD(0);
    unsigned uk[64];
#pragma unroll
    for (int c = 0; c < 8; ++c) {
        if (c < nchunk) {
            __syncthreads();
#pragma unroll
            for (int i = 0; i < 4; ++i) { const int p = tid + 512 * i; *(LAS u32x4*)(lds + (p >> 3) * 144 + (p & 7) * 16) = stg[i]; }
            __syncthreads();
            if (c + 1 < nchunk) IDX_LOAD(c + 1);
#pragma unroll
            for (int jj = 0; jj < 8; ++jj) { const int j = 8 * c + jj;
                if (j < nj) {
                    const LAS unsigned char* bp = lds + (32 * jj + l32) * 144 + 16 * hi;
                    f32x16 cc = {0.f, 0.f, 0.f, 0.f, 0.f, 0.f, 0.f, 0.f, 0.f, 0.f, 0.f, 0.f, 0.f, 0.f, 0.f, 0.f};
#pragma unroll
                    for (int kk = 0; kk < 4; ++kk) cc = MFMA32(af[kk], *(const LAS bf16x8*)(bp + 32 * kk), cc);
                    float sc = 0.f;
#pragma unroll
                    for (int r = 0; r < 16; ++r) sc += w[r] * fmaxf(cc[r], 0.f);
                    const unsigned bits = __float_as_uint(sc); const unsigned ku = bits ^ ((bits >> 31) ? 0xffffffffu : 0x80000000u);
                    uk[j] = (32 * j + l32 <= tq) ? ku : 0u;
                } else uk[j] = 0u; }
        } else {
#pragma unroll
            for (int jj = 0; jj < 8; ++jj) uk[8 * c + jj] = 0u; }
    }
#undef IDX_LOAD
    unsigned p = 0u; bool done = (tq + 1 <= 256);
    for (int bit = 31; bit >= 0; --bit) {
        if (__all(done)) break;
        const unsigned cand = p | (1u << bit);
        int cnt = 0;
#pragma unroll
        for (int g = 0; g < 8; ++g) if (8 * g < nj) {
#pragma unroll
            for (int jj = 0; jj < 8; ++jj) cnt += (uk[8 * g + jj] >= cand) ? 1 : 0; }
        cnt += __builtin_amdgcn_update_dpp(0, cnt, 0xB1, 0xF, 0xF, true); cnt += __builtin_amdgcn_update_dpp(0, cnt, 0x4E, 0xF, 0xF, true);
        cnt += __builtin_amdgcn_update_dpp(0, cnt, 0x141, 0xF, 0xF, true); cnt += __builtin_amdgcn_update_dpp(0, cnt, 0x140, 0xF, 0xF, true);
        { auto rr = __builtin_amdgcn_permlane16_swap((unsigned)cnt, (unsigned)cnt, false, false); cnt = (int)(rr[0] + rr[1]); }
        if (!done && cnt >= 256) { p = cand; if (cnt == 256) done = true; }
    }
    const unsigned thr = (tq + 1 <= 256) ? 1u : (p > 1u ? p : 1u);
    unsigned alo = 0u, ahi = 0u;
#pragma unroll
    for (int j = 0; j < 64; ++j) { const unsigned long long bal = __ballot(uk[j] >= thr); if (lane == j) { alo = (unsigned)bal; ahi = (unsigned)(bal >> 32); } }
    MASK[(rowbase + t0) * 64 + lane] = alo; MASK[(rowbase + t0 + 1) * 64 + lane] = ahi;
}

__device__ __forceinline__ void ra_unit(unsigned char* ws, int unit, int wave, int lane) {
    const bf16_t* RVT = (const bf16_t*)(ws + WS_RVT); const bf16_t* RKT = (const bf16_t*)(ws + WS_RKT); float* U = (float*)(ws + WS_U);
    const int b = unit >> 7, h = (unit >> 4) & 7, n = unit & 15, s0 = n * 128, eb = wave, hi = lane >> 5, l32 = lane & 31;
    const float lg2 = __log2f(1.0f - exp2f(-5.0f - (float)h));
    const bf16_t* vp = RVT + ((size_t)(b * 2048 + h * 256 + 32 * eb + l32)) * 2048 + s0 + 8 * hi;
    bf16x8 af[8];
#pragma unroll
    for (int kk = 0; kk < 8; ++kk) { const bf16x8 raw = *(const bf16x8*)(vp + 16 * kk); float f[8];
#pragma unroll
        for (int i = 0; i < 8; ++i) f[i] = bf2f((unsigned)(unsigned short)raw[i]) * exp2f(lg2 * (float)(127 - (16 * kk + 8 * hi + i)));
        af[kk] = pack8(f); }
    __builtin_amdgcn_sched_barrier(0);
#pragma unroll
    for (int db = 0; db < 4; ++db) {
        bf16x8 bfr[8];
        const bf16_t* kp = RKT + ((size_t)(b * 1024 + h * 128 + 32 * db + l32)) * 2048 + s0 + 8 * hi;
#pragma unroll
        for (int kk = 0; kk < 8; ++kk) bfr[kk] = *(const bf16x8*)(kp + 16 * kk);
        __builtin_amdgcn_sched_barrier(0);
        f32x16 c = {0.f, 0.f, 0.f, 0.f, 0.f, 0.f, 0.f, 0.f, 0.f, 0.f, 0.f, 0.f, 0.f, 0.f, 0.f, 0.f};
#pragma unroll
        for (int kk = 0; kk < 8; ++kk) c = MFMA32(af[kk], bfr[kk], c);
#pragma unroll
        for (int r = 0; r < 16; ++r) U[(size_t)unit * 32768 + (32 * eb + crow(r, hi)) * 128 + 32 * db + l32] = c[r];
        __builtin_amdgcn_sched_barrier(0);
    }
}
__device__ __forceinline__ void rb_scan(unsigned char* ws, int gtid, int nthr) {
    const float* U = (const float*)(ws + WS_U); bf16_t* RP = (bf16_t*)(ws + WS_RP);
    for (int it = gtid; it < 32 * 8192; it += nthr) {
        const int bh = it >> 13, e4 = (it & 8191) * 4, h = bh & 7;
        const float lg2 = __log2f(1.0f - exp2f(-5.0f - (float)h)); const float cd = exp2f(lg2 * 128.0f);
        f32x4 R = {0.f, 0.f, 0.f, 0.f};
#pragma unroll 4
        for (int n = 0; n < 16; ++n) { const size_t off = ((size_t)(bh * 16 + n)) * 32768 + e4; st4bf(RP + off, R); R = *(const f32x4*)(U + off) + R * cd; }
    }
}
__device__ __forceinline__ void stage_put(LAS unsigned char* stg, int lane, int colgrp4  , f32x4 v) {
    *(LAS u32x2*)(stg + (lane & 31) * 272 + colgrp4 * 2) = (u32x2){pk2(v[0], v[1]), pk2(v[2], v[3])};
}
__device__ __forceinline__ void stage_flush(const LAS unsigned char* stg, int lane, bf16_t* out  , size_t row_stride) {
    asm volatile("s_waitcnt lgkmcnt(0)" ::: "memory");
#pragma unroll
    for (int it = 0; it < 8; ++it) { const int row = it * 4 + (lane >> 4), ch = lane & 15; *(u32x4*)(out + (size_t)row * row_stride + ch * 8) = *(const LAS u32x4*)(stg + row * 272 + ch * 16); }
    asm volatile("s_waitcnt lgkmcnt(0)" ::: "memory");
}
__device__ __forceinline__ void rascan_unit(unsigned char* ws, int unit, int wave, int lane) {
    const bf16_t* RVT = (const bf16_t*)(ws + WS_RVT); const bf16_t* RKT = (const bf16_t*)(ws + WS_RKT); bf16_t* RP = (bf16_t*)(ws + WS_RP);
    const int b = unit >> 5, h = (unit >> 2) & 7, dblk = unit & 3, eb = wave, hi = lane >> 5, l32 = lane & 31;
    const float lg2 = __log2f(1.0f - exp2f(-5.0f - (float)h)); const float cd = exp2f(lg2 * 128.0f);
    float zi[8], zk[8];
#pragma unroll
    for (int i = 0; i < 8; ++i) { zi[i] = exp2f(lg2 * (float)(127 - 8 * hi - i)); zk[i] = exp2f(lg2 * (float)(-16 * i)); }
    const bf16_t* vrow = RVT + ((size_t)(b * 8 + h) * 16) * 32768 + eb * 4096 + lane * 8;
    const bf16_t* krow = RKT + ((size_t)(b * 8 + h) * 16) * 16384 + dblk * 4096 + lane * 8;
    const int dq = 32 * dblk + l32; bf16_t* rpo = RP + ((size_t)(b * 8 + h) * 16) * 32768 + eb * 4096 + (((dq >> 4) * 2 + ((dq >> 3) & 1)) * 32 + 4 * hi) * 8 + (dq & 7);
    f32x16 R = {0.f, 0.f, 0.f, 0.f, 0.f, 0.f, 0.f, 0.f, 0.f, 0.f, 0.f, 0.f, 0.f, 0.f, 0.f, 0.f};
    bf16x8 va[8], ka[8];
#define RS_LOAD(n, V, K) do { _Pragma("unroll") for (int kk = 0; kk < 8; ++kk) { V[kk] = *(const bf16x8*)(vrow + (size_t)(n) * 32768 + 512 * kk); K[kk] = *(const bf16x8*)(krow + (size_t)(n) * 16384 + 512 * kk); } } while (0)
#define RS_STEP(n, V, K) do { \
        bf16_t* rp_ = rpo + (size_t)(n) * 32768; \
        _Pragma("unroll") for (int r = 0; r < 16; ++r) rp_[((r & 3) + 8 * (r >> 2)) * 8] = (bf16_t)pk2(R[r], 0.f); \
        f32x16 u_ = {0.f, 0.f, 0.f, 0.f, 0.f, 0.f, 0.f, 0.f, 0.f, 0.f, 0.f, 0.f, 0.f, 0.f, 0.f, 0.f}; \
        _Pragma("unroll") for (int kk = 0; kk < 8; ++kk) { float f_[8]; \
            _Pragma("unroll") for (int i = 0; i < 8; ++i) f_[i] = bf2f((unsigned)(unsigned short)V[kk][i]) * (zk[kk] * zi[i]); \
            u_ = MFMA32(pack8(f_), K[kk], u_); } \
        R = u_ + R * cd; } while (0)
#pragma unroll 1
    for (int n = 0; n < 16; ++n) {
        RS_LOAD(n, va, ka);
        __builtin_amdgcn_sched_barrier(0);
        RS_STEP(n, va, ka);
        __builtin_amdgcn_sched_barrier(0);
    }
#undef RS_LOAD
#undef RS_STEP
}
__device__ __forceinline__ void rc_unit(unsigned char* ws, const float* gn_g, const float* gn_b, LAS unsigned char* lds, int unit, int layer, int wave, int lane) {
    const bf16_t* RQ = (const bf16_t*)(ws + WS_RQ); const bf16_t* RK = (const bf16_t*)(ws + WS_RK); const bf16_t* RVT = (const bf16_t*)(ws + WS_RVT); const bf16_t* RP = (const bf16_t*)(ws + WS_RP);
    const bf16_t* SRG = (const bf16_t*)(ws + WS_SRG); bf16_t* ORET = (bf16_t*)(ws + WS_OATT) + 2048;
    const int b = unit >> 7, h = (unit >> 4) & 7, n = unit & 15, s0 = n * 128, ib = wave >> 1, eh = wave & 1, hi = lane >> 5, l32 = lane & 31;
    const float lg2 = __log2f(1.0f - exp2f(-5.0f - (float)h));
    const size_t tok = (size_t)b * SEQ + s0 + 32 * ib + l32;
    bf16x8 qf[8];
#pragma unroll
    for (int kk = 0; kk < 8; ++kk) qf[kk] = *(const bf16x8*)(RQ + (size_t)unit * 16384 + ib * 4096 + kk * 512 + lane * 8);
    f32x16 acc[4];
    const int iq = 32 * ib + l32;
    bf16x8 pfr[4][2];
    {
        bf16x8 kf[32];
#pragma unroll
        for (int jb = 0; jb < 4; ++jb) { const bf16_t* kp = RK + (size_t)unit * 16384 + jb * 4096 + (hi * 32 + kperm(l32)) * 8;
#pragma unroll
            for (int kk = 0; kk < 8; ++kk) kf[8 * jb + kk] = *(const bf16x8*)(kp + 512 * kk); }
        __builtin_amdgcn_sched_barrier(0);
#pragma unroll
        for (int jb = 0; jb < 4; ++jb) { f32x16 st = {0.f, 0.f, 0.f, 0.f, 0.f, 0.f, 0.f, 0.f, 0.f, 0.f, 0.f, 0.f, 0.f, 0.f, 0.f, 0.f};
#pragma unroll
            for (int kk = 0; kk < 8; ++kk) st = MFMA32(kf[8 * jb + kk], qf[kk], st);
            float f[16];
#pragma unroll
            for (int r = 0; r < 16; ++r) { const int j = 32 * jb + 16 * (r >> 3) + 8 * hi + (r & 7); const int df = iq - j; f[r] = (df >= 0) ? st[r] * exp2f(lg2 * (float)df) : 0.f; }
            pfr[jb][0] = pack8(f); pfr[jb][1] = pack8(f + 8); }
        __builtin_amdgcn_sched_barrier(0);
    }
    int lnc = lane; asm volatile("" : "+v"(lnc)); const int l32c = lnc & 31;
#pragma unroll
    for (int ep = 0; ep < 2; ++ep) {
        bf16x8 rf[16];
#pragma unroll
        for (int e2 = 0; e2 < 2; ++e2) { const int eb = 4 * eh + 2 * ep + e2; const bf16_t* rp = RP + (size_t)unit * 32768 + eb * 4096 + lnc * 8;
#pragma unroll
            for (int kk = 0; kk < 8; ++kk) rf[8 * e2 + kk] = *(const bf16x8*)(rp + 512 * kk); }
        __builtin_amdgcn_sched_barrier(0);
#pragma unroll
        for (int e2 = 0; e2 < 2; ++e2) { f32x16 c = {0.f, 0.f, 0.f, 0.f, 0.f, 0.f, 0.f, 0.f, 0.f, 0.f, 0.f, 0.f, 0.f, 0.f, 0.f, 0.f};
#pragma unroll
            for (int kk = 0; kk < 8; ++kk) c = MFMA32(rf[8 * e2 + kk], qf[kk], c);
            acc[2 * ep + e2] = c * exp2f(lg2 * (float)(32 * ib + l32c + 1)); }
        __builtin_amdgcn_sched_barrier(0);
    }
    int lnv = lane; asm volatile("" : "+v"(lnv)); const int l32v = lnv & 31, hiv = lnv >> 5;
#pragma unroll
    for (int ep = 0; ep < 2; ++ep) {
        bf16x8 vf[16];
#pragma unroll
        for (int e2 = 0; e2 < 2; ++e2) { const int eb = 4 * eh + 2 * ep + e2; const bf16_t* vp = RVT + (size_t)unit * 32768 + eb * 4096 + lnv * 8;
#pragma unroll
            for (int q = 0; q < 8; ++q) vf[8 * e2 + q] = *(const bf16x8*)(vp + 512 * q); }
        __builtin_amdgcn_sched_barrier(0);
#pragma unroll
        for (int e2 = 0; e2 < 2; ++e2)
#pragma unroll
            for (int q = 0; q < 8; ++q) acc[2 * ep + e2] = MFMA32(vf[8 * e2 + q], pfr[q >> 1][q & 1], acc[2 * ep + e2]);
        __builtin_amdgcn_sched_barrier(0);
    }
    float s1 = 0.f, s2 = 0.f;
#pragma unroll
    for (int el = 0; el < 4; ++el)
#pragma unroll
        for (int r = 0; r < 16; ++r) { const float v = acc[el][r]; s1 += v; s2 += v * v; }
    s1 = x32sum(s1); s2 = x32sum(s2);
    LAS float* xs = (LAS float*)lds;
    __syncthreads();
    if (hi == 0) { xs[(wave * 32 + l32) * 2] = s1; xs[(wave * 32 + l32) * 2 + 1] = s2; }
    __syncthreads();
    s1 += xs[((wave ^ 1) * 32 + l32) * 2]; s2 += xs[((wave ^ 1) * 32 + l32) * 2 + 1];
    const float mu = s1 * (1.0f / 256.0f); const float var = fmaxf(s2 * (1.0f / 256.0f) - mu * mu, 0.f); const float rstd = rsqrtf(var + 1e-6f);
    const float* gg = gn_g + layer * 2048 + h * 256; const float* gb = gn_b + layer * 2048 + h * 256;
    int ln2 = lane; asm volatile("" : "+v"(ln2));
    const int hi2 = ln2 >> 5;
    const bf16_t* sgp = SRG + (size_t)unit * 32768 + ib * 8192 + eh * 4096 + ln2 * 4;
    LAS unsigned char* stg = lds + 4096 + wave * 8704;
#pragma unroll
    for (int el = 0; el < 4; ++el)
#pragma unroll
        for (int c4 = 0; c4 < 4; ++c4) {
            const int e0 = 32 * (4 * eh + el) + 8 * c4 + 4 * hi2;
            const f32x4 g4 = *(const f32x4*)(gg + e0), b4 = *(const f32x4*)(gb + e0); const u32x2 sg = *(const u32x2*)(sgp + (el * 4 + c4) * 256);
            f32x4 o;
            o[0] = ((acc[el][4 * c4 + 0] - mu) * rstd * g4[0] + b4[0]) * bf2f(sg.x & 0xffffu);
            o[1] = ((acc[el][4 * c4 + 1] - mu) * rstd * g4[1] + b4[1]) * bf2f(sg.x >> 16);
            o[2] = ((acc[el][4 * c4 + 2] - mu) * rstd * g4[2] + b4[2]) * bf2f(sg.y & 0xffffu);
            o[3] = ((acc[el][4 * c4 + 3] - mu) * rstd * g4[3] + b4[3]) * bf2f(sg.y >> 16);
            stage_put(stg, ln2, 32 * el + 8 * c4 + 4 * hi2, o);
        }
    stage_flush(stg, ln2, ORET + ((size_t)b * SEQ + s0 + 32 * ib) * 4096 + h * 256 + 128 * eh, 4096);
}

constexpr int KT_STRIDE = 136, VT_STRIDE = 72, ATT_K_OFF = 0, ATT_V_OFF = 64 * KT_STRIDE * 2, ATT_BUF = 64 * KT_STRIDE * 2 + 128 * VT_STRIDE * 2, ATT_Q_OFF = 2 * ATT_BUF;
__device__ __forceinline__ void attn_unit(unsigned char* ws, const float* qn_g, const float* kn_g, LAS unsigned char* lds, int unit, int layer, int wave, int lane) {
    const bf16_t* Q = (const bf16_t*)(ws + WS_Q); const bf16_t* KN = (const bf16_t*)(ws + WS_KN); const bf16_t* VT = (const bf16_t*)(ws + WS_VT); const unsigned* MASK = (const unsigned*)(ws + WS_MASK);
    bf16_t* OATT = (bf16_t*)(ws + WS_OATT);
    const int tid = wave * 64 + lane, hi = lane >> 5, l32 = lane & 31;
    int bg, qb; if (unit < 256) { bg = unit >> 4; qb = unit & 15; } else { bg = (unit - 256) >> 4; qb = 31 - ((unit - 256) & 15); }
    const int b = bg >> 2, g = bg & 3, hh = g * 4 + (wave >> 1), q0 = qb * 64, qs = q0 + 32 * (wave & 1);
    const size_t tok = (size_t)b * SEQ + qs + l32;
    bf16x8 qf[8]; float mfix;
    {
        float ss = 0.f;
        const bf16_t* qp = Q + tok * 2048 + hh * 128 + 8 * hi;
#pragma unroll
        for (int kk = 0; kk < 8; ++kk) { qf[kk] = *(const bf16x8*)(qp + 16 * kk);
#pragma unroll
            for (int i = 0; i < 8; ++i) { const float v = bf2f((unsigned)(unsigned short)qf[kk][i]); ss += v * v; } }
        ss = x32sum(ss);
        const float rs = rsqrtf(ss * (1.0f / 128.0f) + 1e-6f) * (0.08838834764831845f * 1.4426950408889634f);
        const float* qg = qn_g + layer * 128 + 8 * hi; float s2 = 0.f;
#pragma unroll
        for (int kk = 0; kk < 8; ++kk) { float f[8];
#pragma unroll
            for (int i = 0; i < 8; ++i) { f[i] = bf2f((unsigned)(unsigned short)qf[kk][i]) * rs * qg[16 * kk + i]; s2 += f[i] * f[i]; }
            *(LAS bf16x8*)(lds + ATT_Q_OFF + wave * 8192 + kk * 1024 + lane * 16) = pack8(f); }
        s2 = x32sum(s2);
        float gm = fmaxf(fabsf(kn_g[layer * 128 + 2 * lane]), fabsf(kn_g[layer * 128 + 2 * lane + 1]));
#pragma unroll
        for (int o = 1; o < 64; o <<= 1) gm = fmaxf(gm, shx(gm, o, lane));
        mfix = sqrtf(s2) * 11.313708498984761f * gm * 1.01f + 0.01f;
    }
    f32x16 o[4];
#pragma unroll
    for (int d = 0; d < 4; ++d) o[d] = (f32x16){0.f, 0.f, 0.f, 0.f, 0.f, 0.f, 0.f, 0.f, 0.f, 0.f, 0.f, 0.f, 0.f, 0.f, 0.f, 0.f};
    float lrun = 0.f;
    const int nt = qb + 1;
    const bf16_t* kbase = KN + ((size_t)(b * 4 + g) * SEQ) * 128; const bf16_t* vbase = VT + ((size_t)(b * 4 + g) * 32) * 8192;
    u32x4 kst[2], vst[2];
    unsigned koff[2], voff[2];
#pragma unroll
    for (int i = 0; i < 2; ++i) { const int p = tid + 512 * i; koff[i] = (unsigned)(p * 16); voff[i] = (unsigned)(p * 16); }
#define ATT_LOAD(t) do { const char* kb_ = (const char*)(kbase + (size_t)(t) * 8192); const char* vb_ = (const char*)(vbase + (size_t)(t) * 8192); \
        _Pragma("unroll") for (int i = 0; i < 2; ++i) { kst[i] = *(const u32x4*)(kb_ + koff[i]); vst[i] = *(const u32x4*)(vb_ + voff[i]); } } while (0)
#define ATT_STORE(buf) do { _Pragma("unroll") for (int i = 0; i < 2; ++i) { const int p = tid + 512 * i; *(LAS u32x4*)(lds + (buf) * ATT_BUF + ATT_K_OFF + ((p >> 4) * KT_STRIDE + 8 * (p & 15)) * 2) = kst[i]; \
        *(LAS u32x4*)(lds + (buf) * ATT_BUF + ATT_V_OFF + ((p >> 3) * VT_STRIDE + 8 * (p & 7)) * 2) = vst[i]; } } while (0)
    __builtin_amdgcn_sched_barrier(0);
    const char* mbase = (const char*)(MASK + ((size_t)b * SEQ + qs) * 64); const unsigned moff = (unsigned)l32 * 256u;
    u32x2 mwn = *(const u32x2*)(mbase + moff);
    ATT_LOAD(0);
    __syncthreads();
    ATT_STORE(0);
    __syncthreads();
    for (int t = 0; t < nt; ++t) {
        const int cur = t & 1;
        const u32x2 mw = mwn;
        if (t + 1 < nt) { mwn = *(const u32x2*)(mbase + (moff + 8u * (unsigned)(t + 1))); ATT_LOAD(t + 1); }
        float psum = 0.f; bf16x8 pf[2][2];
        const LAS unsigned char* kp = lds + cur * ATT_BUF + ATT_K_OFF + (kperm(l32) * KT_STRIDE + 8 * hi) * 2;
        const LAS unsigned char* vp = lds + cur * ATT_BUF + ATT_V_OFF + (l32 * VT_STRIDE + 8 * hi) * 2;
#define KFR(p, kk) (*(const LAS bf16x8*)(kp + (p) * (32 * KT_STRIDE * 2) + 32 * (kk)))
#define VFR(d, q) (*(const LAS bf16x8*)(vp + (d) * (32 * VT_STRIDE * 2) + 32 * (q)))
        f32x16 c0, c1;
#pragma unroll
        for (int r = 0; r < 16; ++r) { c0[r] = -mfix; c1[r] = -mfix; }
        const LAS unsigned char* qpk = lds + ATT_Q_OFF + wave * 8192 + lane * 16;
#define QFR(kk) (*(const LAS bf16x8*)(qpk + (kk) * 1024))
        bf16x8 fA[4], fB[4], qA[2], qB[2];
#define LDK(F, Qv, i) do { F[0] = KFR(0, 2 * (i)); F[1] = KFR(1, 2 * (i)); F[2] = KFR(0, 2 * (i) + 1); F[3] = KFR(1, 2 * (i) + 1); Qv[0] = QFR(2 * (i)); Qv[1] = QFR(2 * (i) + 1); } while (0)
#define LDV(F, d) do { F[0] = VFR(d, 0); F[1] = VFR(d, 1); F[2] = VFR(d, 2); F[3] = VFR(d, 3); } while (0)
#define MMK(F, Qv) do { c0 = MFMA32(F[0], Qv[0], c0); c1 = MFMA32(F[1], Qv[0], c1); c0 = MFMA32(F[2], Qv[1], c0); c1 = MFMA32(F[3], Qv[1], c1); } while (0)
#define MMV(F, d) do { o[d] = MFMA32(F[0], pf[0][0], o[d]); o[d] = MFMA32(F[1], pf[0][1], o[d]); o[d] = MFMA32(F[2], pf[1][0], o[d]); o[d] = MFMA32(F[3], pf[1][1], o[d]); } while (0)
#define SB() __builtin_amdgcn_sched_barrier(0)
        LDK(fA, qA, 0); SB();
        LDK(fB, qB, 1); SB(); MMK(fA, qA); SB();
        LDK(fA, qA, 2); SB(); MMK(fB, qB); SB();
        LDK(fB, qB, 3); SB(); MMK(fA, qA); SB();
        LDV(fA, 0);     SB(); MMK(fB, qB); SB();
#undef QFR
#pragma unroll
        for (int p = 0; p < 2; ++p) {
            const int wbits = (int)((p ? mw.y : mw.x) >> (8 * hi));
            float f[16];
#pragma unroll
            for (int r = 0; r < 16; ++r) { const float e = __builtin_amdgcn_exp2f(p ? c1[r] : c0[r]); int mb;
                asm("v_bfe_i32 %0, %1, %2, 1" : "=v"(mb) : "v"(wbits), "n"(16 * (r >> 3) + (r & 7)));
                f[r] = __uint_as_float(__float_as_uint(e) & (unsigned)mb); psum += f[r]; }
            pf[p][0] = pack8(f); pf[p][1] = pack8(f + 8);
        }
        lrun += psum;
        SB();
        LDV(fB, 1); SB(); MMV(fA, 0); SB();
        LDV(fA, 2); SB(); MMV(fB, 1); SB();
        LDV(fB, 3); SB(); MMV(fA, 2); SB();
        MMV(fB, 3); SB();
#undef LDK
#undef LDV
#undef MMK
#undef MMV
#undef SB
#undef KFR
#undef VFR
        if (t + 1 < nt) ATT_STORE(cur ^ 1);
        __syncthreads();
    }
#undef ATT_LOAD
#undef ATT_STORE
    lrun = x32sum(lrun);
    const float inv = 1.0f / lrun;
    int ln2 = lane; asm volatile("" : "+v"(ln2));
    LAS unsigned char* stg = lds + wave * 8704;
#pragma unroll
    for (int d = 0; d < 4; ++d)
#pragma unroll
        for (int c4 = 0; c4 < 4; ++c4) {
            f32x4 v; v[0] = o[d][4 * c4] * inv; v[1] = o[d][4 * c4 + 1] * inv; v[2] = o[d][4 * c4 + 2] * inv; v[3] = o[d][4 * c4 + 3] * inv;
            stage_put(stg, ln2, 32 * d + 8 * c4 + 4 * (ln2 >> 5), v);
        }
    stage_flush(stg, ln2, OATT + ((size_t)b * SEQ + qs) * 4096 + hh * 128, 4096);
}

#define XB_TMO      128
#define XB_XCNT(j)  (256  + 64 * (j))
#define XB_XSUB(j)  (1280 + 64 * (j))
#define XB_XGEN(j)  (2304 + 64 * (j))
#define XB_TOP      3328
#define XB_TOPGEN   3392
#define XCD_BAR_WORDS 3456
#define XB_SPIN_CAP (1u << 18)

__device__ __forceinline__ unsigned xb_ld(unsigned* p)              { return __hip_atomic_load(p, __ATOMIC_RELAXED, __HIP_MEMORY_SCOPE_AGENT); }
__device__ __forceinline__ unsigned xb_add(unsigned* p, unsigned v) { return __hip_atomic_fetch_add(p, v, __ATOMIC_RELAXED, __HIP_MEMORY_SCOPE_AGENT); }
__device__ __forceinline__ unsigned xb_xcc_id() { return (unsigned)__builtin_amdgcn_s_getreg((3 << 11) | 20) & 0xFu; }
#define XB_SPIN(cond, bar) do { unsigned _sp = 0; while (cond) { __builtin_amdgcn_s_sleep(1); \
    if ((++_sp & 255u) == 0u) { if (xb_ld(&(bar)[XB_TMO])) break; if (_sp > XB_SPIN_CAP) { atomicAdd(&(bar)[XB_TMO], 1u); break; } } } } while (0)

struct XcdBarrier {
    unsigned* bar; unsigned x;
    volatile LAS unsigned* st;
};

__device__ __forceinline__ XcdBarrier xcd_barrier_post(unsigned* bar, volatile LAS unsigned* st) {
    XcdBarrier b; b.bar = bar; b.x = xb_xcc_id(); b.st = st;
    if (threadIdx.x == 0) (void)xb_add(&bar[XB_XCNT(b.x)], 1u);
    return b;
}
__device__ __forceinline__ void xcd_barrier_complete(unsigned* bar, unsigned x, unsigned& nloc, unsigned& nx) {
    const unsigned G = gridDim.x * gridDim.y * gridDim.z;
    unsigned sum, cnt, mine, sp = 0u;
    for (;;) {
        sum = 0u; cnt = 0u; mine = 0u;
#pragma unroll
        for (unsigned j = 0; j < 16; ++j) { const unsigned c = xb_ld(&bar[XB_XCNT(j)]); sum += c; cnt += (c > 0u) ? 1u : 0u; mine = (j == x) ? c : mine; }
        if (sum == G) break;
        __builtin_amdgcn_s_sleep(1);
        if ((++sp & 255u) == 0u) { if (xb_ld(&bar[XB_TMO])) break; if (sp > XB_SPIN_CAP) { atomicAdd(&bar[XB_TMO], 1u); break; } }
    }
    nloc = mine > 0u ? mine : 1u; nx = cnt > 0u ? cnt : 1u;
}

__device__ __forceinline__ void xcd_barrier(const XcdBarrier& b) {
    asm volatile("s_waitcnt vmcnt(0)" ::: "memory");
    __syncthreads();
    if (threadIdx.x == 0) {
        unsigned* bar = b.bar;
        __builtin_amdgcn_s_waitcnt(0);
        unsigned nloc = b.st[0], nx = b.st[1];
        if (nloc == 0u) { xcd_barrier_complete(bar, b.x, nloc, nx); b.st[0] = nloc; b.st[1] = nx; }
        const unsigned old = xb_add(&bar[XB_XSUB(b.x)], 1u);
        const unsigned gen = old / nloc;
        if (old + 1u == (gen + 1u) * nloc) {
            __builtin_amdgcn_fence(__ATOMIC_RELEASE, "agent");
            asm volatile("s_waitcnt vmcnt(0)" ::: "memory");
            const unsigned og = xb_add(&bar[XB_TOP], 1u);
            const unsigned tg = og / nx;
            if (og + 1u == (tg + 1u) * nx) xb_add(&bar[XB_TOPGEN], 1u);
            else XB_SPIN(xb_ld(&bar[XB_TOPGEN]) == tg, bar);
            __builtin_amdgcn_fence(__ATOMIC_ACQUIRE, "agent");
            xb_add(&bar[XB_XGEN(b.x)], 1u);
            asm volatile("s_waitcnt vmcnt(0)" ::: "memory");
        } else {
            XB_SPIN(xb_ld(&bar[XB_XGEN(b.x)]) == gen, bar);
            __builtin_amdgcn_fence(__ATOMIC_ACQUIRE, "agent");
            asm volatile("s_waitcnt vmcnt(0)" ::: "memory");
        }
    }
    __syncthreads();
}

constexpr int LDS_BYTES = 139264;
__global__ void __launch_bounds__(NTHR, 2) hybrid_fwd(Params P_unused) {
    extern __shared__ __attribute__((aligned(16))) unsigned char lds_raw[];
    cg::grid_group grid = cg::this_grid();
#define FRESH() LAS unsigned char* lds = (LAS unsigned char*)lds_raw; int tid = threadIdx.x; asm volatile("" : "+v"(tid)); const int lane = tid & 63, wave = __builtin_amdgcn_readfirstlane(tid >> 6); \
    int G = gridDim.x, bx = blockIdx.x; asm volatile("" : "+s"(G), "+s"(bx)); const int gw = bx * NWAVE + wave, NGW = G * NWAVE; CP pp = getP(); unsigned char* ws = pp->ws; \
    float* RSS = (float*)(ws + WS_RSS); bf16_t* XB = (bf16_t*)(ws + WS_XB); (void)lane; (void)gw; (void)NGW; (void)RSS; (void)XB; (void)lds;
    {
        FRESH();
        if (tid < 4) ((LAS unsigned*)(lds + LDS_BYTES - 16))[tid] = 0u;
        __syncthreads();
        (void)xcd_barrier_post((unsigned*)(ws + WS_BAR), (volatile LAS unsigned*)(lds + LDS_BYTES - 16));
#ifndef NO_PRO
        for (int rep = 0; rep < REP_PRO; ++rep) prologue(pp, lds, gw, NGW, wave, lane);
#endif
    }
    if (P_unused.out == nullptr) grid.sync();
#define GSYNC() do { LAS unsigned char* lds_ = (LAS unsigned char*)lds_raw; XcdBarrier xb_; xb_.bar = (unsigned*)(getP()->ws + WS_BAR); xb_.x = xb_xcc_id(); xb_.st = (volatile LAS unsigned*)(lds_ + LDS_BYTES - 16); xcd_barrier(xb_); } while (0)
    GSYNC();
#pragma unroll 1
    for (int l = 0; l < NL; ++l) {
        {
            FRESH();
            pg8::Gemm g{XB, (const bf16_t*)(ws + WS_WIN + l * 57 * MiB), NTOK, NMAIN, DM}; pg8::StaticOrder S; S.init(NTOK, NMAIN, G, bx);
            EpiIn E{RSS + (2 * l) * NTOK, ws};
#ifndef NO_G1
            pg8::gemm_phase<EpiIn, pg8::StaticOrder, GA_, GS_>(lds, g, S, E);
#endif
            for (int rb = bx; rb < NTOK / 32; rb += G) tail_block(ws, (const bf16_t*)(ws + WS_WIN + l * 57 * MiB) + (size_t)NMAIN * DM, RSS + (2 * l) * NTOK, lds, rb, wave, lane);
        }
        GSYNC();
        {
            FRESH();
            const bf16_t* KR = (const bf16_t*)(ws + WS_KRAW); bf16_t* KN = (bf16_t*)(ws + WS_KN); const float* kg = pp->kn_g + l * 128;
            for (int rep = 0; rep < REP_P2; ++rep) {
            for (int it = gw; it < NTOK * 4; it += NGW) {
                const int row = it >> 2, g4 = it & 3; const unsigned v = *(const unsigned*)(KR + (size_t)row * 512 + g4 * 128 + 2 * lane);
                const float a = bf2f(v & 0xffffu), c = bf2f(v >> 16); const float ss = wave_sum(a * a + c * c, lane); const float rs = rsqrtf(ss * (1.0f / 128.0f) + 1e-6f);
                *(unsigned*)(KN + ((size_t)((row >> 11) * 4 + g4) * SEQ + (row & 2047)) * 128 + 2 * lane) = pk2(a * rs * kg[2 * lane], c * rs * kg[2 * lane + 1]);
            }
            {
                const bool bal = (G == 256); const int i = bx & 127, q = i & 63, hb = i >> 6;
                if (bal) { if (bx < 128) rascan_unit(ws, bx, wave, lane); }
                else { for (int u = bx; u < 128; u += G) rascan_unit(ws, u, wave, lane); }
                const int ng = bal ? (bx < 128 ? 1 : 3) : 2 * ((255 - bx) / G + 1);
#pragma unroll 1
                for (int k = 0; k < ng; ++k) {
                    int gid;
                    if (bal) gid = (bx < 128) ? hb * 128 + 127 - q : (k == 0 ? (2 * hb) * 128 + q : (k == 1 ? (2 * hb + 1) * 128 + 63 - q : (2 + hb) * 128 + 64 + q));
                    else { const int kk2 = bx + (k >> 1) * G; gid = (k & 1) ? 511 - kk2 : kk2; }
                    indexer_group(ws, lds, gid, wave, lane);
                }
            }
            }
        }
        GSYNC();
        {
            FRESH();
            for (int rep = 0; rep < REP_P3; ++rep) {
#ifndef NO_ATT
            { const int vb = (G % 8 == 0) ? (bx % 8) * (G / 8) + bx / 8 : bx;
              for (int unit = vb; unit < 512; unit += G) attn_unit(ws, pp->qn_g, pp->kn_g, lds, unit, l, wave, lane); }
#endif
            { const float* gn_g = pp->gn_g; const float* gn_b = pp->gn_b;
              for (int unit = bx; unit < 512; unit += G) rc_unit(ws, gn_g, gn_b, lds, unit, l, wave, lane); }
            }
        }
        GSYNC();
        {
            FRESH();
            pg8::Gemm g{(const bf16_t*)(ws + WS_OATT), (const bf16_t*)(ws + WS_WUPA + l * 16 * MiB), NTOK, DM, 2 * DM}; pg8::StaticOrder S; S.init(NTOK, DM, G, bx);
            EpiGate E{(const bf16_t*)(ws + WS_SGA), (const bf16_t*)(ws + WS_SGB), (bf16_t*)(ws + WS_MERGED)};
#if !defined(NO_GO) && !defined(NO_GA)
            pg8::gemm_phase<EpiGate, pg8::StaticOrder, GA_, GS_>(lds, g, S, E);
#endif
        }
        GSYNC();
        {
            FRESH();
            pg8::Gemm g{(const bf16_t*)(ws + WS_MERGED), (const bf16_t*)(ws + WS_WOUT + l * 8 * MiB), NTOK, DM, DM}; pg8::StaticOrder S; S.init(NTOK, DM, G, bx);
            EpiRes E{l == 0 ? pp->x : (const float*)pp->out, pp->out, XB, RSS + (2 * l + 1) * NTOK};
#if !defined(NO_GO) && !defined(NO_GR)
            pg8::gemm_phase<EpiRes, pg8::StaticOrder, GA_, GS_>(lds, g, S, E);
#endif
        }
        GSYNC();
        {
            FRESH();
            pg8::Gemm g{XB, (const bf16_t*)(ws + WS_WFF1 + l * 32 * MiB), NTOK, DFF, DM}; pg8::StaticOrder S; S.init(NTOK, DFF, G, bx);
            EpiFF1 E{RSS + (2 * l + 1) * NTOK, (bf16_t*)(ws + WS_HFF)};
#if !defined(NO_GO) && !defined(NO_F1)
            pg8::gemm_phase<EpiFF1, pg8::StaticOrder, GA_, GS_>(lds, g, S, E);
#endif
        }
        GSYNC();
        {
            FRESH();
            pg8::Gemm g{(const bf16_t*)(ws + WS_HFF), (const bf16_t*)(ws + WS_WFF2 + l * 32 * MiB), NTOK, DM, DFF}; pg8::StaticOrder S; S.init(NTOK, DM, G, bx);
            EpiRes E{pp->out, pp->out, (l + 1 < NL) ? XB : nullptr, (l + 1 < NL) ? RSS + (2 * l + 2) * NTOK : nullptr};
#if !defined(NO_GO) && !defined(NO_GR)
            pg8::gemm_phase<EpiRes, pg8::StaticOrder, GA_, GS_>(lds, g, S, E);
#endif
        }
        if (l + 1 < NL) GSYNC();
    }
#undef FRESH
}
}

extern "C" void kernel_launch(void* const* d_in, const int* in_sizes, int n_in, void* d_out, int out_size, void* d_ws, size_t ws_size, hipStream_t stream) {
    static int grid = 0;
    if (grid == 0) {
        if (n_in != 13 || out_size != mk::NTOK * mk::DM || ws_size < mk::WS_END) { fprintf(stderr, "kernel_launch: unexpected shapes (n_in %d out %d ws %zu)\n", n_in, out_size, ws_size); grid = -1; return; }
        int dev = 0, cus = 0, per_cu = 0;
        hipGetDevice(&dev); hipDeviceGetAttribute(&cus, hipDeviceAttributeMultiprocessorCount, dev);
        if (hipFuncSetAttribute((const void*)mk::hybrid_fwd, hipFuncAttributeMaxDynamicSharedMemorySize, mk::LDS_BYTES) != hipSuccess) { fprintf(stderr, "kernel_launch: hipFuncSetAttribute failed\n"); grid = -1; return; }
        if (hipOccupancyMaxActiveBlocksPerMultiprocessor(&per_cu, (const void*)mk::hybrid_fwd, mk::NTHR, mk::LDS_BYTES) != hipSuccess || per_cu < 1) { fprintf(stderr, "kernel_launch: occupancy query gave %d\n", per_cu); per_cu = 1; }
        (void)hipGetLastError();
        grid = cus * 1;
        if (grid <= 0) grid = 256;
    }
    if (grid < 0) return;
    mk::Params p{};
    p.x = (const float*)d_in[0]; p.ln1_g = (const float*)d_in[1]; p.w_in = (const float*)d_in[2]; p.qn_g = (const float*)d_in[3]; p.kn_g = (const float*)d_in[4];
    p.gn_g = (const float*)d_in[5]; p.gn_b = (const float*)d_in[6]; p.w_upa = (const float*)d_in[7]; p.w_upr = (const float*)d_in[8]; p.w_out = (const float*)d_in[9];
    p.ln2_g = (const float*)d_in[10]; p.w_ff1 = (const float*)d_in[11]; p.w_ff2 = (const float*)d_in[12];
    p.out = (float*)d_out; p.ws = (unsigned char*)d_ws;
    (void)hipMemsetAsync((unsigned char*)d_ws + mk::WS_BAR, 0, XCD_BAR_WORDS * sizeof(unsigned), stream);
    void* args[] = {&p};
    hipError_t e = hipLaunchCooperativeKernel((const void*)mk::hybrid_fwd, dim3(grid), dim3(mk::NTHR), args, mk::LDS_BYTES, stream);
    if (e != hipSuccess) fprintf(stderr, "kernel_launch: cooperative launch failed: %s (grid %d)\n", hipGetErrorString(e), grid);
}
```

```cpp
#include <hip/hip_runtime.h>
#include <hip/hip_cooperative_groups.h>
#include <cstdio>
#include <cstdint>
#ifndef REP_PRO
#define REP_PRO 1
#endif
#ifndef REP_P2
#define REP_P2 1
#endif
#ifndef REP_P3
#define REP_P3 1
#endif
#ifndef REP_P4
#define REP_P4 1
#endif
#ifndef GA_
#define GA_ true
#define GS_ true
#endif
namespace cg = cooperative_groups;
namespace pg8 {
#define PG8_LAS __attribute__((address_space(3)))
typedef unsigned short bf16_t;
typedef short bf16x8 __attribute__((ext_vector_type(8)));
typedef float f32x4 __attribute__((ext_vector_type(4)));
typedef unsigned u32x4 __attribute__((ext_vector_type(4)));
constexpr int BM = 256, BK = 64, HALF = 128, HTB = HALF * BK * 2  , STAGE_BYTES = 8 * HTB, NXCD = 8, WGM = 4;

__host__ __device__ __forceinline__ int lds_byte(int r, int c) { const int st = (r >> 4) * 2 + (c >> 5), rr = r & 15, cc = c & 31, ob = rr * 64 + cc * 2; return st * 1024 + (ob ^ (((ob >> 9) & 1) << 5)); }
__host__ __device__ __forceinline__ void stage_rc(int b, int& R, int& C) { const int st = b / 1024, sb = b % 1024, swz = sb ^ (((sb >> 9) & 1) << 5); R = (st >> 1) * 16 + swz / 64; C = (st & 1) * 32 + (swz % 64) / 2; }
__host__ __device__ __forceinline__ int perm32(int rho) { const int n = rho >> 4, i = rho & 15; return 8 * (i >> 2) + 4 * n + (i & 3); }

struct Unit { int pm, pn; };
struct Gemm { const bf16_t* A; const bf16_t* Bt; int M, N, K; };

struct StaticOrder {
    int nM, nN, nwg, G, c;
    __host__ __device__ void init(int M, int N, int G_, int c_) { nM = M / BM; nN = N / BM; nwg = nM * nN; G = G_; c = c_; }
    __host__ __device__ bool next(int i, Unit& u) const {
        const long L = (long)i * G + c; if (L >= nwg) return false;
        int wgid = (int)L; { const int q = nwg / NXCD, r = nwg % NXCD, xcd = wgid % NXCD, off = wgid / NXCD; wgid = (xcd < r ? xcd * (q + 1) : r * (q + 1) + (xcd - r) * q) + off; }
        const int nig = WGM * nN, gid = wgid / nig, fm = gid * WGM, gsz = (nM - fm) < WGM ? (nM - fm) : WGM;
        u.pm = fm + ((wgid % nig) % gsz); u.pn = (wgid % nig) / gsz; return true;
    }
    __device__ __forceinline__ void a_ready(const Unit&) const {}
    __device__ __forceinline__ void done(const Unit&) const {}
};

__device__ __forceinline__ unsigned cvt_pk_bf16(float lo, float hi) { unsigned r; asm volatile("v_cvt_pk_bf16_f32 %0, %1, %2" : "=v"(r) : "v"(lo), "v"(hi)); return r; }
template <class Epi, class Sched, bool ALIGN_EPI = false, bool SP2 = false>
__device__ __forceinline__ void gemm_phase(PG8_LAS unsigned char* lds, const Gemm g, const Sched& S, const Epi& E) {
    int tid_ = threadIdx.x; asm volatile("" : "+v"(tid_)); const int tid = tid_, wid = __builtin_amdgcn_readfirstlane(tid >> 6), lane = tid & 63, wr = wid >> 2, wc = wid & 3, fr = lane & 15, fq = lane >> 4;
    const int K = g.K, nt = K / BK;
    unsigned voffA[2], voffB[2];
#pragma unroll
    for (int i = 0; i < 2; ++i) { int R, C; stage_rc(tid * 16 + i * 8192, R, C); const int Rb = Epi::PERM ? ((R & ~31) + perm32(R & 31)) : R;
        voffA[i] = (unsigned)(R * K + C) * 2u; voffB[i] = (unsigned)(Rb * K + C) * 2u; }
    const size_t kstep = (size_t)(BK * 2);
    const size_t hstep = (size_t)HALF * K * 2;
    const size_t tstep = 2 * hstep;
    const unsigned ldsw = (unsigned)wid * 1024u;
    const int aoff = lds_byte(wr * 64 + fr, fq * 8), boff = lds_byte(wc * 32 + fr, fq * 8);
#define PG8_SA(b, h) (((b) * 2 + (h)) * HTB)
#define PG8_SB(b, h) ((4 + (b) * 2 + (h)) * HTB)
#define PG8_STAGE(bufoff, gbase, voff) do { _Pragma("unroll") for (int _i = 0; _i < 2; ++_i) \
        __builtin_amdgcn_global_load_lds((const unsigned*)((const char*)(gbase) + (voff)[_i]), (PG8_LAS unsigned*)(lds + (bufoff) + ldsw + _i * 8192), 16, 0, 0); } while (0)
#define PG8_LDA(dst, b, h) do { _Pragma("unroll") for (int m = 0; m < 4; ++m) _Pragma("unroll") for (int k = 0; k < 2; ++k) dst[m][k] = *(const PG8_LAS bf16x8*)(lds + PG8_SA(b, h) + aoff + m * 2048 + k * 1024); } while (0)
#define PG8_LDB(dst, b, h) do { _Pragma("unroll") for (int n = 0; n < 2; ++n) _Pragma("unroll") for (int k = 0; k < 2; ++k) dst[n][k] = *(const PG8_LAS bf16x8*)(lds + PG8_SB(b, h) + boff + n * 2048 + k * 1024); } while (0)
#define PG8_MMA(ai, bj, At, Bt) do { __builtin_amdgcn_s_setprio(1); _Pragma("unroll") for (int m = 0; m < 4; ++m) _Pragma("unroll") for (int n = 0; n < 2; ++n) _Pragma("unroll") for (int k = 0; k < 2; ++k) \
        acc[ai][bj][m][n] = __builtin_amdgcn_mfma_f32_16x16x32_bf16(Bt[n][k], At[m][k], acc[ai][bj][m][n], 0, 0, 0); __builtin_amdgcn_s_setprio(0); } while (0)
#define PG8_WAIT_V(n) asm volatile("s_waitcnt vmcnt(" #n ")" ::: "memory")
#define PG8_WAIT_L(n) asm volatile("s_waitcnt lgkmcnt(" #n ")" ::: "memory")
#define PG8_BAR __builtin_amdgcn_s_barrier()
#define PG8_SCHED __builtin_amdgcn_sched_barrier(0)
    Unit cur, nxt; int ui = 0;
    if (!S.next(0, cur)) return;
    f32x4 acc[2][2][4][2];
#pragma unroll
    for (int a = 0; a < 2; ++a)
#pragma unroll
        for (int b = 0; b < 2; ++b)
#pragma unroll
            for (int m = 0; m < 4; ++m)
#pragma unroll
                for (int n = 0; n < 2; ++n) acc[a][b][m][n] = (f32x4){0.f, 0.f, 0.f, 0.f};
    bf16x8 At[4][2], B0[2][2], B1[2][2];
    const char* cA = (const char*)g.A + (size_t)cur.pm * tstep; const char* cB = (const char*)g.Bt + (size_t)cur.pn * tstep;
    S.a_ready(cur);
    if constexpr (SP2) {
        PG8_STAGE(PG8_SB(0, 0), cB, voffB); PG8_STAGE(PG8_SB(0, 1), cB + hstep, voffB); PG8_STAGE(PG8_SA(0, 0), cA, voffA); PG8_STAGE(PG8_SA(0, 1), cA + hstep, voffA);
        if (wr == 1) PG8_BAR;
        PG8_WAIT_V(2); PG8_BAR;
        PG8_STAGE(PG8_SB(1, 0), cB + kstep, voffB); PG8_STAGE(PG8_SA(1, 0), cA + kstep, voffA); PG8_STAGE(PG8_SB(1, 1), cB + hstep + kstep, voffB);
        PG8_WAIT_V(6); PG8_BAR;
    } else {
        PG8_STAGE(PG8_SB(0, 0), cB, voffB); PG8_STAGE(PG8_SA(0, 0), cA, voffA); PG8_STAGE(PG8_SB(0, 1), cB + hstep, voffB); PG8_STAGE(PG8_SA(0, 1), cA + hstep, voffA);
        if (wr == 1) PG8_BAR;
        PG8_WAIT_V(4); PG8_BAR;
        PG8_STAGE(PG8_SB(1, 0), cB + kstep, voffB); PG8_STAGE(PG8_SA(1, 0), cA + kstep, voffA); PG8_STAGE(PG8_SB(1, 1), cB + hstep + kstep, voffB);
        PG8_WAIT_V(6); PG8_BAR;
    }
    for (;;) {
        const bool has_next = S.next(ui + 1, nxt);
        const char* nA = has_next ? (const char*)g.A + (size_t)nxt.pm * tstep : cA; const char* nB = has_next ? (const char*)g.Bt + (size_t)nxt.pn * tstep : cB;
        for (int t = 0; t < nt; t += 2) {
            if constexpr (Epi::MID_HOOK) { if (t == (nt >> 1)) E.mid(acc, cur, wr, wc, fr, fq); }
            const bool last = (t == nt - 2);
            const char* a1 = cA + (size_t)(t + 1) * kstep;
            const char* a2 = last ? nA : cA + (size_t)(t + 2) * kstep; const char* b2 = last ? nB : cB + (size_t)(t + 2) * kstep;
            const char* a3 = a2 + kstep; const char* b3 = b2 + kstep;
            if (last && has_next) S.a_ready(nxt);
            if constexpr (SP2) {
            PG8_LDB(B0, 0, 0); PG8_LDB(B1, 0, 1); PG8_SCHED; PG8_LDA(At, 0, 0); PG8_STAGE(PG8_SA(1, 1), a1 + hstep, voffA);
            PG8_WAIT_V(8); PG8_WAIT_L(0); PG8_BAR; PG8_MMA(0, 0, At, B0); PG8_MMA(0, 1, At, B1); PG8_BAR; PG8_SCHED;
            PG8_LDA(At, 0, 1); PG8_STAGE(PG8_SB(0, 0), b2, voffB); PG8_STAGE(PG8_SB(0, 1), b2 + hstep, voffB); PG8_STAGE(PG8_SA(0, 0), a2, voffA);
            PG8_WAIT_V(8); PG8_WAIT_L(0); PG8_BAR; PG8_MMA(1, 0, At, B0); PG8_MMA(1, 1, At, B1); PG8_BAR; PG8_SCHED;
            PG8_LDB(B0, 1, 0); PG8_LDB(B1, 1, 1); PG8_SCHED; PG8_LDA(At, 1, 0); PG8_STAGE(PG8_SA(0, 1), a2 + hstep, voffA);
            PG8_WAIT_V(8); PG8_WAIT_L(0); PG8_BAR; PG8_MMA(0, 0, At, B0); PG8_MMA(0, 1, At, B1); PG8_BAR; PG8_SCHED;
            PG8_LDA(At, 1, 1); PG8_STAGE(PG8_SB(1, 0), b3, voffB); PG8_STAGE(PG8_SB(1, 1), b3 + hstep, voffB); PG8_STAGE(PG8_SA(1, 0), a3, voffA);
            PG8_WAIT_V(8); PG8_WAIT_L(0); PG8_BAR; PG8_MMA(1, 0, At, B0); PG8_MMA(1, 1, At, B1); PG8_BAR; PG8_SCHED;
            } else {
            PG8_LDB(B0, 0, 0); PG8_SCHED; PG8_LDA(At, 0, 0); PG8_STAGE(PG8_SA(1, 1), a1 + hstep, voffA);
            PG8_WAIT_L(8); PG8_BAR; PG8_WAIT_L(0); PG8_MMA(0, 0, At, B0); PG8_BAR; PG8_SCHED;
            PG8_LDB(B1, 0, 1); PG8_STAGE(PG8_SB(0, 0), b2, voffB);
            PG8_BAR; PG8_WAIT_L(0); PG8_MMA(0, 1, At, B1); PG8_BAR;
            PG8_LDA(At, 0, 1); PG8_STAGE(PG8_SA(0, 0), a2, voffA);
            PG8_BAR; PG8_WAIT_L(0); PG8_MMA(1, 0, At, B0); PG8_BAR; PG8_SCHED;
            PG8_STAGE(PG8_SB(0, 1), b2 + hstep, voffB);
            PG8_WAIT_V(6); PG8_BAR; PG8_MMA(1, 1, At, B1); PG8_BAR;
            PG8_LDB(B0, 1, 0); PG8_SCHED; PG8_LDA(At, 1, 0); PG8_STAGE(PG8_SA(0, 1), a2 + hstep, voffA);
            PG8_WAIT_L(8); PG8_BAR; PG8_WAIT_L(0); PG8_MMA(0, 0, At, B0); PG8_BAR; PG8_SCHED;
            PG8_LDB(B1, 1, 1); PG8_STAGE(PG8_SB(1, 0), b3, voffB);
            PG8_BAR; PG8_WAIT_L(0); PG8_MMA(0, 1, At, B1); PG8_BAR;
            PG8_LDA(At, 1, 1); PG8_STAGE(PG8_SA(1, 0), a3, voffA);
            PG8_BAR; PG8_WAIT_L(0); PG8_MMA(1, 0, At, B0); PG8_BAR; PG8_SCHED;
            PG8_STAGE(PG8_SB(1, 1), b3 + hstep, voffB);
            PG8_WAIT_V(6); PG8_BAR; PG8_MMA(1, 1, At, B1); PG8_BAR;
            }
        }
        if constexpr (ALIGN_EPI) { if (wr == 0) PG8_BAR; }
        if constexpr (!Epi::AFTER_DRAIN) { E(acc, cur, wr, wc, fr, fq); S.done(cur); }
        if (!has_next) break;
#pragma unroll
        for (int a = 0; a < 2; ++a)
#pragma unroll
            for (int b = 0; b < 2; ++b)
#pragma unroll
                for (int m = 0; m < 4; ++m)
#pragma unroll
                    for (int n = 0; n < 2; ++n) acc[a][b][m][n] = (f32x4){0.f, 0.f, 0.f, 0.f};
        cur = nxt; cA = nA; cB = nB; ++ui;
        if constexpr (ALIGN_EPI) { if (wr == 1) PG8_BAR; }
    }
    PG8_WAIT_V(0);
    if constexpr (!ALIGN_EPI) { if (wr == 0) PG8_BAR; }
    PG8_BAR;
    if constexpr (Epi::AFTER_DRAIN) { E.fused(acc, cur, wr, wc, fr, fq, lds, wid, lane); S.done(cur); }
#undef PG8_SA
#undef PG8_SB
#undef PG8_STAGE
#undef PG8_LDA
#undef PG8_LDB
#undef PG8_MMA
#undef PG8_WAIT_V
#undef PG8_WAIT_L
#undef PG8_BAR
#undef PG8_SCHED
}
}

namespace mk {
using pg8::bf16_t; using pg8::bf16x8; using pg8::f32x4; using pg8::u32x4; using pg8::Unit;
typedef float f32x16 __attribute__((ext_vector_type(16)));
typedef unsigned u32x2 __attribute__((ext_vector_type(2)));
#define LAS __attribute__((address_space(3)))

constexpr int NB = 4, SEQ = 2048, DM = 2048, NTOK = NB * SEQ, NL = 2, DIN = 14416, NPAD = 14592, DFF = 8192;
constexpr int NTHR = 512, NWAVE = 8, NMAIN = 14336;
constexpr size_t MiB = 1u << 20;
constexpr size_t WS_WIN = 0;
constexpr size_t WS_WUPA = 114 * MiB;
constexpr size_t WS_WUPR = 130 * MiB;
constexpr size_t WS_WOUT = 146 * MiB;
constexpr size_t WS_WFF1 = 162 * MiB;
constexpr size_t WS_WFF2 = 226 * MiB;
constexpr size_t WS_XB = 290 * MiB;
constexpr size_t WS_PROJ = 322 * MiB;
constexpr size_t WS_Q = WS_PROJ, WS_KRAW = WS_Q + 32 * MiB, WS_KN = WS_KRAW + 8 * MiB, WS_VT = WS_KN + 8 * MiB, WS_IQ = WS_VT + 8 * MiB,
                 WS_RQ = WS_IQ + 16 * MiB, WS_RK = WS_RQ + 16 * MiB, WS_RKT = WS_RK + 16 * MiB, WS_RVT = WS_RKT + 16 * MiB, WS_SRG = WS_RVT + 32 * MiB,
                 WS_SGA = WS_SRG + 32 * MiB, WS_SGB = WS_SGA + 32 * MiB, WS_IK = WS_SGB + 32 * MiB, WS_IW = WS_IK + 1 * MiB;
constexpr size_t WS_HFF = WS_PROJ;
constexpr size_t WS_MASK = 572 * MiB;
constexpr size_t WS_U = 574 * MiB;
constexpr size_t WS_MBUF = WS_U;
constexpr size_t WS_RP = 638 * MiB;
constexpr size_t WS_OATT = 670 * MiB;
constexpr size_t WS_ORET = 702 * MiB;
constexpr size_t WS_MERGED = 734 * MiB;
constexpr size_t WS_ROPE = 766 * MiB;
constexpr size_t WS_RSS = 767 * MiB;
constexpr size_t WS_BAR = 767 * MiB + 512 * 1024;
constexpr size_t WS_END = 768 * MiB;
static_assert(WS_IW + 1 * MiB <= WS_MASK, "proj region");

struct Params {
    const float* x; const float* ln1_g; const float* w_in; const float* qn_g; const float* kn_g; const float* gn_g; const float* gn_b;
    const float* w_upa; const float* w_upr; const float* w_out; const float* ln2_g; const float* w_ff1; const float* w_ff2;
    float* out; unsigned char* ws;
};

typedef const __attribute__((address_space(4))) Params* CP;
__device__ __forceinline__ CP getP() { auto k = __builtin_amdgcn_kernarg_segment_ptr(); asm volatile("" : "+s"(k)); return (CP)k; }
__device__ __forceinline__ float bf2f(unsigned h) { return __uint_as_float(h << 16); }
__device__ __forceinline__ unsigned pk2(float lo, float hi) { return pg8::cvt_pk_bf16(lo, hi); }
__device__ __forceinline__ void st4bf(bf16_t* p, f32x4 v) { *(u32x2*)p = (u32x2){pk2(v[0], v[1]), pk2(v[2], v[3])}; }
__device__ __forceinline__ float shx(float v, int o, int lane) { return __int_as_float(__builtin_amdgcn_ds_bpermute((lane ^ o) << 2, __float_as_int(v))); }
__device__ __forceinline__ int shxi(int v, int o, int lane) { return __builtin_amdgcn_ds_bpermute((lane ^ o) << 2, v); }
__device__ __forceinline__ float x32sum(float v) { auto rr = __builtin_amdgcn_permlane32_swap(__float_as_uint(v), __float_as_uint(v), false, false); return __uint_as_float(rr[0]) + __uint_as_float(rr[1]); }
__device__ __forceinline__ float wave_sum(float v, int lane) {
#pragma unroll
    for (int o = 1; o < 32; o <<= 1) v += shx(v, o, lane);
    return x32sum(v);
}
__device__ __forceinline__ int crow(int r, int hi) { return (r & 3) + 8 * (r >> 2) + 4 * hi; }
__device__ __forceinline__ int kperm(int m) { const int a = m & 3, h1 = (m >> 2) & 1, c = m >> 3; return 16 * (c >> 1) + 8 * h1 + 4 * (c & 1) + a; }
#define MFMA32(a, b, c) __builtin_amdgcn_mfma_f32_32x32x16_bf16((a), (b), (c), 0, 0, 0)
__device__ __forceinline__ bf16x8 pack8(const float* f) { u32x4 w; w.x = pk2(f[0], f[1]); w.y = pk2(f[2], f[3]); w.z = pk2(f[4], f[5]); w.w = pk2(f[6], f[7]); return __builtin_bit_cast(bf16x8, w); }

struct MapIdent { __device__ __forceinline__ int operator()(int n) const { return n; } };
struct MapWin {
    __device__ __forceinline__ int operator()(int n) const {
        if (n < 4096) return n;
        if (n < 6144) { const int t = n - 4096, which = t >> 10, tt = t & 1023, h = tt >> 7, lc = tt & 127; return (which ? 5200 : 4176) + h * 128 + (lc >> 1) + 64 * (lc & 1); }
        if (n < 8192) return 6224 + (n - 6144);
        if (n < 10240) return 8272 + (n - 8192);
        if (n < 12288) return 10320 + (n - 10240);
        if (n < 14336) return 12368 + (n - 12288);
        if (n < 14416) return 4096 + (n - 14336);
        return -1;
    }
};
__device__ __forceinline__ void transpose64(const float* __restrict__ W, int K, int N, bf16_t* WT, const float* __restrict__ gk, int k0, int c0, int ncols, int d0, int ds, LAS float* scr, int lane, int ldk = 0, int fragn0 = -1) {
    if (ldk == 0) ldk = K;
    const int lr = lane >> 4, lc4 = (lane & 15) * 4;
    f32x4 v[16];
#pragma unroll
    for (int i = 0; i < 16; ++i) { const int kk = 4 * i + lr; v[i] = (lc4 < ncols) ? __builtin_nontemporal_load((const f32x4*)(W + (size_t)(k0 + kk) * N + c0 + lc4)) : (f32x4){0.f, 0.f, 0.f, 0.f}; }
#pragma unroll
    for (int i = 0; i < 16; ++i) { const int kk = 4 * i + lr; const float g = gk ? gk[k0 + kk] : 1.0f; LAS float* d = scr + kk * 65 + lc4; d[0] = v[i][0] * g; d[1] = v[i][1] * g; d[2] = v[i][2] * g; d[3] = v[i][3] * g; }
    asm volatile("s_waitcnt lgkmcnt(0)" ::: "memory");
    const int c = lane & 7;
#pragma unroll
    for (int j = 0; j < 8; ++j) { const int n = (lane >> 3) + 8 * j; const LAS float* sp = scr + (8 * c) * 65 + n;
        u32x4 o; o.x = pk2(sp[0 * 65], sp[1 * 65]); o.y = pk2(sp[2 * 65], sp[3 * 65]); o.z = pk2(sp[4 * 65], sp[5 * 65]); o.w = pk2(sp[6 * 65], sp[7 * 65]);
        if (fragn0 < 0) { if (n < ncols) *(u32x4*)(WT + (size_t)(d0 + ds * n) * ldk + k0 + 8 * c) = o; }
        else if (n < 32) { const int nn = fragn0 + n, kq = k0 + 8 * c; if (n >= ncols) o = (u32x4){0u, 0u, 0u, 0u};
            *(u32x4*)(WT + ((size_t)(((nn >> 5) * (K >> 4) + (kq >> 4)) * 2 + ((kq >> 3) & 1)) * 32 + (nn & 31)) * 8) = o; } }
    asm volatile("s_waitcnt lgkmcnt(0)" ::: "memory");
}

__device__ __forceinline__ void prologue(CP pp, LAS unsigned char* lds, int gw, int NGW, int wave, int lane) {
    Params P; P.x = pp->x; P.ln1_g = pp->ln1_g; P.w_in = pp->w_in; P.w_upa = pp->w_upa; P.w_upr = pp->w_upr; P.w_out = pp->w_out; P.ln2_g = pp->ln2_g; P.w_ff1 = pp->w_ff1; P.w_ff2 = pp->w_ff2; P.ws = pp->ws; unsigned char* ws = P.ws;
    LAS float* scr = (LAS float*)(lds + wave * 16640);
    constexpr int T_IN = 226, I_IN = 32 * T_IN, I_SQ = 32 * 32, I_F1 = 32 * 128, I_F2 = 128 * 32, I_L = I_IN + 3 * I_SQ + I_F1 + I_F2;
    for (int it = gw; it < NL * I_L; it += NGW) {
        const int itr = NL * I_L - 1 - it;
        const int l = itr / I_L; int r = itr % I_L;
        if (r < I_IN) {
            const int kb = r / T_IN, t = r % T_IN; int c0, d0, ds = 1, nc = 64;
            if (t < 64) { c0 = 64 * t; d0 = c0; }
            else if (t == 64 || t == 65) {
                bf16_t* wt = (bf16_t*)(ws + WS_WIN + l * 57 * MiB) + (size_t)NMAIN * DM;
                transpose64(P.w_in + (size_t)l * DM * DIN, DM, DIN, wt, P.ln1_g + l * DM, 64 * kb, t == 64 ? 4096 : 4160, t == 64 ? 64 : 16, 0, 1, scr, lane, 0, t == 64 ? 0 : 64);
                if (t == 64) transpose64(P.w_in + (size_t)l * DM * DIN, DM, DIN, wt, P.ln1_g + l * DM, 64 * kb, 4096 + 32, 32, 0, 1, scr, lane, 0, 32);
                continue; }
            else if (t < 98) { const int q = t - 66, which = q >> 4, rr = q & 15, h = rr >> 1, half = rr & 1; c0 = (which ? 5200 : 4176) + h * 128 + 64 * half; d0 = (which ? 5120 : 4096) + h * 128 + half; ds = 2; }
            else { const int q = t - 98; c0 = 6224 + 64 * q; d0 = 6144 + 64 * q; }
            transpose64(P.w_in + (size_t)l * DM * DIN, DM, DIN, (bf16_t*)(ws + WS_WIN + l * 57 * MiB), P.ln1_g + l * DM, 64 * kb, c0, nc, d0, ds, scr, lane); continue; }
        r -= I_IN;
        if (r < 3 * I_SQ) { const int w = r / I_SQ, q = r % I_SQ, kb = q >> 5, t = q & 31; const float* src = (w == 0 ? P.w_upa : (w == 1 ? P.w_upr : P.w_out)) + (size_t)l * DM * DM;
            bf16_t* dst = (w == 2) ? (bf16_t*)(ws + WS_WOUT + l * 8 * MiB) : (bf16_t*)(ws + WS_WUPA + l * 16 * MiB) + (w == 1 ? DM : 0);
            transpose64(src, DM, DM, dst, nullptr, 64 * kb, 64 * t, 64, 64 * t, 1, scr, lane, (w == 2) ? DM : 2 * DM); continue; }
        r -= 3 * I_SQ;
        if (r < I_F1) { const int kb = r >> 7, t = r & 127; transpose64(P.w_ff1 + (size_t)l * DM * DFF, DM, DFF, (bf16_t*)(ws + WS_WFF1 + l * 32 * MiB), P.ln2_g + l * DM, 64 * kb, 64 * t, 64, 64 * t, 1, scr, lane); continue; }
        r -= I_F1;
        { const int kb = r >> 5, t = r & 31; transpose64(P.w_ff2 + (size_t)l * DFF * DM, DFF, DM, (bf16_t*)(ws + WS_WFF2 + l * 32 * MiB), nullptr, 64 * kb, 64 * t, 64, 64 * t, 1, scr, lane); }
    }
    bf16_t* XB = (bf16_t*)(ws + WS_XB); float* RSS = (float*)(ws + WS_RSS);
    for (int m = gw; m < NTOK; m += NGW) {
        const f32x4* xr = (const f32x4*)(P.x + (size_t)m * DM) + lane; float ss = 0.f;
#pragma unroll
        for (int j = 0; j < 8; ++j) { const f32x4 v = xr[64 * j]; ss += (v[0] * v[0] + v[1] * v[1]) + (v[2] * v[2] + v[3] * v[3]); st4bf(XB + (size_t)m * DM + 4 * lane + 256 * j, v); }
        ss = wave_sum(ss, lane);
        if (lane == 0) RSS[m] = ss;
    }
    for (int i = gw * 64 + lane; i < 3 * NTOK; i += NGW * 64) RSS[NTOK + i] = 0.f;
    float* rope = (float*)(ws + WS_ROPE);
    for (int i = gw * 64 + lane; i < SEQ * 64; i += NGW * 64) {
        const int pos = i >> 6, fi = i & 63;
        const float invf = (float)exp(-(double)fi * (9.210340371976184 / 64.0));
        const float angf = (float)pos * invf;
        const double a = (double)angf; const double k = rint(a * 0.15915494309189535); const double r = a - k * 6.283185307179586477;
        const double r2 = r * r; double ts = r, ss = r, tc = 1.0, cc = 1.0;
#pragma unroll
        for (int n = 1; n <= 14; ++n) { ts *= -r2 * (1.0 / (double)((2 * n) * (2 * n + 1))); ss += ts; tc *= -r2 * (1.0 / (double)((2 * n - 1) * (2 * n))); cc += tc; }
        rope[2 * i] = (float)cc; rope[2 * i + 1] = (float)ss;
    }
}

#define EPI_ROWS(...) _Pragma("unroll") for (int ai = 0; ai < 2; ++ai) _Pragma("unroll") for (int m = 0; m < 4; ++m) { int row_ = u.pm * 256 + ai * 128 + wr * 64 + m * 16 + fr; asm volatile("" : "+v"(row_) :: "memory"); const int row = row_; __VA_ARGS__ }
#define EPI_COLS8(...) _Pragma("unroll") for (int bj = 0; bj < 2; ++bj) { const int lc = bj * 128 + wc * 32 + 8 * fq; const f32x4 a0 = acc[ai][bj][m][0], a1 = acc[ai][bj][m][1]; __VA_ARGS__ }

__device__ __forceinline__ float sigm(float x) { return __builtin_amdgcn_rcpf(1.0f + __builtin_amdgcn_exp2f(-1.4426950408889634f * x)); }
__device__ __forceinline__ f32x4 sigm4(f32x4 v) { return (f32x4){sigm(v[0]), sigm(v[1]), sigm(v[2]), sigm(v[3])}; }
__device__ __forceinline__ void st8bf(bf16_t* p, f32x4 v0, f32x4 v1) { *(u32x4*)p = (u32x4){pk2(v0[0], v0[1]), pk2(v0[2], v0[3]), pk2(v1[0], v1[1]), pk2(v1[2], v1[3])}; }
__device__ __forceinline__ void st8col(bf16_t* d, int stride, f32x4 v0, f32x4 v1) {
    d[0] = (bf16_t)pk2(v0[0], 0.f); d[stride] = (bf16_t)pk2(v0[1], 0.f); d[2 * stride] = (bf16_t)pk2(v0[2], 0.f); d[3 * stride] = (bf16_t)pk2(v0[3], 0.f);
    d[4 * stride] = (bf16_t)pk2(v1[0], 0.f); d[5 * stride] = (bf16_t)pk2(v1[1], 0.f); d[6 * stride] = (bf16_t)pk2(v1[2], 0.f); d[7 * stride] = (bf16_t)pk2(v1[3], 0.f);
}
__device__ __forceinline__ f32x4 bflo4(u32x4 w) { return (f32x4){bf2f(w.x & 0xffffu), bf2f(w.x >> 16), bf2f(w.y & 0xffffu), bf2f(w.y >> 16)}; }
__device__ __forceinline__ f32x4 bfhi4(u32x4 w) { return (f32x4){bf2f(w.z & 0xffffu), bf2f(w.z >> 16), bf2f(w.w & 0xffffu), bf2f(w.w >> 16)}; }

struct EpiIn {
    static constexpr bool PERM = true, AFTER_DRAIN = false, MID_HOOK = false;
    const float* rss; unsigned char* ws;
    __device__ __forceinline__ void operator()(const f32x4 (&acc)[2][2][4][2], const Unit& u, int wr, int wc, int fr, int fq) const {
        asm volatile("" : "+v"(fr), "+v"(fq));
        const int pn = u.pn;
        bf16_t* Q = (bf16_t*)(ws + WS_Q); bf16_t* KR = (bf16_t*)(ws + WS_KRAW); bf16_t* VT = (bf16_t*)(ws + WS_VT); bf16_t* IQ = (bf16_t*)(ws + WS_IQ);
        bf16_t* RQ = (bf16_t*)(ws + WS_RQ); bf16_t* RK = (bf16_t*)(ws + WS_RK); bf16_t* RKT = (bf16_t*)(ws + WS_RKT); bf16_t* RVT = (bf16_t*)(ws + WS_RVT);
        bf16_t* SRG = (bf16_t*)(ws + WS_SRG); bf16_t* SGA = (bf16_t*)(ws + WS_SGA); bf16_t* SGB = (bf16_t*)(ws + WS_SGB);
        const float* rope = (const float*)(ws + WS_ROPE);
#define RS const float rs = __builtin_amdgcn_rsqf(rss[row] * (1.0f / 2048.0f) + 1e-6f);
        if (pn < 8) { EPI_ROWS(RS EPI_COLS8(st8bf(Q + (size_t)row * 2048 + pn * 256 + lc, a0 * rs, a1 * rs);)) }
        else if (pn < 10) { EPI_ROWS(RS EPI_COLS8(st8bf(KR + (size_t)row * 512 + (pn - 8) * 256 + lc, a0 * rs, a1 * rs);)) }
        else if (pn < 12) { EPI_ROWS(RS const int b = row >> 11, s = row & 2047; EPI_COLS8(const int c = (pn - 10) * 256 + lc;
                st8col(VT + ((((size_t)(b * 4 + (c >> 7)) * 32 + (s >> 6)) * 128 + (c & 127)) * 64 + (s & 63)), 64, a0 * rs, a1 * rs);)) }
        else if (pn < 16) { EPI_ROWS(RS EPI_COLS8(st8bf(IQ + (size_t)row * 1024 + (pn - 12) * 256 + lc, a0 * rs, a1 * rs);)) }
        else if (pn < 24) { const bool isk = pn >= 20; const int cb = (pn - (isk ? 20 : 16)) * 256; const float scl = isk ? 0.08838834764831845f : 1.0f;
            EPI_ROWS(RS const int b = row >> 11, s = row & 2047; EPI_COLS8(const f32x4 v0 = a0 * (rs * scl), v1 = a1 * (rs * scl);
                const float* rp = rope + ((size_t)s * 64 + ((lc & 127) >> 1)) * 2; const f32x4 cA = *(const f32x4*)rp, cB = *(const f32x4*)(rp + 4);
                f32x4 o0, o1; o0[0] = v0[0] * cA[0] - v0[1] * cA[1]; o0[1] = v0[1] * cA[0] + v0[0] * cA[1]; o0[2] = v0[2] * cA[2] - v0[3] * cA[3]; o0[3] = v0[3] * cA[2] + v0[2] * cA[3];
                o1[0] = v1[0] * cB[0] - v1[1] * cB[1]; o1[1] = v1[1] * cB[0] + v1[0] * cB[1]; o1[2] = v1[2] * cB[2] - v1[3] * cB[3]; o1[3] = v1[3] * cB[2] + v1[2] * cB[3];
                const int c = cb + lc, dd = c & 127, ii = s & 127;
                const size_t ub = ((size_t)(b * 8 + (c >> 7)) * 16 + (s >> 7)) * 16384;
                const size_t fo = ub + (ii >> 5) * 4096 + (((dd >> 4) * 2 + ((dd >> 3) & 1)) * 32 + (ii & 31)) * 8;
                if (!isk) st8bf(RQ + fo, o0, o1);
                else { st8bf(RK + fo, o0, o1); st8col(RKT + ub + (dd >> 5) * 4096 + (((ii >> 4) * 2 + ((ii >> 3) & 1)) * 32 + (dd & 31)) * 8 + (ii & 7), 8, o0, o1); })) }
        else if (pn < 32) { EPI_ROWS(RS const int b = row >> 11, s = row & 2047; EPI_COLS8(const int c = (pn - 24) * 256 + lc, ee = c & 255, ii = s & 127;
                st8col(RVT + ((size_t)(b * 8 + (c >> 8)) * 16 + (s >> 7)) * 32768 + (ee >> 5) * 4096 + (((ii >> 4) * 2 + ((ii >> 3) & 1)) * 32 + (ee & 31)) * 8 + (ii & 7), 8, a0 * rs, a1 * rs);)) }
        else if (pn < 40) { EPI_ROWS(RS const int b = row >> 11, s = row & 2047; EPI_COLS8(f32x4 v0 = a0 * rs, v1 = a1 * rs; v0 = v0 * sigm4(v0); v1 = v1 * sigm4(v1);
                const int c = (pn - 32) * 256 + lc, e = c & 255, i = s & 127;
                bf16_t* d = SRG + ((size_t)(b * 8 + (c >> 8)) * 16 + (s >> 7)) * 32768 + (i >> 5) * 8192 + (e >> 7) * 4096 + ((e >> 3) & 15) * 256 + (i & 31) * 4;
                st4bf(d, v0); st4bf(d + 128, v1);)) }
        else { bf16_t* G = (pn < 48) ? SGA : SGB; const int cb = (pn - (pn < 48 ? 40 : 48)) * 256;
            EPI_ROWS(RS EPI_COLS8(st8bf(G + (size_t)row * 2048 + cb + lc, sigm4(a0 * rs), sigm4(a1 * rs));)) }
#undef RS
    }
};
struct EpiGate {
    static constexpr bool PERM = true, AFTER_DRAIN = false, MID_HOOK = true;
    const bf16_t* GA; const bf16_t* GB; bf16_t* merged;
    __device__ __forceinline__ void mid(f32x4 (&acc)[2][2][4][2], const Unit& u, int wr, int wc, int fr, int fq) const {
        asm volatile("s_waitcnt vmcnt(0)" : "+v"(fr), "+v"(fq) :: "memory");
        EPI_ROWS(_Pragma("unroll") for (int bj = 0; bj < 2; ++bj) { const int lc = bj * 128 + wc * 32 + 8 * fq; const size_t off = (size_t)row * 2048 + u.pn * 256 + lc;
            const u32x4 ga = *(const u32x4*)(GA + off); const u32x4 gb = *(const u32x4*)(GB + off);
            const f32x4 gb0 = bflo4(gb), gb1 = bfhi4(gb); f32x4 r0 = bflo4(ga), r1 = bfhi4(ga);
            _Pragma("unroll") for (int k = 0; k < 4; ++k) { r0[k] *= __builtin_amdgcn_rcpf(fmaxf(gb0[k], 1e-30f)); r1[k] *= __builtin_amdgcn_rcpf(fmaxf(gb1[k], 1e-30f)); }
            acc[ai][bj][m][0] = acc[ai][bj][m][0] * r0; acc[ai][bj][m][1] = acc[ai][bj][m][1] * r1; })
        asm volatile("s_waitcnt vmcnt(0)" ::: "memory");
    }
    __device__ __forceinline__ void operator()(const f32x4 (&acc)[2][2][4][2], const Unit& u, int wr, int wc, int fr, int fq) const {
        asm volatile("" : "+v"(fr), "+v"(fq));
        EPI_ROWS(EPI_COLS8(const size_t off = (size_t)row * 2048 + u.pn * 256 + lc; const u32x4 g = *(const u32x4*)(GB + off); st8bf(merged + off, a0 * bflo4(g), a1 * bfhi4(g));))
    }
};
struct EpiRes {
    static constexpr bool PERM = true, AFTER_DRAIN = false, MID_HOOK = false;
    const float* xin; float* xout; bf16_t* xb; float* rss;
    __device__ __forceinline__ void operator()(const f32x4 (&acc)[2][2][4][2], const Unit& u, int wr, int wc, int fr, int fq) const {
        asm volatile("" : "+v"(fr), "+v"(fq));
        EPI_ROWS(float ss = 0.f; EPI_COLS8(const size_t off = (size_t)row * 2048 + u.pn * 256 + lc; const f32x4 o0 = *(const f32x4*)(xin + off) + a0, o1 = *(const f32x4*)(xin + off + 4) + a1;
                *(f32x4*)(xout + off) = o0; *(f32x4*)(xout + off + 4) = o1; if (xb) st8bf(xb + off, o0, o1);
                ss += ((o0[0] * o0[0] + o0[1] * o0[1]) + (o0[2] * o0[2] + o0[3] * o0[3])) + ((o1[0] * o1[0] + o1[1] * o1[1]) + (o1[2] * o1[2] + o1[3] * o1[3]));)
            if (rss) { ss += shx(ss, 16, fr + 16 * fq); ss = x32sum(ss); if (fq == 0) atomicAdd(rss + row, ss); })
    }
};
struct EpiFF1 {
    static constexpr bool PERM = true, AFTER_DRAIN = false, MID_HOOK = false;
    const float* rss; bf16_t* H;
    __device__ __forceinline__ void operator()(const f32x4 (&acc)[2][2][4][2], const Unit& u, int wr, int wc, int fr, int fq) const {
        asm volatile("" : "+v"(fr), "+v"(fq));
        EPI_ROWS(const float rs = __builtin_amdgcn_rsqf(rss[row] * (1.0f / 2048.0f) + 1e-6f); EPI_COLS8(f32x4 v0 = a0 * rs, v1 = a1 * rs;
            v0[0] = fmaxf(v0[0], 0.f); v0[1] = fmaxf(v0[1], 0.f); v0[2] = fmaxf(v0[2], 0.f); v0[3] = fmaxf(v0[3], 0.f); v1[0] = fmaxf(v1[0], 0.f); v1[1] = fmaxf(v1[1], 0.f); v1[2] = fmaxf(v1[2], 0.f); v1[3] = fmaxf(v1[3], 0.f);
            st8bf(H + (size_t)row * DFF + u.pn * 256 + lc, v0 * v0, v1 * v1);))
    }
};

__device__ __forceinline__ void tail_block(unsigned char* ws, const bf16_t* Wt, const float* rss, LAS unsigned char* lds, int rb, int wave, int lane) {
    const bf16_t* XB = (const bf16_t*)(ws + WS_XB); bf16_t* IK = (bf16_t*)(ws + WS_IK); float* IW = (float*)(ws + WS_IW);
    const int hi = lane >> 5, l32 = lane & 31, tid = wave * 64 + lane;
    const bf16_t* ap = XB + (size_t)(32 * rb + l32) * 2048 + 256 * wave + 8 * hi;
    const bf16_t* bp = Wt + (size_t)(16 * wave) * 512 + lane * 8;
    f32x16 acc[3];
#pragma unroll
    for (int nb = 0; nb < 3; ++nb) acc[nb] = (f32x16){0.f, 0.f, 0.f, 0.f, 0.f, 0.f, 0.f, 0.f, 0.f, 0.f, 0.f, 0.f, 0.f, 0.f, 0.f, 0.f};
#pragma unroll
    for (int kb = 0; kb < 4; ++kb) {
        bf16x8 af[4], bfr[3][4];
#pragma unroll
        for (int k4 = 0; k4 < 4; ++k4) { af[k4] = *(const bf16x8*)(ap + 16 * (4 * kb + k4));
#pragma unroll
            for (int nb = 0; nb < 3; ++nb) bfr[nb][k4] = *(const bf16x8*)(bp + (size_t)(nb * 128 + 4 * kb + k4) * 512); }
        __builtin_amdgcn_sched_barrier(0);
#pragma unroll
        for (int k4 = 0; k4 < 4; ++k4)
#pragma unroll
            for (int nb = 0; nb < 3; ++nb) acc[nb] = MFMA32(af[k4], bfr[nb][k4], acc[nb]);
        __builtin_amdgcn_sched_barrier(0);
    }
    LAS float* part = (LAS float*)lds;
#pragma unroll
    for (int nb = 0; nb < 3; ++nb)
#pragma unroll
        for (int r = 0; r < 16; ++r) part[wave * 3072 + crow(r, hi) * 96 + 32 * nb + l32] = acc[nb][r];
    __syncthreads();
#pragma unroll
    for (int i = 0; i < 6; ++i) {
        const int idx = tid + 512 * i, row = idx / 96, col = idx % 96;
        float v = 0.f;
#pragma unroll
        for (int w = 0; w < 8; ++w) v += part[w * 3072 + idx];
        const int grow = 32 * rb + row;
        v *= rsqrtf(rss[grow] * (1.0f / 2048.0f) + 1e-6f);
        if (col < 64) IK[(size_t)grow * 64 + col] = (bf16_t)pk2(v, 0.f);
        else if (col < 80) IW[(size_t)grow * 16 + (col - 64)] = v * 0.25f;
    }
    __syncthreads();
}

__device__ __forceinline__ void indexer_group(unsigned char* ws, LAS unsigned char* lds, int grp, int wave, int lane) {
    const bf16_t* IQ = (const bf16_t*)(ws + WS_IQ); const bf16_t* IK = (const bf16_t*)(ws + WS_IK); const float* IW = (const float*)(ws + WS_IW); unsigned* MASK = (unsigned*)(ws + WS_MASK);
    const int b = grp >> 7, T0 = (grp & 127) * 16, t0 = T0 + 2 * wave, hi = lane >> 5, l32 = lane & 31, tid = wave * 64 + lane;
    const size_t rowbase = (size_t)b * SEQ;
    const int atok = (l32 >> 2) & 1, ahead = 4 * (l32 >> 3) + (l32 & 3);
    const bf16_t* ap = IQ + (rowbase + t0 + atok) * 1024 + ahead * 64 + 8 * hi;
    bf16x8 af[4];
#pragma unroll
    for (int kk = 0; kk < 4; ++kk) af[kk] = *(const bf16x8*)(ap + 16 * kk);
    float w[16];
#pragma unroll
    for (int i = 0; i < 4; ++i) { const f32x4 t = *(const f32x4*)(IW + (rowbase + t0 + hi) * 16 + 4 * i); w[4 * i] = t[0]; w[4 * i + 1] = t[1]; w[4 * i + 2] = t[2]; w[4 * i + 3] = t[3]; }
    const int tq = t0 + hi, nj = (t0 + 1) / 32 + 1, nchunk = ((T0 + 15) / 32 + 1 + 7) / 8;
    u32x4 stg[4];
#define IDX_LOAD(c) do { _Pragma("unroll") for (int i = 0; i < 4; ++i) { const int p = tid + 512 * i; stg[i] = *(const u32x4*)(IK + (rowbase + 256 * (c) + (p >> 3)) * 64 + 8 * (p & 7)); } } while (0)
    IDX_LOAD(0);
    unsigned uk[64];
#pragma unroll
    for (int c = 0; c < 8; ++c) {
        if (c < nchunk) {
            __syncthreads();
#pragma unroll
            for (int i = 0; i < 4; ++i) { const int p = tid + 512 * i; *(LAS u32x4*)(lds + (p >> 3) * 144 + (p & 7) * 16) = stg[i]; }
            __syncthreads();
            if (c + 1 < nchunk) IDX_LOAD(c + 1);
#pragma unroll
            for (int jj = 0; jj < 8; ++jj) { const int j = 8 * c + jj;
                if (j < nj) {
                    const LAS unsigned char* bp = lds + (32 * jj + l32) * 144 + 16 * hi;
                    f32x16 cc = {0.f, 0.f, 0.f, 0.f, 0.f, 0.f, 0.f, 0.f, 0.f, 0.f, 0.f, 0.f, 0.f, 0.f, 0.f, 0.f};
#pragma unroll
                    for (int kk = 0; kk < 4; ++kk) cc = MFMA32(af[kk], *(const LAS bf16x8*)(bp + 32 * kk), cc);
                    float sc = 0.f;
#pragma unroll
                    for (int r = 0; r < 16; ++r) sc += w[r] * fmaxf(cc[r], 0.f);
                    const unsigned bits = __float_as_uint(sc); const unsigned ku = bits ^ ((bits >> 31) ? 0xffffffffu : 0x80000000u);
                    uk[j] = (32 * j + l32 <= tq) ? ku : 0u;
                } else uk[j] = 0u; }
        } else {
#pragma unroll
            for (int jj = 0; jj < 8; ++jj) uk[8 * c + jj] = 0u; }
    }
#undef IDX_LOAD
    unsigned p = 0u; bool done = (tq + 1 <= 256);
    for (int bit = 31; bit >= 0; --bit) {
        if (__all(done)) break;
        const unsigned cand = p | (1u << bit);
        int cnt = 0;
#pragma unroll
        for (int g = 0; g < 8; ++g) if (8 * g < nj) {
#pragma unroll
            for (int jj = 0; jj < 8; ++jj) cnt += (uk[8 * g + jj] >= cand) ? 1 : 0; }
        cnt += __builtin_amdgcn_update_dpp(0, cnt, 0xB1, 0xF, 0xF, true); cnt += __builtin_amdgcn_update_dpp(0, cnt, 0x4E, 0xF, 0xF, true);
        cnt += __builtin_amdgcn_update_dpp(0, cnt, 0x141, 0xF, 0xF, true); cnt += __builtin_amdgcn_update_dpp(0, cnt, 0x140, 0xF, 0xF, true);
        { auto rr = __builtin_amdgcn_permlane16_swap((unsigned)cnt, (unsigned)cnt, false, false); cnt = (int)(rr[0] + rr[1]); }
        if (!done && cnt >= 256) { p = cand; if (cnt == 256) done = true; }
    }
    const unsigned thr = (tq + 1 <= 256) ? 1u : (p > 1u ? p : 1u);
    unsigned alo = 0u, ahi = 0u;
#pragma unroll
    for (int j = 0; j < 64; ++j) { const unsigned long long bal = __ballot(uk[j] >= thr); if (lane == j) { alo = (unsigned)bal; ahi = (unsigned)(bal >> 32); } }
    MASK[(rowbase + t0) * 64 + lane] = alo; MASK[(rowbase + t0 + 1) * 64 + lane] = ahi;
}

__device__ __forceinline__ void ra_unit(unsigned char* ws, int unit, int wave, int lane) {
    const bf16_t* RVT = (const bf16_t*)(ws + WS_RVT); const bf16_t* RKT = (const bf16_t*)(ws + WS_RKT); float* U = (float*)(ws + WS_U);
    const int b = unit >> 7, h = (unit >> 4) & 7, n = unit & 15, s0 = n * 128, eb = wave, hi = lane >> 5, l32 = lane & 31;
    const float lg2 = __log2f(1.0f - exp2f(-5.0f - (float)h));
    const bf16_t* vp = RVT + ((size_t)(b * 2048 + h * 256 + 32 * eb + l32)) * 2048 + s0 + 8 * hi;
    bf16x8 af[8];
#pragma unroll
    for (int kk = 0; kk < 8; ++kk) { const bf16x8 raw = *(const bf16x8*)(vp + 16 * kk); float f[8];
#pragma unroll
        for (int i = 0; i < 8; ++i) f[i] = bf2f((unsigned)(unsigned short)raw[i]) * exp2f(lg2 * (float)(127 - (16 * kk + 8 * hi + i)));
        af[kk] = pack8(f); }
    __builtin_amdgcn_sched_barrier(0);
#pragma unroll
    for (int db = 0; db < 4; ++db) {
        bf16x8 bfr[8];
        const bf16_t* kp = RKT + ((size_t)(b * 1024 + h * 128 + 32 * db + l32)) * 2048 + s0 + 8 * hi;
#pragma unroll
        for (int kk = 0; kk < 8; ++kk) bfr[kk] = *(const bf16x8*)(kp + 16 * kk);
        __builtin_amdgcn_sched_barrier(0);
        f32x16 c = {0.f, 0.f, 0.f, 0.f, 0.f, 0.f, 0.f, 0.f, 0.f, 0.f, 0.f, 0.f, 0.f, 0.f, 0.f, 0.f};
#pragma unroll
        for (int kk = 0; kk < 8; ++kk) c = MFMA32(af[kk], bfr[kk], c);
#pragma unroll
        for (int r = 0; r < 16; ++r) U[(size_t)unit * 32768 + (32 * eb + crow(r, hi)) * 128 + 32 * db + l32] = c[r];
        __builtin_amdgcn_sched_barrier(0);
    }
}
__device__ __forceinline__ void rb_scan(unsigned char* ws, int gtid, int nthr) {
    const float* U = (const float*)(ws + WS_U); bf16_t* RP = (bf16_t*)(ws + WS_RP);
    for (int it = gtid; it < 32 * 8192; it += nthr) {
        const int bh = it >> 13, e4 = (it & 8191) * 4, h = bh & 7;
        const float lg2 = __log2f(1.0f - exp2f(-5.0f - (float)h)); const float cd = exp2f(lg2 * 128.0f);
        f32x4 R = {0.f, 0.f, 0.f, 0.f};
#pragma unroll 4
        for (int n = 0; n < 16; ++n) { const size_t off = ((size_t)(bh * 16 + n)) * 32768 + e4; st4bf(RP + off, R); R = *(const f32x4*)(U + off) + R * cd; }
    }
}
__device__ __forceinline__ void stage_put(LAS unsigned char* stg, int lane, int colgrp4  , f32x4 v) {
    *(LAS u32x2*)(stg + (lane & 31) * 272 + colgrp4 * 2) = (u32x2){pk2(v[0], v[1]), pk2(v[2], v[3])};
}
__device__ __forceinline__ void stage_flush(const LAS unsigned char* stg, int lane, bf16_t* out  , size_t row_stride) {
    asm volatile("s_waitcnt lgkmcnt(0)" ::: "memory");
#pragma unroll
    for (int it = 0; it < 8; ++it) { const int row = it * 4 + (lane >> 4), ch = lane & 15; *(u32x4*)(out + (size_t)row * row_stride + ch * 8) = *(const LAS u32x4*)(stg + row * 272 + ch * 16); }
    asm volatile("s_waitcnt lgkmcnt(0)" ::: "memory");
}
__device__ __forceinline__ void rascan_unit(unsigned char* ws, int unit, int wave, int lane) {
    const bf16_t* RVT = (const bf16_t*)(ws + WS_RVT); const bf16_t* RKT = (const bf16_t*)(ws + WS_RKT); bf16_t* RP = (bf16_t*)(ws + WS_RP);
    const int b = unit >> 5, h = (unit >> 2) & 7, dblk = unit & 3, eb = wave, hi = lane >> 5, l32 = lane & 31;
    const float lg2 = __log2f(1.0f - exp2f(-5.0f - (float)h)); const float cd = exp2f(lg2 * 128.0f);
    float zi[8], zk[8];
#pragma unroll
    for (int i = 0; i < 8; ++i) { zi[i] = exp2f(lg2 * (float)(127 - 8 * hi - i)); zk[i] = exp2f(lg2 * (float)(-16 * i)); }
    const bf16_t* vrow = RVT + ((size_t)(b * 8 + h) * 16) * 32768 + eb * 4096 + lane * 8;
    const bf16_t* krow = RKT + ((size_t)(b * 8 + h) * 16) * 16384 + dblk * 4096 + lane * 8;
    const int dq = 32 * dblk + l32; bf16_t* rpo = RP + ((size_t)(b * 8 + h) * 16) * 32768 + eb * 4096 + (((dq >> 4) * 2 + ((dq >> 3) & 1)) * 32 + 4 * hi) * 8 + (dq & 7);
    f32x16 R = {0.f, 0.f, 0.f, 0.f, 0.f, 0.f, 0.f, 0.f, 0.f, 0.f, 0.f, 0.f, 0.f, 0.f, 0.f, 0.f};
    bf16x8 va[8], ka[8];
#define RS_LOAD(n, V, K) do { _Pragma("unroll") for (int kk = 0; kk < 8; ++kk) { V[kk] = *(const bf16x8*)(vrow + (size_t)(n) * 32768 + 512 * kk); K[kk] = *(const bf16x8*)(krow + (size_t)(n) * 16384 + 512 * kk); } } while (0)
#define RS_STEP(n, V, K) do { \
        bf16_t* rp_ = rpo + (size_t)(n) * 32768; \
        _Pragma("unroll") for (int r = 0; r < 16; ++r) rp_[((r & 3) + 8 * (r >> 2)) * 8] = (bf16_t)pk2(R[r], 0.f); \
        f32x16 u_ = {0.f, 0.f, 0.f, 0.f, 0.f, 0.f, 0.f, 0.f, 0.f, 0.f, 0.f, 0.f, 0.f, 0.f, 0.f, 0.f}; \
        _Pragma("unroll") for (int kk = 0; kk < 8; ++kk) { float f_[8]; \
            _Pragma("unroll") for (int i = 0; i < 8; ++i) f_[i] = bf2f((unsigned)(unsigned short)V[kk][i]) * (zk[kk] * zi[i]); \
            u_ = MFMA32(pack8(f_), K[kk], u_); } \
        R = u_ + R * cd; } while (0)
#pragma unroll 1
    for (int n = 0; n < 16; ++n) {
        RS_LOAD(n, va, ka);
        __builtin_amdgcn_sched_barrier(0);
        RS_STEP(n, va, ka);
        __builtin_amdgcn_sched_barrier(0);
    }
#undef RS_LOAD
#undef RS_STEP
}
__device__ __forceinline__ void rc_unit(unsigned char* ws, const float* gn_g, const float* gn_b, LAS unsigned char* lds, int unit, int layer, int wave, int lane) {
    const bf16_t* RQ = (const bf16_t*)(ws + WS_RQ); const bf16_t* RK = (const bf16_t*)(ws + WS_RK); const bf16_t* RVT = (const bf16_t*)(ws + WS_RVT); const bf16_t* RP = (const bf16_t*)(ws + WS_RP);
    const bf16_t* SRG = (const bf16_t*)(ws + WS_SRG); bf16_t* ORET = (bf16_t*)(ws + WS_OATT) + 2048;
    const int b = unit >> 7, h = (unit >> 4) & 7, n = unit & 15, s0 = n * 128, ib = wave >> 1, eh = wave & 1, hi = lane >> 5, l32 = lane & 31;
    const float lg2 = __log2f(1.0f - exp2f(-5.0f - (float)h));
    const size_t tok = (size_t)b * SEQ + s0 + 32 * ib + l32;
    bf16x8 qf[8];
#pragma unroll
    for (int kk = 0; kk < 8; ++kk) qf[kk] = *(const bf16x8*)(RQ + (size_t)unit * 16384 + ib * 4096 + kk * 512 + lane * 8);
    f32x16 acc[4];
    const int iq = 32 * ib + l32;
    bf16x8 pfr[4][2];
    {
        bf16x8 kf[32];
#pragma unroll
        for (int jb = 0; jb < 4; ++jb) { const bf16_t* kp = RK + (size_t)unit * 16384 + jb * 4096 + (hi * 32 + kperm(l32)) * 8;
#pragma unroll
            for (int kk = 0; kk < 8; ++kk) kf[8 * jb + kk] = *(const bf16x8*)(kp + 512 * kk); }
        __builtin_amdgcn_sched_barrier(0);
#pragma unroll
        for (int jb = 0; jb < 4; ++jb) { f32x16 st = {0.f, 0.f, 0.f, 0.f, 0.f, 0.f, 0.f, 0.f, 0.f, 0.f, 0.f, 0.f, 0.f, 0.f, 0.f, 0.f};
#pragma unroll
            for (int kk = 0; kk < 8; ++kk) st = MFMA32(kf[8 * jb + kk], qf[kk], st);
            float f[16];
#pragma unroll
            for (int r = 0; r < 16; ++r) { const int j = 32 * jb + 16 * (r >> 3) + 8 * hi + (r & 7); const int df = iq - j; f[r] = (df >= 0) ? st[r] * exp2f(lg2 * (float)df) : 0.f; }
            pfr[jb][0] = pack8(f); pfr[jb][1] = pack8(f + 8); }
        __builtin_amdgcn_sched_barrier(0);
    }
    int lnc = lane; asm volatile("" : "+v"(lnc)); const int l32c = lnc & 31;
#pragma unroll
    for (int ep = 0; ep < 2; ++ep) {
        bf16x8 rf[16];
#pragma unroll
        for (int e2 = 0; e2 < 2; ++e2) { const int eb = 4 * eh + 2 * ep + e2; const bf16_t* rp = RP + (size_t)unit * 32768 + eb * 4096 + lnc * 8;
#pragma unroll
            for (int kk = 0; kk < 8; ++kk) rf[8 * e2 + kk] = *(const bf16x8*)(rp + 512 * kk); }
        __builtin_amdgcn_sched_barrier(0);
#pragma unroll
        for (int e2 = 0; e2 < 2; ++e2) { f32x16 c = {0.f, 0.f, 0.f, 0.f, 0.f, 0.f, 0.f, 0.f, 0.f, 0.f, 0.f, 0.f, 0.f, 0.f, 0.f, 0.f};
#pragma unroll
            for (int kk = 0; kk < 8; ++kk) c = MFMA32(rf[8 * e2 + kk], qf[kk], c);
            acc[2 * ep + e2] = c * exp2f(lg2 * (float)(32 * ib + l32c + 1)); }
        __builtin_amdgcn_sched_barrier(0);
    }
    int lnv = lane; asm volatile("" : "+v"(lnv)); const int l32v = lnv & 31, hiv = lnv >> 5;
#pragma unroll
    for (int ep = 0; ep < 2; ++ep) {
        bf16x8 vf[16];
#pragma unroll
        for (int e2 = 0; e2 < 2; ++e2) { const int eb = 4 * eh + 2 * ep + e2; const bf16_t* vp = RVT + (size_t)unit * 32768 + eb * 4096 + lnv * 8;
#pragma unroll
            for (int q = 0; q < 8; ++q) vf[8 * e2 + q] = *(const bf16x8*)(vp + 512 * q); }
        __builtin_amdgcn_sched_barrier(0);
#pragma unroll
        for (int e2 = 0; e2 < 2; ++e2)
#pragma unroll
            for (int q = 0; q < 8; ++q) acc[2 * ep + e2] = MFMA32(vf[8 * e2 + q], pfr[q >> 1][q & 1], acc[2 * ep + e2]);
        __builtin_amdgcn_sched_barrier(0);
    }
    float s1 = 0.f, s2 = 0.f;
#pragma unroll
    for (int el = 0; el < 4; ++el)
#pragma unroll
        for (int r = 0; r < 16; ++r) { const float v = acc[el][r]; s1 += v; s2 += v * v; }
    s1 = x32sum(s1); s2 = x32sum(s2);
    LAS float* xs = (LAS float*)lds;
    __syncthreads();
    if (hi == 0) { xs[(wave * 32 + l32) * 2] = s1; xs[(wave * 32 + l32) * 2 + 1] = s2; }
    __syncthreads();
    s1 += xs[((wave ^ 1) * 32 + l32) * 2]; s2 += xs[((wave ^ 1) * 32 + l32) * 2 + 1];
    const float mu = s1 * (1.0f / 256.0f); const float var = fmaxf(s2 * (1.0f / 256.0f) - mu * mu, 0.f); const float rstd = rsqrtf(var + 1e-6f);
    const float* gg = gn_g + layer * 2048 + h * 256; const float* gb = gn_b + layer * 2048 + h * 256;
    int ln2 = lane; asm volatile("" : "+v"(ln2));
    const int hi2 = ln2 >> 5;
    const bf16_t* sgp = SRG + (size_t)unit * 32768 + ib * 8192 + eh * 4096 + ln2 * 4;
    LAS unsigned char* stg = lds + 4096 + wave * 8704;
#pragma unroll
    for (int el = 0; el < 4; ++el)
#pragma unroll
        for (int c4 = 0; c4 < 4; ++c4) {
            const int e0 = 32 * (4 * eh + el) + 8 * c4 + 4 * hi2;
            const f32x4 g4 = *(const f32x4*)(gg + e0), b4 = *(const f32x4*)(gb + e0); const u32x2 sg = *(const u32x2*)(sgp + (el * 4 + c4) * 256);
            f32x4 o;
            o[0] = ((acc[el][4 * c4 + 0] - mu) * rstd * g4[0] + b4[0]) * bf2f(sg.x & 0xffffu);
            o[1] = ((acc[el][4 * c4 + 1] - mu) * rstd * g4[1] + b4[1]) * bf2f(sg.x >> 16);
            o[2] = ((acc[el][4 * c4 + 2] - mu) * rstd * g4[2] + b4[2]) * bf2f(sg.y & 0xffffu);
            o[3] = ((acc[el][4 * c4 + 3] - mu) * rstd * g4[3] + b4[3]) * bf2f(sg.y >> 16);
            stage_put(stg, ln2, 32 * el + 8 * c4 + 4 * hi2, o);
        }
    stage_flush(stg, ln2, ORET + ((size_t)b * SEQ + s0 + 32 * ib) * 4096 + h * 256 + 128 * eh, 4096);
}

constexpr int KT_STRIDE = 136, VT_STRIDE = 72, ATT_K_OFF = 0, ATT_V_OFF = 64 * KT_STRIDE * 2, ATT_BUF = 64 * KT_STRIDE * 2 + 128 * VT_STRIDE * 2, ATT_Q_OFF = 2 * ATT_BUF;
__device__ __forceinline__ void attn_unit(unsigned char* ws, const float* qn_g, const float* kn_g, LAS unsigned char* lds, int unit, int layer, int wave, int lane) {
    const bf16_t* Q = (const bf16_t*)(ws + WS_Q); const bf16_t* KN = (const bf16_t*)(ws + WS_KN); const bf16_t* VT = (const bf16_t*)(ws + WS_VT); const unsigned* MASK = (const unsigned*)(ws + WS_MASK);
    bf16_t* OATT = (bf16_t*)(ws + WS_OATT);
    const int tid = wave * 64 + lane, hi = lane >> 5, l32 = lane & 31;
    int bg, qb; if (unit < 256) { bg = unit >> 4; qb = unit & 15; } else { bg = (unit - 256) >> 4; qb = 31 - ((unit - 256) & 15); }
    const int b = bg >> 2, g = bg & 3, hh = g * 4 + (wave >> 1), q0 = qb * 64, qs = q0 + 32 * (wave & 1);
    const size_t tok = (size_t)b * SEQ + qs + l32;
    bf16x8 qf[8]; float mfix;
    {
        float ss = 0.f;
        const bf16_t* qp = Q + tok * 2048 + hh * 128 + 8 * hi;
#pragma unroll
        for (int kk = 0; kk < 8; ++kk) { qf[kk] = *(const bf16x8*)(qp + 16 * kk);
#pragma unroll
            for (int i = 0; i < 8; ++i) { const float v = bf2f((unsigned)(unsigned short)qf[kk][i]); ss += v * v; } }
        ss = x32sum(ss);
        const float rs = rsqrtf(ss * (1.0f / 128.0f) + 1e-6f) * (0.08838834764831845f * 1.4426950408889634f);
        const float* qg = qn_g + layer * 128 + 8 * hi; float s2 = 0.f;
#pragma unroll
        for (int kk = 0; kk < 8; ++kk) { float f[8];
#pragma unroll
            for (int i = 0; i < 8; ++i) { f[i] = bf2f((unsigned)(unsigned short)qf[kk][i]) * rs * qg[16 * kk + i]; s2 += f[i] * f[i]; }
            *(LAS bf16x8*)(lds + ATT_Q_OFF + wave * 8192 + kk * 1024 + lane * 16) = pack8(f); }
        s2 = x32sum(s2);
        float gm = fmaxf(fabsf(kn_g[layer * 128 + 2 * lane]), fabsf(kn_g[layer * 128 + 2 * lane + 1]));
#pragma unroll
        for (int o = 1; o < 64; o <<= 1) gm = fmaxf(gm, shx(gm, o, lane));
        mfix = sqrtf(s2) * 11.313708498984761f * gm * 1.01f + 0.01f;
    }
    f32x16 o[4];
#pragma unroll
    for (int d = 0; d < 4; ++d) o[d] = (f32x16){0.f, 0.f, 0.f, 0.f, 0.f, 0.f, 0.f, 0.f, 0.f, 0.f, 0.f, 0.f, 0.f, 0.f, 0.f, 0.f};
    float lrun = 0.f;
    const int nt = qb + 1;
    const bf16_t* kbase = KN + ((size_t)(b * 4 + g) * SEQ) * 128; const bf16_t* vbase = VT + ((size_t)(b * 4 + g) * 32) * 8192;
    u32x4 kst[2], vst[2];
    unsigned koff[2], voff[2];
#pragma unroll
    for (int i = 0; i < 2; ++i) { const int p = tid + 512 * i; koff[i] = (unsigned)(p * 16); voff[i] = (unsigned)(p * 16); }
#define ATT_LOAD(t) do { const char* kb_ = (const char*)(kbase + (size_t)(t) * 8192); const char* vb_ = (const char*)(vbase + (size_t)(t) * 8192); \
        _Pragma("unroll") for (int i = 0; i < 2; ++i) { kst[i] = *(const u32x4*)(kb_ + koff[i]); vst[i] = *(const u32x4*)(vb_ + voff[i]); } } while (0)
#define ATT_STORE(buf) do { _Pragma("unroll") for (int i = 0; i < 2; ++i) { const int p = tid + 512 * i; *(LAS u32x4*)(lds + (buf) * ATT_BUF + ATT_K_OFF + ((p >> 4) * KT_STRIDE + 8 * (p & 15)) * 2) = kst[i]; \
        *(LAS u32x4*)(lds + (buf) * ATT_BUF + ATT_V_OFF + ((p >> 3) * VT_STRIDE + 8 * (p & 7)) * 2) = vst[i]; } } while (0)
    __builtin_amdgcn_sched_barrier(0);
    const char* mbase = (const char*)(MASK + ((size_t)b * SEQ + qs) * 64); const unsigned moff = (unsigned)l32 * 256u;
    u32x2 mwn = *(const u32x2*)(mbase + moff);
    ATT_LOAD(0);
    __syncthreads();
    ATT_STORE(0);
    __syncthreads();
    for (int t = 0; t < nt; ++t) {
        const int cur = t & 1;
        const u32x2 mw = mwn;
        if (t + 1 < nt) { mwn = *(const u32x2*)(mbase + (moff + 8u * (unsigned)(t + 1))); ATT_LOAD(t + 1); }
        float psum = 0.f; bf16x8 pf[2][2];
        const LAS unsigned char* kp = lds + cur * ATT_BUF + ATT_K_OFF + (kperm(l32) * KT_STRIDE + 8 * hi) * 2;
        const LAS unsigned char* vp = lds + cur * ATT_BUF + ATT_V_OFF + (l32 * VT_STRIDE + 8 * hi) * 2;
#define KFR(p, kk) (*(const LAS bf16x8*)(kp + (p) * (32 * KT_STRIDE * 2) + 32 * (kk)))
#define VFR(d, q) (*(const LAS bf16x8*)(vp + (d) * (32 * VT_STRIDE * 2) + 32 * (q)))
        f32x16 c0, c1;
#pragma unroll
        for (int r = 0; r < 16; ++r) { c0[r] = -mfix; c1[r] = -mfix; }
        const LAS unsigned char* qpk = lds + ATT_Q_OFF + wave * 8192 + lane * 16;
#define QFR(kk) (*(const LAS bf16x8*)(qpk + (kk) * 1024))
        bf16x8 fA[4], fB[4], qA[2], qB[2];
#define LDK(F, Qv, i) do { F[0] = KFR(0, 2 * (i)); F[1] = KFR(1, 2 * (i)); F[2] = KFR(0, 2 * (i) + 1); F[3] = KFR(1, 2 * (i) + 1); Qv[0] = QFR(2 * (i)); Qv[1] = QFR(2 * (i) + 1); } while (0)
#define LDV(F, d) do { F[0] = VFR(d, 0); F[1] = VFR(d, 1); F[2] = VFR(d, 2); F[3] = VFR(d, 3); } while (0)
#define MMK(F, Qv) do { c0 = MFMA32(F[0], Qv[0], c0); c1 = MFMA32(F[1], Qv[0], c1); c0 = MFMA32(F[2], Qv[1], c0); c1 = MFMA32(F[3], Qv[1], c1); } while (0)
#define MMV(F, d) do { o[d] = MFMA32(F[0], pf[0][0], o[d]); o[d] = MFMA32(F[1], pf[0][1], o[d]); o[d] = MFMA32(F[2], pf[1][0], o[d]); o[d] = MFMA32(F[3], pf[1][1], o[d]); } while (0)
#define SB() __builtin_amdgcn_sched_barrier(0)
        LDK(fA, qA, 0); SB();
        LDK(fB, qB, 1); SB(); MMK(fA, qA); SB();
        LDK(fA, qA, 2); SB(); MMK(fB, qB); SB();
        LDK(fB, qB, 3); SB(); MMK(fA, qA); SB();
        LDV(fA, 0);     SB(); MMK(fB, qB); SB();
#undef QFR
#pragma unroll
        for (int p = 0; p < 2; ++p) {
            const int wbits = (int)((p ? mw.y : mw.x) >> (8 * hi));
            float f[16];
#pragma unroll
            for (int r = 0; r < 16; ++r) { const float e = __builtin_amdgcn_exp2f(p ? c1[r] : c0[r]); int mb;
                asm("v_bfe_i32 %0, %1, %2, 1" : "=v"(mb) : "v"(wbits), "n"(16 * (r >> 3) + (r & 7)));
                f[r] = __uint_as_float(__float_as_uint(e) & (unsigned)mb); psum += f[r]; }
            pf[p][0] = pack8(f); pf[p][1] = pack8(f + 8);
        }
        lrun += psum;
        SB();
        LDV(fB, 1); SB(); MMV(fA, 0); SB();
        LDV(fA, 2); SB(); MMV(fB, 1); SB();
        LDV(fB, 3); SB(); MMV(fA, 2); SB();
        MMV(fB, 3); SB();
#undef LDK
#undef LDV
#undef MMK
#undef MMV
#undef SB
#undef KFR
#undef VFR
        if (t + 1 < nt) ATT_STORE(cur ^ 1);
        __syncthreads();
    }
#undef ATT_LOAD
#undef ATT_STORE
    lrun = x32sum(lrun);
    const float inv = 1.0f / lrun;
    int ln2 = lane; asm volatile("" : "+v"(ln2));
    LAS unsigned char* stg = lds + wave * 8704;
#pragma unroll
    for (int d = 0; d < 4; ++d)
#pragma unroll
        for (int c4 = 0; c4 < 4; ++c4) {
            f32x4 v; v[0] = o[d][4 * c4] * inv; v[1] = o[d][4 * c4 + 1] * inv; v[2] = o[d][4 * c4 + 2] * inv; v[3] = o[d][4 * c4 + 3] * inv;
            stage_put(stg, ln2, 32 * d + 8 * c4 + 4 * (ln2 >> 5), v);
        }
    stage_flush(stg, ln2, OATT + ((size_t)b * SEQ + qs) * 4096 + hh * 128, 4096);
}

#define XB_TMO      128
#define XB_XCNT(j)  (256  + 64 * (j))
#define XB_XSUB(j)  (1280 + 64 * (j))
#define XB_XGEN(j)  (2304 + 64 * (j))
#define XB_TOP      3328
#define XB_TOPGEN   3392
#define XCD_BAR_WORDS 3456
#define XB_SPIN_CAP (1u << 18)

__device__ __forceinline__ unsigned xb_ld(unsigned* p)              { return __hip_atomic_load(p, __ATOMIC_RELAXED, __HIP_MEMORY_SCOPE_AGENT); }
__device__ __forceinline__ unsigned xb_add(unsigned* p, unsigned v) { return __hip_atomic_fetch_add(p, v, __ATOMIC_RELAXED, __HIP_MEMORY_SCOPE_AGENT); }
__device__ __forceinline__ unsigned xb_xcc_id() { return (unsigned)__builtin_amdgcn_s_getreg((3 << 11) | 20) & 0xFu; }
#define XB_SPIN(cond, bar) do { unsigned _sp = 0; while (cond) { __builtin_amdgcn_s_sleep(1); \
    if ((++_sp & 255u) == 0u) { if (xb_ld(&(bar)[XB_TMO])) break; if (_sp > XB_SPIN_CAP) { atomicAdd(&(bar)[XB_TMO], 1u); break; } } } } while (0)

struct XcdBarrier {
    unsigned* bar; unsigned x;
    volatile LAS unsigned* st;
};

__device__ __forceinline__ XcdBarrier xcd_barrier_post(unsigned* bar, volatile LAS unsigned* st) {
    XcdBarrier b; b.bar = bar; b.x = xb_xcc_id(); b.st = st;
    if (threadIdx.x == 0) (void)xb_add(&bar[XB_XCNT(b.x)], 1u);
    return b;
}
__device__ __forceinline__ void xcd_barrier_complete(unsigned* bar, unsigned x, unsigned& nloc, unsigned& nx) {
    const unsigned G = gridDim.x * gridDim.y * gridDim.z;
    unsigned sum, cnt, mine, sp = 0u;
    for (;;) {
        sum = 0u; cnt = 0u; mine = 0u;
#pragma unroll
        for (unsigned j = 0; j < 16; ++j) { const unsigned c = xb_ld(&bar[XB_XCNT(j)]); sum += c; cnt += (c > 0u) ? 1u : 0u; mine = (j == x) ? c : mine; }
        if (sum == G) break;
        __builtin_amdgcn_s_sleep(1);
        if ((++sp & 255u) == 0u) { if (xb_ld(&bar[XB_TMO])) break; if (sp > XB_SPIN_CAP) { atomicAdd(&bar[XB_TMO], 1u); break; } }
    }
    nloc = mine > 0u ? mine : 1u; nx = cnt > 0u ? cnt : 1u;
}

__device__ __forceinline__ void xcd_barrier(const XcdBarrier& b) {
    asm volatile("s_waitcnt vmcnt(0)" ::: "memory");
    __syncthreads();
    if (threadIdx.x == 0) {
        unsigned* bar = b.bar;
        __builtin_amdgcn_s_waitcnt(0);
        unsigned nloc = b.st[0], nx = b.st[1];
        if (nloc == 0u) { xcd_barrier_complete(bar, b.x, nloc, nx); b.st[0] = nloc; b.st[1] = nx; }
        const unsigned old = xb_add(&bar[XB_XSUB(b.x)], 1u);
        const unsigned gen = old / nloc;
        if (old + 1u == (gen + 1u) * nloc) {
            __builtin_amdgcn_fence(__ATOMIC_RELEASE, "agent");
            asm volatile("s_waitcnt vmcnt(0)" ::: "memory");
            const unsigned og = xb_add(&bar[XB_TOP], 1u);
            const unsigned tg = og / nx;
            if (og + 1u == (tg + 1u) * nx) xb_add(&bar[XB_TOPGEN], 1u);
            else XB_SPIN(xb_ld(&bar[XB_TOPGEN]) == tg, bar);
            __builtin_amdgcn_fence(__ATOMIC_ACQUIRE, "agent");
            xb_add(&bar[XB_XGEN(b.x)], 1u);
            asm volatile("s_waitcnt vmcnt(0)" ::: "memory");
        } else {
            XB_SPIN(xb_ld(&bar[XB_XGEN(b.x)]) == gen, bar);
            __builtin_amdgcn_fence(__ATOMIC_ACQUIRE, "agent");
            asm volatile("s_waitcnt vmcnt(0)" ::: "memory");
        }
    }
    __syncthreads();
}

constexpr int LDS_BYTES = 139264;
__global__ void __launch_bounds__(NTHR, 2) hybrid_fwd(Params P_unused) {
    extern __shared__ __attribute__((aligned(16))) unsigned char lds_raw[];
    cg::grid_group grid = cg::this_grid();
#define FRESH() LAS unsigned char* lds = (LAS unsigned char*)lds_raw; int tid = threadIdx.x; asm volatile("" : "+v"(tid)); const int lane = tid & 63, wave = __builtin_amdgcn_readfirstlane(tid >> 6); \
    int G = gridDim.x, bx = blockIdx.x; asm volatile("" : "+s"(G), "+s"(bx)); const int gw = bx * NWAVE + wave, NGW = G * NWAVE; CP pp = getP(); unsigned char* ws = pp->ws; \
    float* RSS = (float*)(ws + WS_RSS); bf16_t* XB = (bf16_t*)(ws + WS_XB); (void)lane; (void)gw; (void)NGW; (void)RSS; (void)XB; (void)lds;
    {
        FRESH();
        if (tid < 4) ((LAS unsigned*)(lds + LDS_BYTES - 16))[tid] = 0u;
        __syncthreads();
        (void)xcd_barrier_post((unsigned*)(ws + WS_BAR), (volatile LAS unsigned*)(lds + LDS_BYTES - 16));
#ifndef NO_PRO
        for (int rep = 0; rep < REP_PRO; ++rep) prologue(pp, lds, gw, NGW, wave, lane);
#endif
    }
    if (P_unused.out == nullptr) grid.sync();
#define GSYNC() do { LAS unsigned char* lds_ = (LAS unsigned char*)lds_raw; XcdBarrier xb_; xb_.bar = (unsigned*)(getP()->ws + WS_BAR); xb_.x = xb_xcc_id(); xb_.st = (volatile LAS unsigned*)(lds_ + LDS_BYTES - 16); xcd_barrier(xb_); } while (0)
    GSYNC();
#pragma unroll 1
    for (int l = 0; l < NL; ++l) {
        {
            FRESH();
            pg8::Gemm g{XB, (const bf16_t*)(ws + WS_WIN + l * 57 * MiB), NTOK, NMAIN, DM}; pg8::StaticOrder S; S.init(NTOK, NMAIN, G, bx);
            EpiIn E{RSS + (2 * l) * NTOK, ws};
#ifndef NO_G1
            pg8::gemm_phase<EpiIn, pg8::StaticOrder, GA_, GS_>(lds, g, S, E);
#endif
            for (int rb = bx; rb < NTOK / 32; rb += G) tail_block(ws, (const bf16_t*)(ws + WS_WIN + l * 57 * MiB) + (size_t)NMAIN * DM, RSS + (2 * l) * NTOK, lds, rb, wave, lane);
        }
        GSYNC();
        {
            FRESH();
            const bf16_t* KR = (const bf16_t*)(ws + WS_KRAW); bf16_t* KN = (bf16_t*)(ws + WS_KN); const float* kg = pp->kn_g + l * 128;
            for (int rep = 0; rep < REP_P2; ++rep) {
            for (int it = gw; it < NTOK * 4; it += NGW) {
                const int row = it >> 2, g4 = it & 3; const unsigned v = *(const unsigned*)(KR + (size_t)row * 512 + g4 * 128 + 2 * lane);
                const float a = bf2f(v & 0xffffu), c = bf2f(v >> 16); const float ss = wave_sum(a * a + c * c, lane); const float rs = rsqrtf(ss * (1.0f / 128.0f) + 1e-6f);
                *(unsigned*)(KN + ((size_t)((row >> 11) * 4 + g4) * SEQ + (row & 2047)) * 128 + 2 * lane) = pk2(a * rs * kg[2 * lane], c * rs * kg[2 * lane + 1]);
            }
            {
                const bool bal = (G == 256); const int i = bx & 127, q = i & 63, hb = i >> 6;
                if (bal) { if (bx < 128) rascan_unit(ws, bx, wave, lane); }
                else { for (int u = bx; u < 128; u += G) rascan_unit(ws, u, wave, lane); }
                const int ng = bal ? (bx < 128 ? 1 : 3) : 2 * ((255 - bx) / G + 1);
#pragma unroll 1
                for (int k = 0; k < ng; ++k) {
                    int gid;
                    if (bal) gid = (bx < 128) ? hb * 128 + 127 - q : (k == 0 ? (2 * hb) * 128 + q : (k == 1 ? (2 * hb + 1) * 128 + 63 - q : (2 + hb) * 128 + 64 + q));
                    else { const int kk2 = bx + (k >> 1) * G; gid = (k & 1) ? 511 - kk2 : kk2; }
                    indexer_group(ws, lds, gid, wave, lane);
                }
            }
            }
        }
        GSYNC();
        {
            FRESH();
            for (int rep = 0; rep < REP_P3; ++rep) {
#ifndef NO_ATT
            { const int vb = (G % 8 == 0) ? (bx % 8) * (G / 8) + bx / 8 : bx;
              for (int unit = vb; unit < 512; unit += G) attn_unit(ws, pp->qn_g, pp->kn_g, lds, unit, l, wave, lane); }
#endif
            { const float* gn_g = pp->gn_g; const float* gn_b = pp->gn_b;
              for (int unit = bx; unit < 512; unit += G) rc_unit(ws, gn_g, gn_b, lds, unit, l, wave, lane); }
            }
        }
        GSYNC();
        {
            FRESH();
            pg8::Gemm g{(const bf16_t*)(ws + WS_OATT), (const bf16_t*)(ws + WS_WUPA + l * 16 * MiB), NTOK, DM, 2 * DM}; pg8::StaticOrder S; S.init(NTOK, DM, G, bx);
            EpiGate E{(const bf16_t*)(ws + WS_SGA), (const bf16_t*)(ws + WS_SGB), (bf16_t*)(ws + WS_MERGED)};
#if !defined(NO_GO) && !defined(NO_GA)
            pg8::gemm_phase<EpiGate, pg8::StaticOrder, GA_, GS_>(lds, g, S, E);
#endif
        }
        GSYNC();
        {
            FRESH();
            pg8::Gemm g{(const bf16_t*)(ws + WS_MERGED), (const bf16_t*)(ws + WS_WOUT + l * 8 * MiB), NTOK, DM, DM}; pg8::StaticOrder S; S.init(NTOK, DM, G, bx);
            EpiRes E{l == 0 ? pp->x : (const float*)pp->out, pp->out, XB, RSS + (2 * l + 1) * NTOK};
#if !defined(NO_GO) && !defined(NO_GR)
            pg8::gemm_phase<EpiRes, pg8::StaticOrder, GA_, GS_>(lds, g, S, E);
#endif
        }
        GSYNC();
        {
            FRESH();
            pg8::Gemm g{XB, (const bf16_t*)(ws + WS_WFF1 + l * 32 * MiB), NTOK, DFF, DM}; pg8::StaticOrder S; S.init(NTOK, DFF, G, bx);
            EpiFF1 E{RSS + (2 * l + 1) * NTOK, (bf16_t*)(ws + WS_HFF)};
#if !defined(NO_GO) && !defined(NO_F1)
            pg8::gemm_phase<EpiFF1, pg8::StaticOrder, GA_, GS_>(lds, g, S, E);
#endif
        }
        GSYNC();
        {
            FRESH();
            pg8::Gemm g{(const bf16_t*)(ws + WS_HFF), (const bf16_t*)(ws + WS_WFF2 + l * 32 * MiB), NTOK, DM, DFF}; pg8::StaticOrder S; S.init(NTOK, DM, G, bx);
            EpiRes E{pp->out, pp->out, (l + 1 < NL) ? XB : nullptr, (l + 1 < NL) ? RSS + (2 * l + 2) * NTOK : nullptr};
#if !defined(NO_GO) && !defined(NO_GR)
            pg8::gemm_phase<EpiRes, pg8::StaticOrder, GA_, GS_>(lds, g, S, E);
#endif
        }
        if (l + 1 < NL) GSYNC();
    }
#undef FRESH
}
}

extern "C" void kernel_launch(void* const* d_in, const int* in_sizes, int n_in, void* d_out, int out_size, void* d_ws, size_t ws_size, hipStream_t stream) {
    static int grid = 0;
    if (grid == 0) {
        if (n_in != 13 || out_size != mk::NTOK * mk::DM || ws_size < mk::WS_END) { fprintf(stderr, "kernel_launch: unexpected shapes (n_in %d out %d ws %zu)\n", n_in, out_size, ws_size); grid = -1; return; }
        int dev = 0, cus = 0, per_cu = 0;
        hipGetDevice(&dev); hipDeviceGetAttribute(&cus, hipDeviceAttributeMultiprocessorCount, dev);
        if (hipFuncSetAttribute((const void*)mk::hybrid_fwd, hipFuncAttributeMaxDynamicSharedMemorySize, mk::LDS_BYTES) != hipSuccess) { fprintf(stderr, "kernel_launch: hipFuncSetAttribute failed\n"); grid = -1; return; }
        if (hipOccupancyMaxActiveBlocksPerMultiprocessor(&per_cu, (const void*)mk::hybrid_fwd, mk::NTHR, mk::LDS_BYTES) != hipSuccess || per_cu < 1) { fprintf(stderr, "kernel_launch: occupancy query gave %d\n", per_cu); per_cu = 1; }
        (void)hipGetLastError();
        grid = cus * 1;
        if (grid <= 0) grid = 256;
    }
    if (grid < 0) return;
    mk::Params p{};
    p.x = (const float*)d_in[0]; p.ln1_g = (const float*)d_in[1]; p.w_in = (const float*)d_in[2]; p.qn_g = (const float*)d_in[3]; p.kn_g = (const float*)d_in[4];
    p.gn_g = (const float*)d_in[5]; p.gn_b = (const float*)d_in[6]; p.w_upa = (const float*)d_in[7]; p.w_upr = (const float*)d_in[8]; p.w_out = (const float*)d_in[9];
    p.ln2_g = (const float*)d_in[10]; p.w_ff1 = (const float*)d_in[11]; p.w_ff2 = (const float*)d_in[12];
    p.out = (float*)d_out; p.ws = (unsigned char*)d_ws;
    (void)hipMemsetAsync((unsigned char*)d_ws + mk::WS_BAR, 0, XCD_BAR_WORDS * sizeof(unsigned), stream);
    void* args[] = {&p};
    hipError_t e = hipLaunchCooperativeKernel((const void*)mk::hybrid_fwd, dim3(grid), dim3(mk::NTHR), args, mk::LDS_BYTES, stream);
    if (e != hipSuccess) fprintf(stderr, "kernel_launch: cooperative launch failed: %s (grid %d)\n", hipGetErrorString(e), grid);
}
```

```cpp
#include <hip/hip_runtime.h>
#include <hip/hip_cooperative_groups.h>
#include <cstdio>
#include <cstdint>
#ifndef REP_PRO
#define REP_PRO 1
#endif
#ifndef REP_P2
#define REP_P2 1
#endif
#ifndef REP_P3
#define REP_P3 1
#endif
#ifndef REP_P4
#define REP_P4 1
#endif
#ifndef GA_
#define GA_ true
#define GS_ true
#endif
namespace cg = cooperative_groups;
namespace pg8 {
#define PG8_LAS __attribute__((address_space(3)))
typedef unsigned short bf16_t;
typedef short bf16x8 __attribute__((ext_vector_type(8)));
typedef float f32x4 __attribute__((ext_vector_type(4)));
typedef unsigned u32x4 __attribute__((ext_vector_type(4)));
constexpr int BM = 256, BK = 64, HALF = 128, HTB = HALF * BK * 2  , STAGE_BYTES = 8 * HTB, NXCD = 8, WGM = 8;

__host__ __device__ __forceinline__ int lds_byte(int r, int c) { const int st = (r >> 4) * 2 + (c >> 5), rr = r & 15, cc = c & 31, ob = rr * 64 + cc * 2; return st * 1024 + (ob ^ (((ob >> 9) & 1) << 5)); }
__host__ __device__ __forceinline__ void stage_rc(int b, int& R, int& C) { const int st = b / 1024, sb = b % 1024, swz = sb ^ (((sb >> 9) & 1) << 5); R = (st >> 1) * 16 + swz / 64; C = (st & 1) * 32 + (swz % 64) / 2; }
__host__ __device__ __forceinline__ int perm32(int rho) { const int n = rho >> 4, i = rho & 15; return 8 * (i >> 2) + 4 * n + (i & 3); }

struct Unit { int pm, pn; };
struct Gemm { const bf16_t* A; const bf16_t* Bt; int M, N, K; };

struct StaticOrder {
    int nM, nN, nwg, G, c;
    __host__ __device__ void init(int M, int N, int G_, int c_) { nM = M / BM; nN = N / BM; nwg = nM * nN; G = G_; c = c_; }
    __host__ __device__ bool next(int i, Unit& u) const {
        const long L = (long)i * G + c; if (L >= nwg) return false;
        int wgid = (int)L; { const int q = nwg / NXCD, r = nwg % NXCD, xcd = wgid % NXCD, off = wgid / NXCD; wgid = (xcd < r ? xcd * (q + 1) : r * (q + 1) + (xcd - r) * q) + off; }
        const int nig = WGM * nN, gid = wgid / nig, fm = gid * WGM, gsz = (nM - fm) < WGM ? (nM - fm) : WGM;
        u.pm = fm + ((wgid % nig) % gsz); u.pn = (wgid % nig) / gsz; return true;
    }
    __device__ __forceinline__ void a_ready(const Unit&) const {}
    __device__ __forceinline__ void done(const Unit&) const {}
};

__device__ __forceinline__ unsigned cvt_pk_bf16(float lo, float hi) { unsigned r; asm volatile("v_cvt_pk_bf16_f32 %0, %1, %2" : "=v"(r) : "v"(lo), "v"(hi)); return r; }
template <class Epi, class Sched, bool ALIGN_EPI = false, bool SP2 = false>
__device__ __forceinline__ void gemm_phase(PG8_LAS unsigned char* lds, const Gemm g, const Sched& S, const Epi& E) {
    int tid_ = threadIdx.x; asm volatile("" : "+v"(tid_)); const int tid = tid_, wid = __builtin_amdgcn_readfirstlane(tid >> 6), lane = tid & 63, wr = wid >> 2, wc = wid & 3, fr = lane & 15, fq = lane >> 4;
    const int K = g.K, nt = K / BK;
    unsigned voffA[2], voffB[2];
#pragma unroll
    for (int i = 0; i < 2; ++i) { int R, C; stage_rc(tid * 16 + i * 8192, R, C); const int Rb = Epi::PERM ? ((R & ~31) + perm32(R & 31)) : R;
        voffA[i] = (unsigned)(R * K + C) * 2u; voffB[i] = (unsigned)(Rb * K + C) * 2u; }
    const size_t kstep = (size_t)(BK * 2);
    const size_t hstep = (size_t)HALF * K * 2;
    const size_t tstep = 2 * hstep;
    const unsigned ldsw = (unsigned)wid * 1024u;
    const int aoff = lds_byte(wr * 64 + fr, fq * 8), boff = lds_byte(wc * 32 + fr, fq * 8);
#define PG8_SA(b, h) (((b) * 2 + (h)) * HTB)
#define PG8_SB(b, h) ((4 + (b) * 2 + (h)) * HTB)
#define PG8_STAGE(bufoff, gbase, voff) do { _Pragma("unroll") for (int _i = 0; _i < 2; ++_i) \
        __builtin_amdgcn_global_load_lds((const unsigned*)((const char*)(gbase) + (voff)[_i]), (PG8_LAS unsigned*)(lds + (bufoff) + ldsw + _i * 8192), 16, 0, 0); } while (0)
#define PG8_LDA(dst, b, h) do { _Pragma("unroll") for (int m = 0; m < 4; ++m) _Pragma("unroll") for (int k = 0; k < 2; ++k) dst[m][k] = *(const PG8_LAS bf16x8*)(lds + PG8_SA(b, h) + aoff + m * 2048 + k * 1024); } while (0)
#define PG8_LDB(dst, b, h) do { _Pragma("unroll") for (int n = 0; n < 2; ++n) _Pragma("unroll") for (int k = 0; k < 2; ++k) dst[n][k] = *(const PG8_LAS bf16x8*)(lds + PG8_SB(b, h) + boff + n * 2048 + k * 1024); } while (0)
#define PG8_MMA(ai, bj, At, Bt) do { __builtin_amdgcn_s_setprio(1); _Pragma("unroll") for (int m = 0; m < 4; ++m) _Pragma("unroll") for (int n = 0; n < 2; ++n) _Pragma("unroll") for (int k = 0; k < 2; ++k) \
        acc[ai][bj][m][n] = __builtin_amdgcn_mfma_f32_16x16x32_bf16(Bt[n][k], At[m][k], acc[ai][bj][m][n], 0, 0, 0); __builtin_amdgcn_s_setprio(0); } while (0)
#define PG8_WAIT_V(n) asm volatile("s_waitcnt vmcnt(" #n ")" ::: "memory")
#define PG8_WAIT_L(n) asm volatile("s_waitcnt lgkmcnt(" #n ")" ::: "memory")
#define PG8_BAR __builtin_amdgcn_s_barrier()
#define PG8_SCHED __builtin_amdgcn_sched_barrier(0)
    Unit cur, nxt; int ui = 0;
    if (!S.next(0, cur)) return;
    f32x4 acc[2][2][4][2];
#pragma unroll
    for (int a = 0; a < 2; ++a)
#pragma unroll
        for (int b = 0; b < 2; ++b)
#pragma unroll
            for (int m = 0; m < 4; ++m)
#pragma unroll
                for (int n = 0; n < 2; ++n) acc[a][b][m][n] = (f32x4){0.f, 0.f, 0.f, 0.f};
    bf16x8 At[4][2], B0[2][2], B1[2][2];
    const char* cA = (const char*)g.A + (size_t)cur.pm * tstep; const char* cB = (const char*)g.Bt + (size_t)cur.pn * tstep;
    S.a_ready(cur);
    if constexpr (SP2) {
        PG8_STAGE(PG8_SB(0, 0), cB, voffB); PG8_STAGE(PG8_SB(0, 1), cB + hstep, voffB); PG8_STAGE(PG8_SA(0, 0), cA, voffA); PG8_STAGE(PG8_SA(0, 1), cA + hstep, voffA);
        if (wr == 1) PG8_BAR;
        PG8_WAIT_V(2); PG8_BAR;
        PG8_STAGE(PG8_SB(1, 0), cB + kstep, voffB); PG8_STAGE(PG8_SA(1, 0), cA + kstep, voffA); PG8_STAGE(PG8_SB(1, 1), cB + hstep + kstep, voffB);
        PG8_WAIT_V(6); PG8_BAR;
    } else {
        PG8_STAGE(PG8_SB(0, 0), cB, voffB); PG8_STAGE(PG8_SA(0, 0), cA, voffA); PG8_STAGE(PG8_SB(0, 1), cB + hstep, voffB); PG8_STAGE(PG8_SA(0, 1), cA + hstep, voffA);
        if (wr == 1) PG8_BAR;
        PG8_WAIT_V(4); PG8_BAR;
        PG8_STAGE(PG8_SB(1, 0), cB + kstep, voffB); PG8_STAGE(PG8_SA(1, 0), cA + kstep, voffA); PG8_STAGE(PG8_SB(1, 1), cB + hstep + kstep, voffB);
        PG8_WAIT_V(6); PG8_BAR;
    }
    for (;;) {
        const bool has_next = S.next(ui + 1, nxt);
        const char* nA = has_next ? (const char*)g.A + (size_t)nxt.pm * tstep : cA; const char* nB = has_next ? (const char*)g.Bt + (size_t)nxt.pn * tstep : cB;
        for (int t = 0; t < nt; t += 2) {
            if constexpr (Epi::MID_HOOK) { if (t == (nt >> 1)) E.mid(acc, cur, wr, wc, fr, fq); }
            const bool last = (t == nt - 2);
            const char* a1 = cA + (size_t)(t + 1) * kstep;
            const char* a2 = last ? nA : cA + (size_t)(t + 2) * kstep; const char* b2 = last ? nB : cB + (size_t)(t + 2) * kstep;
            const char* a3 = a2 + kstep; const char* b3 = b2 + kstep;
            if (last && has_next) S.a_ready(nxt);
            if constexpr (SP2) {
            PG8_LDB(B0, 0, 0); PG8_LDB(B1, 0, 1); PG8_SCHED; PG8_LDA(At, 0, 0); PG8_STAGE(PG8_SA(1, 1), a1 + hstep, voffA);
            PG8_WAIT_V(8); PG8_WAIT_L(0); PG8_BAR; PG8_MMA(0, 0, At, B0); PG8_MMA(0, 1, At, B1); PG8_BAR; PG8_SCHED;
            PG8_LDA(At, 0, 1); PG8_STAGE(PG8_SB(0, 0), b2, voffB); PG8_STAGE(PG8_SB(0, 1), b2 + hstep, voffB); PG8_STAGE(PG8_SA(0, 0), a2, voffA);
            PG8_WAIT_V(8); PG8_WAIT_L(0); PG8_BAR; PG8_MMA(1, 0, At, B0); PG8_MMA(1, 1, At, B1); PG8_BAR; PG8_SCHED;
            PG8_LDB(B0, 1, 0); PG8_LDB(B1, 1, 1); PG8_SCHED; PG8_LDA(At, 1, 0); PG8_STAGE(PG8_SA(0, 1), a2 + hstep, voffA);
            PG8_WAIT_V(8); PG8_WAIT_L(0); PG8_BAR; PG8_MMA(0, 0, At, B0); PG8_MMA(0, 1, At, B1); PG8_BAR; PG8_SCHED;
            PG8_LDA(At, 1, 1); PG8_STAGE(PG8_SB(1, 0), b3, voffB); PG8_STAGE(PG8_SB(1, 1), b3 + hstep, voffB); PG8_STAGE(PG8_SA(1, 0), a3, voffA);
            PG8_WAIT_V(8); PG8_WAIT_L(0); PG8_BAR; PG8_MMA(1, 0, At, B0); PG8_MMA(1, 1, At, B1); PG8_BAR; PG8_SCHED;
            } else {
            PG8_LDB(B0, 0, 0); PG8_SCHED; PG8_LDA(At, 0, 0); PG8_STAGE(PG8_SA(1, 1), a1 + hstep, voffA);
            PG8_WAIT_L(8); PG8_BAR; PG8_WAIT_L(0); PG8_MMA(0, 0, At, B0); PG8_BAR; PG8_SCHED;
            PG8_LDB(B1, 0, 1); PG8_STAGE(PG8_SB(0, 0), b2, voffB);
            PG8_BAR; PG8_WAIT_L(0); PG8_MMA(0, 1, At, B1); PG8_BAR;
            PG8_LDA(At, 0, 1); PG8_STAGE(PG8_SA(0, 0), a2, voffA);
            PG8_BAR; PG8_WAIT_L(0); PG8_MMA(1, 0, At, B0); PG8_BAR; PG8_SCHED;
            PG8_STAGE(PG8_SB(0, 1), b2 + hstep, voffB);
            PG8_WAIT_V(6); PG8_BAR; PG8_MMA(1, 1, At, B1); PG8_BAR;
            PG8_LDB(B0, 1, 0); PG8_SCHED; PG8_LDA(At, 1, 0); PG8_STAGE(PG8_SA(0, 1), a2 + hstep, voffA);
            PG8_WAIT_L(8); PG8_BAR; PG8_WAIT_L(0); PG8_MMA(0, 0, At, B0); PG8_BAR; PG8_SCHED;
            PG8_LDB(B1, 1, 1); PG8_STAGE(PG8_SB(1, 0), b3, voffB);
            PG8_BAR; PG8_WAIT_L(0); PG8_MMA(0, 1, At, B1); PG8_BAR;
            PG8_LDA(At, 1, 1); PG8_STAGE(PG8_SA(1, 0), a3, voffA);
            PG8_BAR; PG8_WAIT_L(0); PG8_MMA(1, 0, At, B0); PG8_BAR; PG8_SCHED;
            PG8_STAGE(PG8_SB(1, 1), b3 + hstep, voffB);
            PG8_WAIT_V(6); PG8_BAR; PG8_MMA(1, 1, At, B1); PG8_BAR;
            }
        }
        if constexpr (ALIGN_EPI) { if (wr == 0) PG8_BAR; }
        if constexpr (!Epi::AFTER_DRAIN) { E(acc, cur, wr, wc, fr, fq); S.done(cur); }
        if (!has_next) break;
#pragma unroll
        for (int a = 0; a < 2; ++a)
#pragma unroll
            for (int b = 0; b < 2; ++b)
#pragma unroll
                for (int m = 0; m < 4; ++m)
#pragma unroll
                    for (int n = 0; n < 2; ++n) acc[a][b][m][n] = (f32x4){0.f, 0.f, 0.f, 0.f};
        cur = nxt; cA = nA; cB = nB; ++ui;
        if constexpr (ALIGN_EPI) { if (wr == 1) PG8_BAR; }
    }
    PG8_WAIT_V(0);
    if constexpr (!ALIGN_EPI) { if (wr == 0) PG8_BAR; }
    PG8_BAR;
    if constexpr (Epi::AFTER_DRAIN) { E.fused(acc, cur, wr, wc, fr, fq, lds, wid, lane); S.done(cur); }
#undef PG8_SA
#undef PG8_SB
#undef PG8_STAGE
#undef PG8_LDA
#undef PG8_LDB
#undef PG8_MMA
#undef PG8_WAIT_V
#undef PG8_WAIT_L
#undef PG8_BAR
#undef PG8_SCHED
}
}

namespace mk {
using pg8::bf16_t; using pg8::bf16x8; using pg8::f32x4; using pg8::u32x4; using pg8::Unit;
typedef float f32x16 __attribute__((ext_vector_type(16)));
typedef unsigned u32x2 __attribute__((ext_vector_type(2)));
#define LAS __attribute__((address_space(3)))

constexpr int NB = 4, SEQ = 2048, DM = 2048, NTOK = NB * SEQ, NL = 2, DIN = 14416, NPAD = 14592, DFF = 8192;
constexpr int NTHR = 512, NWAVE = 8, NMAIN = 14336;
constexpr size_t MiB = 1u << 20;
constexpr size_t WS_WIN = 0;
constexpr size_t WS_WUPA = 114 * MiB;
constexpr size_t WS_WUPR = 130 * MiB;
constexpr size_t WS_WOUT = 146 * MiB;
constexpr size_t WS_WFF1 = 162 * MiB;
constexpr size_t WS_WFF2 = 226 * MiB;
constexpr size_t WS_XB = 290 * MiB;
constexpr size_t WS_PROJ = 322 * MiB;
constexpr size_t WS_Q = WS_PROJ, WS_KRAW = WS_Q + 32 * MiB, WS_KN = WS_KRAW + 8 * MiB, WS_VT = WS_KN + 8 * MiB, WS_IQ = WS_VT + 8 * MiB,
                 WS_RQ = WS_IQ + 16 * MiB, WS_RK = WS_RQ + 16 * MiB, WS_RKT = WS_RK + 16 * MiB, WS_RVT = WS_RKT + 16 * MiB, WS_SRG = WS_RVT + 32 * MiB,
                 WS_SGA = WS_SRG + 32 * MiB, WS_SGB = WS_SGA + 32 * MiB, WS_IK = WS_SGB + 32 * MiB, WS_IW = WS_IK + 1 * MiB;
constexpr size_t WS_HFF = WS_PROJ;
constexpr size_t WS_MASK = 572 * MiB;
constexpr size_t WS_U = 574 * MiB;
constexpr size_t WS_MBUF = WS_U;
constexpr size_t WS_RP = 638 * MiB;
constexpr size_t WS_OATT = 670 * MiB;
constexpr size_t WS_ORET = 702 * MiB;
constexpr size_t WS_MERGED = 734 * MiB;
constexpr size_t WS_ROPE = 766 * MiB;
constexpr size_t WS_RSS = 767 * MiB;
constexpr size_t WS_BAR = 767 * MiB + 512 * 1024;
constexpr size_t WS_END = 768 * MiB;
static_assert(WS_IW + 1 * MiB <= WS_MASK, "proj region");

struct Params {
    const float* x; const float* ln1_g; const float* w_in; const float* qn_g; const float* kn_g; const float* gn_g; const float* gn_b;
    const float* w_upa; const float* w_upr; const float* w_out; const float* ln2_g; const float* w_ff1; const float* w_ff2;
    float* out; unsigned char* ws;
};

typedef const __attribute__((address_space(4))) Params* CP;
__device__ __forceinline__ CP getP() { auto k = __builtin_amdgcn_kernarg_segment_ptr(); asm volatile("" : "+s"(k)); return (CP)k; }
__device__ __forceinline__ float bf2f(unsigned h) { return __uint_as_float(h << 16); }
__device__ __forceinline__ unsigned pk2(float lo, float hi) { return pg8::cvt_pk_bf16(lo, hi); }
__device__ __forceinline__ void st4bf(bf16_t* p, f32x4 v) { *(u32x2*)p = (u32x2){pk2(v[0], v[1]), pk2(v[2], v[3])}; }
__device__ __forceinline__ float shx(float v, int o, int lane) { return __int_as_float(__builtin_amdgcn_ds_bpermute((lane ^ o) << 2, __float_as_int(v))); }
__device__ __forceinline__ int shxi(int v, int o, int lane) { return __builtin_amdgcn_ds_bpermute((lane ^ o) << 2, v); }
__device__ __forceinline__ float x32sum(float v) { auto rr = __builtin_amdgcn_permlane32_swap(__float_as_uint(v), __float_as_uint(v), false, false); return __uint_as_float(rr[0]) + __uint_as_float(rr[1]); }
__device__ __forceinline__ float wave_sum(float v, int lane) {
#pragma unroll
    for (int o = 1; o < 32; o <<= 1) v += shx(v, o, lane);
    return x32sum(v);
}
__device__ __forceinline__ int crow(int r, int hi) { return (r & 3) + 8 * (r >> 2) + 4 * hi; }
__device__ __forceinline__ int kperm(int m) { const int a = m & 3, h1 = (m >> 2) & 1, c = m >> 3; return 16 * (c >> 1) + 8 * h1 + 4 * (c & 1) + a; }
#define MFMA32(a, b, c) __builtin_amdgcn_mfma_f32_32x32x16_bf16((a), (b), (c), 0, 0, 0)
__device__ __forceinline__ bf16x8 pack8(const float* f) { u32x4 w; w.x = pk2(f[0], f[1]); w.y = pk2(f[2], f[3]); w.z = pk2(f[4], f[5]); w.w = pk2(f[6], f[7]); return __builtin_bit_cast(bf16x8, w); }

struct MapIdent { __device__ __forceinline__ int operator()(int n) const { return n; } };
struct MapWin {
    __device__ __forceinline__ int operator()(int n) const {
        if (n < 4096) return n;
        if (n < 6144) { const int t = n - 4096, which = t >> 10, tt = t & 1023, h = tt >> 7, lc = tt & 127; return (which ? 5200 : 4176) + h * 128 + (lc >> 1) + 64 * (lc & 1); }
        if (n < 8192) return 6224 + (n - 6144);
        if (n < 10240) return 8272 + (n - 8192);
        if (n < 12288) return 10320 + (n - 10240);
        if (n < 14336) return 12368 + (n - 12288);
        if (n < 14416) return 4096 + (n - 14336);
        return -1;
    }
};
__device__ __forceinline__ void transpose64(const float* __restrict__ W, int K, int N, bf16_t* WT, const float* __restrict__ gk, int k0, int c0, int ncols, int d0, int ds, LAS float* scr, int lane, int ldk = 0, int fragn0 = -1) {
    if (ldk == 0) ldk = K;
    const int lr = lane >> 4, lc4 = (lane & 15) * 4;
    f32x4 v[16];
#pragma unroll
    for (int i = 0; i < 16; ++i) { const int kk = 4 * i + lr; v[i] = (lc4 < ncols) ? __builtin_nontemporal_load((const f32x4*)(W + (size_t)(k0 + kk) * N + c0 + lc4)) : (f32x4){0.f, 0.f, 0.f, 0.f}; }
#pragma unroll
    for (int i = 0; i < 16; ++i) { const int kk = 4 * i + lr; const float g = gk ? gk[k0 + kk] : 1.0f; LAS float* d = scr + kk * 65 + lc4; d[0] = v[i][0] * g; d[1] = v[i][1] * g; d[2] = v[i][2] * g; d[3] = v[i][3] * g; }
    asm volatile("s_waitcnt lgkmcnt(0)" ::: "memory");
    const int c = lane & 7;
#pragma unroll
    for (int j = 0; j < 8; ++j) { const int n = (lane >> 3) + 8 * j; const LAS float* sp = scr + (8 * c) * 65 + n;
        u32x4 o; o.x = pk2(sp[0 * 65], sp[1 * 65]); o.y = pk2(sp[2 * 65], sp[3 * 65]); o.z = pk2(sp[4 * 65], sp[5 * 65]); o.w = pk2(sp[6 * 65], sp[7 * 65]);
        if (fragn0 < 0) { if (n < ncols) *(u32x4*)(WT + (size_t)(d0 + ds * n) * ldk + k0 + 8 * c) = o; }
        else if (n < 32) { const int nn = fragn0 + n, kq = k0 + 8 * c; if (n >= ncols) o = (u32x4){0u, 0u, 0u, 0u};
            *(u32x4*)(WT + ((size_t)(((nn >> 5) * (K >> 4) + (kq >> 4)) * 2 + ((kq >> 3) & 1)) * 32 + (nn & 31)) * 8) = o; } }
    asm volatile("s_waitcnt lgkmcnt(0)" ::: "memory");
}

__device__ __forceinline__ void prologue(CP pp, LAS unsigned char* lds, int gw, int NGW, int wave, int lane) {
    Params P; P.x = pp->x; P.ln1_g = pp->ln1_g; P.w_in = pp->w_in; P.w_upa = pp->w_upa; P.w_upr = pp->w_upr; P.w_out = pp->w_out; P.ln2_g = pp->ln2_g; P.w_ff1 = pp->w_ff1; P.w_ff2 = pp->w_ff2; P.ws = pp->ws; unsigned char* ws = P.ws;
    LAS float* scr = (LAS float*)(lds + wave * 16640);
    constexpr int T_IN = 226, I_IN = 32 * T_IN, I_SQ = 32 * 32, I_F1 = 32 * 128, I_F2 = 128 * 32, I_L = I_IN + 3 * I_SQ + I_F1 + I_F2;
    for (int it = gw; it < NL * I_L; it += NGW) {
        const int itr = NL * I_L - 1 - it;
        const int l = itr / I_L; int r = itr % I_L;
        if (r < I_IN) {
            const int kb = r / T_IN, t = r % T_IN; int c0, d0, ds = 1, nc = 64;
            if (t < 64) { c0 = 64 * t; d0 = c0; }
            else if (t == 64 || t == 65) {
                bf16_t* wt = (bf16_t*)(ws + WS_WIN + l * 57 * MiB) + (size_t)NMAIN * DM;
                transpose64(P.w_in + (size_t)l * DM * DIN, DM, DIN, wt, P.ln1_g + l * DM, 64 * kb, t == 64 ? 4096 : 4160, t == 64 ? 64 : 16, 0, 1, scr, lane, 0, t == 64 ? 0 : 64);
                if (t == 64) transpose64(P.w_in + (size_t)l * DM * DIN, DM, DIN, wt, P.ln1_g + l * DM, 64 * kb, 4096 + 32, 32, 0, 1, scr, lane, 0, 32);
                continue; }
            else if (t < 98) { const int q = t - 66, which = q >> 4, rr = q & 15, h = rr >> 1, half = rr & 1; c0 = (which ? 5200 : 4176) + h * 128 + 64 * half; d0 = (which ? 5120 : 4096) + h * 128 + half; ds = 2; }
            else { const int q = t - 98; c0 = 6224 + 64 * q; d0 = 6144 + 64 * q; }
            transpose64(P.w_in + (size_t)l * DM * DIN, DM, DIN, (bf16_t*)(ws + WS_WIN + l * 57 * MiB), P.ln1_g + l * DM, 64 * kb, c0, nc, d0, ds, scr, lane); continue; }
        r -= I_IN;
        if (r < 3 * I_SQ) { const int w = r / I_SQ, q = r % I_SQ, kb = q >> 5, t = q & 31; const float* src = (w == 0 ? P.w_upa : (w == 1 ? P.w_upr : P.w_out)) + (size_t)l * DM * DM;
            bf16_t* dst = (w == 2) ? (bf16_t*)(ws + WS_WOUT + l * 8 * MiB) : (bf16_t*)(ws + WS_WUPA + l * 16 * MiB) + (w == 1 ? DM : 0);
            transpose64(src, DM, DM, dst, nullptr, 64 * kb, 64 * t, 64, 64 * t, 1, scr, lane, (w == 2) ? DM : 2 * DM); continue; }
        r -= 3 * I_SQ;
        if (r < I_F1) { const int kb = r >> 7, t = r & 127; transpose64(P.w_ff1 + (size_t)l * DM * DFF, DM, DFF, (bf16_t*)(ws + WS_WFF1 + l * 32 * MiB), P.ln2_g + l * DM, 64 * kb, 64 * t, 64, 64 * t, 1, scr, lane); continue; }
        r -= I_F1;
        { const int kb = r >> 5, t = r & 31; transpose64(P.w_ff2 + (size_t)l * DFF * DM, DFF, DM, (bf16_t*)(ws + WS_WFF2 + l * 32 * MiB), nullptr, 64 * kb, 64 * t, 64, 64 * t, 1, scr, lane); }
    }
    bf16_t* XB = (bf16_t*)(ws + WS_XB); float* RSS = (float*)(ws + WS_RSS);
    for (int m = gw; m < NTOK; m += NGW) {
        const f32x4* xr = (const f32x4*)(P.x + (size_t)m * DM) + lane; float ss = 0.f;
#pragma unroll
        for (int j = 0; j < 8; ++j) { const f32x4 v = xr[64 * j]; ss += (v[0] * v[0] + v[1] * v[1]) + (v[2] * v[2] + v[3] * v[3]); st4bf(XB + (size_t)m * DM + 4 * lane + 256 * j, v); }
        ss = wave_sum(ss, lane);
        if (lane == 0) RSS[m] = ss;
    }
    for (int i = gw * 64 + lane; i < 3 * NTOK; i += NGW * 64) RSS[NTOK + i] = 0.f;
    float* rope = (float*)(ws + WS_ROPE);
    for (int i = gw * 64 + lane; i < SEQ * 64; i += NGW * 64) {
        const int pos = i >> 6, fi = i & 63;
        const float invf = (float)exp(-(double)fi * (9.210340371976184 / 64.0));
        const float angf = (float)pos * invf;
        const double a = (double)angf; const double k = rint(a * 0.15915494309189535); const double r = a - k * 6.283185307179586477;
        const double r2 = r * r; double ts = r, ss = r, tc = 1.0, cc = 1.0;
#pragma unroll
        for (int n = 1; n <= 14; ++n) { ts *= -r2 * (1.0 / (double)((2 * n) * (2 * n + 1))); ss += ts; tc *= -r2 * (1.0 / (double)((2 * n - 1) * (2 * n))); cc += tc; }
        rope[2 * i] = (float)cc; rope[2 * i + 1] = (float)ss;
    }
}

#define EPI_ROWS(...) _Pragma("unroll") for (int ai = 0; ai < 2; ++ai) _Pragma("unroll") for (int m = 0; m < 4; ++m) { int row_ = u.pm * 256 + ai * 128 + wr * 64 + m * 16 + fr; asm volatile("" : "+v"(row_) :: "memory"); const int row = row_; __VA_ARGS__ }
#define EPI_COLS8(...) _Pragma("unroll") for (int bj = 0; bj < 2; ++bj) { const int lc = bj * 128 + wc * 32 + 8 * fq; const f32x4 a0 = acc[ai][bj][m][0], a1 = acc[ai][bj][m][1]; __VA_ARGS__ }

__device__ __forceinline__ float sigm(float x) { return __builtin_amdgcn_rcpf(1.0f + __builtin_amdgcn_exp2f(-1.4426950408889634f * x)); }
__device__ __forceinline__ f32x4 sigm4(f32x4 v) { return (f32x4){sigm(v[0]), sigm(v[1]), sigm(v[2]), sigm(v[3])}; }
__device__ __forceinline__ void st8bf(bf16_t* p, f32x4 v0, f32x4 v1) { *(u32x4*)p = (u32x4){pk2(v0[0], v0[1]), pk2(v0[2], v0[3]), pk2(v1[0], v1[1]), pk2(v1[2], v1[3])}; }
__device__ __forceinline__ void st8col(bf16_t* d, int stride, f32x4 v0, f32x4 v1) {
    d[0] = (bf16_t)pk2(v0[0], 0.f); d[stride] = (bf16_t)pk2(v0[1], 0.f); d[2 * stride] = (bf16_t)pk2(v0[2], 0.f); d[3 * stride] = (bf16_t)pk2(v0[3], 0.f);
    d[4 * stride] = (bf16_t)pk2(v1[0], 0.f); d[5 * stride] = (bf16_t)pk2(v1[1], 0.f); d[6 * stride] = (bf16_t)pk2(v1[2], 0.f); d[7 * stride] = (bf16_t)pk2(v1[3], 0.f);
}
__device__ __forceinline__ f32x4 bflo4(u32x4 w) { return (f32x4){bf2f(w.x & 0xffffu), bf2f(w.x >> 16), bf2f(w.y & 0xffffu), bf2f(w.y >> 16)}; }
__device__ __forceinline__ f32x4 bfhi4(u32x4 w) { return (f32x4){bf2f(w.z & 0xffffu), bf2f(w.z >> 16), bf2f(w.w & 0xffffu), bf2f(w.w >> 16)}; }

struct EpiIn {
    static constexpr bool PERM = true, AFTER_DRAIN = false, MID_HOOK = false;
    const float* rss; unsigned char* ws;
    __device__ __forceinline__ void operator()(const f32x4 (&acc)[2][2][4][2], const Unit& u, int wr, int wc, int fr, int fq) const {
        asm volatile("" : "+v"(fr), "+v"(fq));
        const int pn = u.pn;
        bf16_t* Q = (bf16_t*)(ws + WS_Q); bf16_t* KR = (bf16_t*)(ws + WS_KRAW); bf16_t* VT = (bf16_t*)(ws + WS_VT); bf16_t* IQ = (bf16_t*)(ws + WS_IQ);
        bf16_t* RQ = (bf16_t*)(ws + WS_RQ); bf16_t* RK = (bf16_t*)(ws + WS_RK); bf16_t* RKT = (bf16_t*)(ws + WS_RKT); bf16_t* RVT = (bf16_t*)(ws + WS_RVT);
        bf16_t* SRG = (bf16_t*)(ws + WS_SRG); bf16_t* SGA = (bf16_t*)(ws + WS_SGA); bf16_t* SGB = (bf16_t*)(ws + WS_SGB);
        const float* rope = (const float*)(ws + WS_ROPE);
#define RS const float rs = __builtin_amdgcn_rsqf(rss[row] * (1.0f / 2048.0f) + 1e-6f);
        if (pn < 8) { EPI_ROWS(RS EPI_COLS8(st8bf(Q + (size_t)row * 2048 + pn * 256 + lc, a0 * rs, a1 * rs);)) }
        else if (pn < 10) { EPI_ROWS(RS EPI_COLS8(st8bf(KR + (size_t)row * 512 + (pn - 8) * 256 + lc, a0 * rs, a1 * rs);)) }
        else if (pn < 12) { EPI_ROWS(RS const int b = row >> 11, s = row & 2047; EPI_COLS8(const int c = (pn - 10) * 256 + lc;
                st8col(VT + ((((size_t)(b * 4 + (c >> 7)) * 32 + (s >> 6)) * 128 + (c & 127)) * 64 + (s & 63)), 64, a0 * rs, a1 * rs);)) }
        else if (pn < 16) { EPI_ROWS(RS EPI_COLS8(st8bf(IQ + (size_t)row * 1024 + (pn - 12) * 256 + lc, a0 * rs, a1 * rs);)) }
        else if (pn < 24) { const bool isk = pn >= 20; const int cb = (pn - (isk ? 20 : 16)) * 256; const float scl = isk ? 0.08838834764831845f : 1.0f;
            EPI_ROWS(RS const int b = row >> 11, s = row & 2047; EPI_COLS8(const f32x4 v0 = a0 * (rs * scl), v1 = a1 * (rs * scl);
                const float* rp = rope + ((size_t)s * 64 + ((lc & 127) >> 1)) * 2; const f32x4 cA = *(const f32x4*)rp, cB = *(const f32x4*)(rp + 4);
                f32x4 o0, o1; o0[0] = v0[0] * cA[0] - v0[1] * cA[1]; o0[1] = v0[1] * cA[0] + v0[0] * cA[1]; o0[2] = v0[2] * cA[2] - v0[3] * cA[3]; o0[3] = v0[3] * cA[2] + v0[2] * cA[3];
                o1[0] = v1[0] * cB[0] - v1[1] * cB[1]; o1[1] = v1[1] * cB[0] + v1[0] * cB[1]; o1[2] = v1[2] * cB[2] - v1[3] * cB[3]; o1[3] = v1[3] * cB[2] + v1[2] * cB[3];
                const int c = cb + lc, dd = c & 127, ii = s & 127;
                const size_t ub = ((size_t)(b * 8 + (c >> 7)) * 16 + (s >> 7)) * 16384;
                const size_t fo = ub + (ii >> 5) * 4096 + (((dd >> 4) * 2 + ((dd >> 3) & 1)) * 32 + (ii & 31)) * 8;
                if (!isk) st8bf(RQ + fo, o0, o1);
                else { st8bf(RK + fo, o0, o1); st8col(RKT + ub + (dd >> 5) * 4096 + (((ii >> 4) * 2 + ((ii >> 3) & 1)) * 32 + (dd & 31)) * 8 + (ii & 7), 8, o0, o1); })) }
        else if (pn < 32) { EPI_ROWS(RS const int b = row >> 11, s = row & 2047; EPI_COLS8(const int c = (pn - 24) * 256 + lc, ee = c & 255, ii = s & 127;
                st8col(RVT + ((size_t)(b * 8 + (c >> 8)) * 16 + (s >> 7)) * 32768 + (ee >> 5) * 4096 + (((ii >> 4) * 2 + ((ii >> 3) & 1)) * 32 + (ee & 31)) * 8 + (ii & 7), 8, a0 * rs, a1 * rs);)) }
        else if (pn < 40) { EPI_ROWS(RS const int b = row >> 11, s = row & 2047; EPI_COLS8(f32x4 v0 = a0 * rs, v1 = a1 * rs; v0 = v0 * sigm4(v0); v1 = v1 * sigm4(v1);
                const int c = (pn - 32) * 256 + lc, e = c & 255, i = s & 127;
                bf16_t* d = SRG + ((size_t)(b * 8 + (c >> 8)) * 16 + (s >> 7)) * 32768 + (i >> 5) * 8192 + (e >> 7) * 4096 + ((e >> 3) & 15) * 256 + (i & 31) * 4;
                st4bf(d, v0); st4bf(d + 128, v1);)) }
        else { bf16_t* G = (pn < 48) ? SGA : SGB; const int cb = (pn - (pn < 48 ? 40 : 48)) * 256;
            EPI_ROWS(RS EPI_COLS8(st8bf(G + (size_t)row * 2048 + cb + lc, sigm4(a0 * rs), sigm4(a1 * rs));)) }
#undef RS
    }
};
struct EpiGate {
    static constexpr bool PERM = true, AFTER_DRAIN = false, MID_HOOK = true;
    const bf16_t* GA; const bf16_t* GB; bf16_t* merged;
    __device__ __forceinline__ void mid(f32x4 (&acc)[2][2][4][2], const Unit& u, int wr, int wc, int fr, int fq) const {
        asm volatile("s_waitcnt vmcnt(0)" : "+v"(fr), "+v"(fq) :: "memory");
        EPI_ROWS(_Pragma("unroll") for (int bj = 0; bj < 2; ++bj) { const int lc = bj * 128 + wc * 32 + 8 * fq; const size_t off = (size_t)row * 2048 + u.pn * 256 + lc;
            const u32x4 ga = *(const u32x4*)(GA + off); const u32x4 gb = *(const u32x4*)(GB + off);
            const f32x4 gb0 = bflo4(gb), gb1 = bfhi4(gb); f32x4 r0 = bflo4(ga), r1 = bfhi4(ga);
            _Pragma("unroll") for (int k = 0; k < 4; ++k) { r0[k] *= __builtin_amdgcn_rcpf(fmaxf(gb0[k], 1e-30f)); r1[k] *= __builtin_amdgcn_rcpf(fmaxf(gb1[k], 1e-30f)); }
            acc[ai][bj][m][0] = acc[ai][bj][m][0] * r0; acc[ai][bj][m][1] = acc[ai][bj][m][1] * r1; })
        asm volatile("s_waitcnt vmcnt(0)" ::: "memory");
    }
    __device__ __forceinline__ void operator()(const f32x4 (&acc)[2][2][4][2], const Unit& u, int wr, int wc, int fr, int fq) const {
        asm volatile("" : "+v"(fr), "+v"(fq));
        EPI_ROWS(EPI_COLS8(const size_t off = (size_t)row * 2048 + u.pn * 256 + lc; const u32x4 g = *(const u32x4*)(GB + off); st8bf(merged + off, a0 * bflo4(g), a1 * bfhi4(g));))
    }
};
struct EpiRes {
    static constexpr bool PERM = true, AFTER_DRAIN = false, MID_HOOK = false;
    const float* xin; float* xout; bf16_t* xb; float* rss;
    __device__ __forceinline__ void operator()(const f32x4 (&acc)[2][2][4][2], const Unit& u, int wr, int wc, int fr, int fq) const {
        asm volatile("" : "+v"(fr), "+v"(fq));
        EPI_ROWS(float ss = 0.f; EPI_COLS8(const size_t off = (size_t)row * 2048 + u.pn * 256 + lc; const f32x4 o0 = *(const f32x4*)(xin + off) + a0, o1 = *(const f32x4*)(xin + off + 4) + a1;
                *(f32x4*)(xout + off) = o0; *(f32x4*)(xout + off + 4) = o1; if (xb) st8bf(xb + off, o0, o1);
                ss += ((o0[0] * o0[0] + o0[1] * o0[1]) + (o0[2] * o0[2] + o0[3] * o0[3])) + ((o1[0] * o1[0] + o1[1] * o1[1]) + (o1[2] * o1[2] + o1[3] * o1[3]));)
            if (rss) { ss += shx(ss, 16, fr + 16 * fq); ss = x32sum(ss); if (fq == 0) atomicAdd(rss + row, ss); })
    }
};
struct EpiFF1 {
    static constexpr bool PERM = true, AFTER_DRAIN = false, MID_HOOK = false;
    const float* rss; bf16_t* H;
    __device__ __forceinline__ void operator()(const f32x4 (&acc)[2][2][4][2], const Unit& u, int wr, int wc, int fr, int fq) const {
        asm volatile("" : "+v"(fr), "+v"(fq));
        EPI_ROWS(const float rs = __builtin_amdgcn_rsqf(rss[row] * (1.0f / 2048.0f) + 1e-6f); EPI_COLS8(f32x4 v0 = a0 * rs, v1 = a1 * rs;
            v0[0] = fmaxf(v0[0], 0.f); v0[1] = fmaxf(v0[1], 0.f); v0[2] = fmaxf(v0[2], 0.f); v0[3] = fmaxf(v0[3], 0.f); v1[0] = fmaxf(v1[0], 0.f); v1[1] = fmaxf(v1[1], 0.f); v1[2] = fmaxf(v1[2], 0.f); v1[3] = fmaxf(v1[3], 0.f);
            st8bf(H + (size_t)row * DFF + u.pn * 256 + lc, v0 * v0, v1 * v1);))
    }
};

__device__ __forceinline__ void tail_block(unsigned char* ws, const bf16_t* Wt, const float* rss, LAS unsigned char* lds, int rb, int wave, int lane) {
    const bf16_t* XB = (const bf16_t*)(ws + WS_XB); bf16_t* IK = (bf16_t*)(ws + WS_IK); float* IW = (float*)(ws + WS_IW);
    const int hi = lane >> 5, l32 = lane & 31, tid = wave * 64 + lane;
    const bf16_t* ap = XB + (size_t)(32 * rb + l32) * 2048 + 256 * wave + 8 * hi;
    const bf16_t* bp = Wt + (size_t)(16 * wave) * 512 + lane * 8;
    f32x16 acc[3];
#pragma unroll
    for (int nb = 0; nb < 3; ++nb) acc[nb] = (f32x16){0.f, 0.f, 0.f, 0.f, 0.f, 0.f, 0.f, 0.f, 0.f, 0.f, 0.f, 0.f, 0.f, 0.f, 0.f, 0.f};
#pragma unroll
    for (int kb = 0; kb < 4; ++kb) {
        bf16x8 af[4], bfr[3][4];
#pragma unroll
        for (int k4 = 0; k4 < 4; ++k4) { af[k4] = *(const bf16x8*)(ap + 16 * (4 * kb + k4));
#pragma unroll
            for (int nb = 0; nb < 3; ++nb) bfr[nb][k4] = *(const bf16x8*)(bp + (size_t)(nb * 128 + 4 * kb + k4) * 512); }
        __builtin_amdgcn_sched_barrier(0);
#pragma unroll
        for (int k4 = 0; k4 < 4; ++k4)
#pragma unroll
            for (int nb = 0; nb < 3; ++nb) acc[nb] = MFMA32(af[k4], bfr[nb][k4], acc[nb]);
        __builtin_amdgcn_sched_barrier(0);
    }
    LAS float* part = (LAS float*)lds;
#pragma unroll
    for (int nb = 0; nb < 3; ++nb)
#pragma unroll
        for (int r = 0; r < 16; ++r) part[wave * 3072 + crow(r, hi) * 96 + 32 * nb + l32] = acc[nb][r];
    __syncthreads();
#pragma unroll
    for (int i = 0; i < 6; ++i) {
        const int idx = tid + 512 * i, row = idx / 96, col = idx % 96;
        float v = 0.f;
#pragma unroll
        for (int w = 0; w < 8; ++w) v += part[w * 3072 + idx];
        const int grow = 32 * rb + row;
        v *= rsqrtf(rss[grow] * (1.0f / 2048.0f) + 1e-6f);
        if (col < 64) IK[(size_t)grow * 64 + col] = (bf16_t)pk2(v, 0.f);
        else if (col < 80) IW[(size_t)grow * 16 + (col - 64)] = v * 0.25f;
    }
    __syncthreads();
}

__device__ __forceinline__ void indexer_group(unsigned char* ws, LAS unsigned char* lds, int grp, int wave, int lane) {
    const bf16_t* IQ = (const bf16_t*)(ws + WS_IQ); const bf16_t* IK = (const bf16_t*)(ws + WS_IK); const float* IW = (const float*)(ws + WS_IW); unsigned* MASK = (unsigned*)(ws + WS_MASK);
    const int b = grp >> 7, T0 = (grp & 127) * 16, t0 = T0 + 2 * wave, hi = lane >> 5, l32 = lane & 31, tid = wave * 64 + lane;
    const size_t rowbase = (size_t)b * SEQ;
    const int atok = (l32 >> 2) & 1, ahead = 4 * (l32 >> 3) + (l32 & 3);
    const bf16_t* ap = IQ + (rowbase + t0 + atok) * 1024 + ahead * 64 + 8 * hi;
    bf16x8 af[4];
#pragma unroll
    for (int kk = 0; kk < 4; ++kk) af[kk] = *(const bf16x8*)(ap + 16 * kk);
    float w[16];
#pragma unroll
    for (int i = 0; i < 4; ++i) { const f32x4 t = *(const f32x4*)(IW + (rowbase + t0 + hi) * 16 + 4 * i); w[4 * i] = t[0]; w[4 * i + 1] = t[1]; w[4 * i + 2] = t[2]; w[4 * i + 3] = t[3]; }
    const int tq = t0 + hi, nj = (t0 + 1) / 32 + 1, nchunk = ((T0 + 15) / 32 + 1 + 7) / 8;
    u32x4 stg[4];
#define IDX_LOAD(c) do { _Pragma("unroll") for (int i = 0; i < 4; ++i) { const int p = tid + 512 * i; stg[i] = *(const u32x4*)(IK + (rowbase + 256 * (c) + (p >> 3)) * 64 + 8 * (p & 7)); } } while (0)
    IDX_LOAD(0);
    unsigned uk[64];
#pragma unroll
    for (int c = 0; c < 8; ++c) {
        if (c < nchunk) {
            __syncthreads();
#pragma unroll
            for (int i = 0; i < 4; ++i) { const int p = tid + 512 * i; *(LAS u32x4*)(lds + (p >> 3) * 144 + (p & 7) * 16) = stg[i]; }
            __syncthreads();
            if (c + 1 < nchunk) IDX_LOAD(c + 1);
#pragma unroll
            for (int jj = 0; jj < 8; ++jj) { const int j = 8 * c + jj;
                if (j < nj) {
                    const LAS unsigned char* bp = lds + (32 * jj + l32) * 144 + 16 * hi;
                    f32x16 cc = {0.f, 0.f, 0.f, 0.f, 0.f, 0.f, 0.f, 0.f, 0.f, 0.f, 0.f, 0.f, 0.f, 0.f, 0.f, 0.f};
#pragma unroll
                    for (int kk = 0; kk < 4; ++kk) cc = MFMA32(af[kk], *(const LAS bf16x8*)(bp + 32 * kk), cc);
                    float sc = 0.f;
#pragma unroll
                    for (int r = 0; r < 16; ++r) sc += w[r] * fmaxf(cc[r], 0.f);
                    const unsigned bits = __float_as_uint(sc); const unsigned ku = bits ^ ((bits >> 31) ? 0xffffffffu : 0x80000000u);
                    uk[j] = (32 * j + l32 <= tq) ? ku : 0u;
                } else uk[j] = 0u; }
        } else {
#pragma unroll
            for (int jj = 0; jj < 8; ++jj) uk[8 * c + jj] = 0u; }
    }
#undef IDX_LOAD
    unsigned p = 0u; bool done = (tq + 1 <= 256);
    for (int bit = 31; bit >= 0; --bit) {
        if (__all(done)) break;
        const unsigned cand = p | (1u << bit);
        int cnt = 0;
#pragma unroll
        for (int g = 0; g < 8; ++g) if (8 * g < nj) {
#pragma unroll
            for (int jj = 0; jj < 8; ++jj) cnt += (uk[8 * g + jj] >= cand) ? 1 : 0; }
        cnt += __builtin_amdgcn_update_dpp(0, cnt, 0xB1, 0xF, 0xF, true); cnt += __builtin_amdgcn_update_dpp(0, cnt, 0x4E, 0xF, 0xF, true);
        cnt += __builtin_amdgcn_update_dpp(0, cnt, 0x141, 0xF, 0xF, true); cnt += __builtin_amdgcn_update_dpp(0, cnt, 0x140, 0xF, 0xF, true);
        { auto rr = __builtin_amdgcn_permlane16_swap((unsigned)cnt, (unsigned)cnt, false, false); cnt = (int)(rr[0] + rr[1]); }
        if (!done && cnt >= 256) { p = cand; if (cnt == 256) done = true; }
    }
    const unsigned thr = (tq + 1 <= 256) ? 1u : (p > 1u ? p : 1u);
    unsigned alo = 0u, ahi = 0u;
#pragma unroll
    for (int j = 0; j < 64; ++j) { const unsigned long long bal = __ballot(uk[j] >= thr); if (lane == j) { alo = (unsigned)bal; ahi = (unsigned)(bal >> 32); } }
    MASK[(rowbase + t0) * 64 + lane] = alo; MASK[(rowbase + t0 + 1) * 64 + lane] = ahi;
}

__device__ __forceinline__ void ra_unit(unsigned char* ws, int unit, int wave, int lane) {
    const bf16_t* RVT = (const bf16_t*)(ws + WS_RVT); const bf16_t* RKT = (const bf16_t*)(ws + WS_RKT); float* U = (float*)(ws + WS_U);
    const int b = unit >> 7, h = (unit >> 4) & 7, n = unit & 15, s0 = n * 128, eb = wave, hi = lane >> 5, l32 = lane & 31;
    const float lg2 = __log2f(1.0f - exp2f(-5.0f - (float)h));
    const bf16_t* vp = RVT + ((size_t)(b * 2048 + h * 256 + 32 * eb + l32)) * 2048 + s0 + 8 * hi;
    bf16x8 af[8];
#pragma unroll
    for (int kk = 0; kk < 8; ++kk) { const bf16x8 raw = *(const bf16x8*)(vp + 16 * kk); float f[8];
#pragma unroll
        for (int i = 0; i < 8; ++i) f[i] = bf2f((unsigned)(unsigned short)raw[i]) * exp2f(lg2 * (float)(127 - (16 * kk + 8 * hi + i)));
        af[kk] = pack8(f); }
    __builtin_amdgcn_sched_barrier(0);
#pragma unroll
    for (int db = 0; db < 4; ++db) {
        bf16x8 bfr[8];
        const bf16_t* kp = RKT + ((size_t)(b * 1024 + h * 128 + 32 * db + l32)) * 2048 + s0 + 8 * hi;
#pragma unroll
        for (int kk = 0; kk < 8; ++kk) bfr[kk] = *(const bf16x8*)(kp + 16 * kk);
        __builtin_amdgcn_sched_barrier(0);
        f32x16 c = {0.f, 0.f, 0.f, 0.f, 0.f, 0.f, 0.f, 0.f, 0.f, 0.f, 0.f, 0.f, 0.f, 0.f, 0.f, 0.f};
#pragma unroll
        for (int kk = 0; kk < 8; ++kk) c = MFMA32(af[kk], bfr[kk], c);
#pragma unroll
        for (int r = 0; r < 16; ++r) U[(size_t)unit * 32768 + (32 * eb + crow(r, hi)) * 128 + 32 * db + l32] = c[r];
        __builtin_amdgcn_sched_barrier(0);
    }
}
__device__ __forceinline__ void rb_scan(unsigned char* ws, int gtid, int nthr) {
    const float* U = (const float*)(ws + WS_U); bf16_t* RP = (bf16_t*)(ws + WS_RP);
    for (int it = gtid; it < 32 * 8192; it += nthr) {
        const int bh = it >> 13, e4 = (it & 8191) * 4, h = bh & 7;
        const float lg2 = __log2f(1.0f - exp2f(-5.0f - (float)h)); const float cd = exp2f(lg2 * 128.0f);
        f32x4 R = {0.f, 0.f, 0.f, 0.f};
#pragma unroll 4
        for (int n = 0; n < 16; ++n) { const size_t off = ((size_t)(bh * 16 + n)) * 32768 + e4; st4bf(RP + off, R); R = *(const f32x4*)(U + off) + R * cd; }
    }
}
__device__ __forceinline__ void stage_put(LAS unsigned char* stg, int lane, int colgrp4  , f32x4 v) {
    *(LAS u32x2*)(stg + (lane & 31) * 272 + colgrp4 * 2) = (u32x2){pk2(v[0], v[1]), pk2(v[2], v[3])};
}
__device__ __forceinline__ void stage_flush(const LAS unsigned char* stg, int lane, bf16_t* out  , size_t row_stride) {
    asm volatile("s_waitcnt lgkmcnt(0)" ::: "memory");
#pragma unroll
    for (int it = 0; it < 8; ++it) { const int row = it * 4 + (lane >> 4), ch = lane & 15; *(u32x4*)(out + (size_t)row * row_stride + ch * 8) = *(const LAS u32x4*)(stg + row * 272 + ch * 16); }
    asm volatile("s_waitcnt lgkmcnt(0)" ::: "memory");
}
__device__ __forceinline__ void rascan_unit(unsigned char* ws, int unit, int wave, int lane) {
    const bf16_t* RVT = (const bf16_t*)(ws + WS_RVT); const bf16_t* RKT = (const bf16_t*)(ws + WS_RKT); bf16_t* RP = (bf16_t*)(ws + WS_RP);
    const int b = unit >> 5, h = (unit >> 2) & 7, dblk = unit & 3, eb = wave, hi = lane >> 5, l32 = lane & 31;
    const float lg2 = __log2f(1.0f - exp2f(-5.0f - (float)h)); const float cd = exp2f(lg2 * 128.0f);
    float zi[8], zk[8];
#pragma unroll
    for (int i = 0; i < 8; ++i) { zi[i] = exp2f(lg2 * (float)(127 - 8 * hi - i)); zk[i] = exp2f(lg2 * (float)(-16 * i)); }
    const bf16_t* vrow = RVT + ((size_t)(b * 8 + h) * 16) * 32768 + eb * 4096 + lane * 8;
    const bf16_t* krow = RKT + ((size_t)(b * 8 + h) * 16) * 16384 + dblk * 4096 + lane * 8;
    const int dq = 32 * dblk + l32; bf16_t* rpo = RP + ((size_t)(b * 8 + h) * 16) * 32768 + eb * 4096 + (((dq >> 4) * 2 + ((dq >> 3) & 1)) * 32 + 4 * hi) * 8 + (dq & 7);
    f32x16 R = {0.f, 0.f, 0.f, 0.f, 0.f, 0.f, 0.f, 0.f, 0.f, 0.f, 0.f, 0.f, 0.f, 0.f, 0.f, 0.f};
    bf16x8 va[8], ka[8];
#define RS_LOAD(n, V, K) do { _Pragma("unroll") for (int kk = 0; kk < 8; ++kk) { V[kk] = *(const bf16x8*)(vrow + (size_t)(n) * 32768 + 512 * kk); K[kk] = *(const bf16x8*)(krow + (size_t)(n) * 16384 + 512 * kk); } } while (0)
#define RS_STEP(n, V, K) do { \
        bf16_t* rp_ = rpo + (size_t)(n) * 32768; \
        _Pragma("unroll") for (int r = 0; r < 16; ++r) rp_[((r & 3) + 8 * (r >> 2)) * 8] = (bf16_t)pk2(R[r], 0.f); \
        f32x16 u_ = {0.f, 0.f, 0.f, 0.f, 0.f, 0.f, 0.f, 0.f, 0.f, 0.f, 0.f, 0.f, 0.f, 0.f, 0.f, 0.f}; \
        _Pragma("unroll") for (int kk = 0; kk < 8; ++kk) { float f_[8]; \
            _Pragma("unroll") for (int i = 0; i < 8; ++i) f_[i] = bf2f((unsigned)(unsigned short)V[kk][i]) * (zk[kk] * zi[i]); \
            u_ = MFMA32(pack8(f_), K[kk], u_); } \
        R = u_ + R * cd; } while (0)
#pragma unroll 1
    for (int n = 0; n < 16; ++n) {
        RS_LOAD(n, va, ka);
        __builtin_amdgcn_sched_barrier(0);
        RS_STEP(n, va, ka);
        __builtin_amdgcn_sched_barrier(0);
    }
#undef RS_LOAD
#undef RS_STEP
}
__device__ __forceinline__ void rc_unit(unsigned char* ws, const float* gn_g, const float* gn_b, LAS unsigned char* lds, int unit, int layer, int wave, int lane) {
    const bf16_t* RQ = (const bf16_t*)(ws + WS_RQ); const bf16_t* RK = (const bf16_t*)(ws + WS_RK); const bf16_t* RVT = (const bf16_t*)(ws + WS_RVT); const bf16_t* RP = (const bf16_t*)(ws + WS_RP);
    const bf16_t* SRG = (const bf16_t*)(ws + WS_SRG); bf16_t* ORET = (bf16_t*)(ws + WS_OATT) + 2048;
    const int b = unit >> 7, h = (unit >> 4) & 7, n = unit & 15, s0 = n * 128, ib = wave >> 1, eh = wave & 1, hi = lane >> 5, l32 = lane & 31;
    const float lg2 = __log2f(1.0f - exp2f(-5.0f - (float)h));
    const size_t tok = (size_t)b * SEQ + s0 + 32 * ib + l32;
    bf16x8 qf[8];
#pragma unroll
    for (int kk = 0; kk < 8; ++kk) qf[kk] = *(const bf16x8*)(RQ + (size_t)unit * 16384 + ib * 4096 + kk * 512 + lane * 8);
    f32x16 acc[4];
    const int iq = 32 * ib + l32;
    bf16x8 pfr[4][2];
    {
        bf16x8 kf[32];
#pragma unroll
        for (int jb = 0; jb < 4; ++jb) { const bf16_t* kp = RK + (size_t)unit * 16384 + jb * 4096 + (hi * 32 + kperm(l32)) * 8;
#pragma unroll
            for (int kk = 0; kk < 8; ++kk) kf[8 * jb + kk] = *(const bf16x8*)(kp + 512 * kk); }
        __builtin_amdgcn_sched_barrier(0);
#pragma unroll
        for (int jb = 0; jb < 4; ++jb) { f32x16 st = {0.f, 0.f, 0.f, 0.f, 0.f, 0.f, 0.f, 0.f, 0.f, 0.f, 0.f, 0.f, 0.f, 0.f, 0.f, 0.f};
#pragma unroll
            for (int kk = 0; kk < 8; ++kk) st = MFMA32(kf[8 * jb + kk], qf[kk], st);
            float f[16];
#pragma unroll
            for (int r = 0; r < 16; ++r) { const int j = 32 * jb + 16 * (r >> 3) + 8 * hi + (r & 7); const int df = iq - j; f[r] = (df >= 0) ? st[r] * exp2f(lg2 * (float)df) : 0.f; }
            pfr[jb][0] = pack8(f); pfr[jb][1] = pack8(f + 8); }
        __builtin_amdgcn_sched_barrier(0);
    }
    int lnc = lane; asm volatile("" : "+v"(lnc)); const int l32c = lnc & 31;
#pragma unroll
    for (int ep = 0; ep < 2; ++ep) {
        bf16x8 rf[16];
#pragma unroll
        for (int e2 = 0; e2 < 2; ++e2) { const int eb = 4 * eh + 2 * ep + e2; const bf16_t* rp = RP + (size_t)unit * 32768 + eb * 4096 + lnc * 8;
#pragma unroll
            for (int kk = 0; kk < 8; ++kk) rf[8 * e2 + kk] = *(const bf16x8*)(rp + 512 * kk); }
        __builtin_amdgcn_sched_barrier(0);
#pragma unroll
        for (int e2 = 0; e2 < 2; ++e2) { f32x16 c = {0.f, 0.f, 0.f, 0.f, 0.f, 0.f, 0.f, 0.f, 0.f, 0.f, 0.f, 0.f, 0.f, 0.f, 0.f, 0.f};
#pragma unroll
            for (int kk = 0; kk < 8; ++kk) c = MFMA32(rf[8 * e2 + kk], qf[kk], c);
            acc[2 * ep + e2] = c * exp2f(lg2 * (float)(32 * ib + l32c + 1)); }
        __builtin_amdgcn_sched_barrier(0);
    }
    int lnv = lane; asm volatile("" : "+v"(lnv)); const int l32v = lnv & 31, hiv = lnv >> 5;
#pragma unroll
    for (int ep = 0; ep < 2; ++ep) {
        bf16x8 vf[16];
#pragma unroll
        for (int e2 = 0; e2 < 2; ++e2) { const int eb = 4 * eh + 2 * ep + e2; const bf16_t* vp = RVT + (size_t)unit * 32768 + eb * 4096 + lnv * 8;
#pragma unroll
            for (int q = 0; q < 8; ++q) vf[8 * e2 + q] = *(const bf16x8*)(vp + 512 * q); }
        __builtin_amdgcn_sched_barrier(0);
#pragma unroll
        for (int e2 = 0; e2 < 2; ++e2)
#pragma unroll
            for (int q = 0; q < 8; ++q) acc[2 * ep + e2] = MFMA32(vf[8 * e2 + q], pfr[q >> 1][q & 1], acc[2 * ep + e2]);
        __builtin_amdgcn_sched_barrier(0);
    }
    float s1 = 0.f, s2 = 0.f;
#pragma unroll
    for (int el = 0; el < 4; ++el)
#pragma unroll
        for (int r = 0; r < 16; ++r) { const float v = acc[el][r]; s1 += v; s2 += v * v; }
    s1 = x32sum(s1); s2 = x32sum(s2);
    LAS float* xs = (LAS float*)lds;
    __syncthreads();
    if (hi == 0) { xs[(wave * 32 + l32) * 2] = s1; xs[(wave * 32 + l32) * 2 + 1] = s2; }
    __syncthreads();
    s1 += xs[((wave ^ 1) * 32 + l32) * 2]; s2 += xs[((wave ^ 1) * 32 + l32) * 2 + 1];
    const float mu = s1 * (1.0f / 256.0f); const float var = fmaxf(s2 * (1.0f / 256.0f) - mu * mu, 0.f); const float rstd = rsqrtf(var + 1e-6f);
    const float* gg = gn_g + layer * 2048 + h * 256; const float* gb = gn_b + layer * 2048 + h * 256;
    int ln2 = lane; asm volatile("" : "+v"(ln2));
    const int hi2 = ln2 >> 5;
    const bf16_t* sgp = SRG + (size_t)unit * 32768 + ib * 8192 + eh * 4096 + ln2 * 4;
    LAS unsigned char* stg = lds + 4096 + wave * 8704;
#pragma unroll
    for (int el = 0; el < 4; ++el)
#pragma unroll
        for (int c4 = 0; c4 < 4; ++c4) {
            const int e0 = 32 * (4 * eh + el) + 8 * c4 + 4 * hi2;
            const f32x4 g4 = *(const f32x4*)(gg + e0), b4 = *(const f32x4*)(gb + e0); const u32x2 sg = *(const u32x2*)(sgp + (el * 4 + c4) * 256);
            f32x4 o;
            o[0] = ((acc[el][4 * c4 + 0] - mu) * rstd * g4[0] + b4[0]) * bf2f(sg.x & 0xffffu);
            o[1] = ((acc[el][4 * c4 + 1] - mu) * rstd * g4[1] + b4[1]) * bf2f(sg.x >> 16);
            o[2] = ((acc[el][4 * c4 + 2] - mu) * rstd * g4[2] + b4[2]) * bf2f(sg.y & 0xffffu);
            o[3] = ((acc[el][4 * c4 + 3] - mu) * rstd * g4[3] + b4[3]) * bf2f(sg.y >> 16);
            stage_put(stg, ln2, 32 * el + 8 * c4 + 4 * hi2, o);
        }
    stage_flush(stg, ln2, ORET + ((size_t)b * SEQ + s0 + 32 * ib) * 4096 + h * 256 + 128 * eh, 4096);
}

constexpr int KT_STRIDE = 136, VT_STRIDE = 72, ATT_K_OFF = 0, ATT_V_OFF = 64 * KT_STRIDE * 2, ATT_BUF = 64 * KT_STRIDE * 2 + 128 * VT_STRIDE * 2, ATT_Q_OFF = 2 * ATT_BUF;
__device__ __forceinline__ void attn_unit(unsigned char* ws, const float* qn_g, const float* kn_g, LAS unsigned char* lds, int unit, int layer, int wave, int lane) {
    const bf16_t* Q = (const bf16_t*)(ws + WS_Q); const bf16_t* KN = (const bf16_t*)(ws + WS_KN); const bf16_t* VT = (const bf16_t*)(ws + WS_VT); const unsigned* MASK = (const unsigned*)(ws + WS_MASK);
    bf16_t* OATT = (bf16_t*)(ws + WS_OATT);
    const int tid = wave * 64 + lane, hi = lane >> 5, l32 = lane & 31;
    int bg, qb; if (unit < 256) { bg = unit >> 4; qb = unit & 15; } else { bg = (unit - 256) >> 4; qb = 31 - ((unit - 256) & 15); }
    const int b = bg >> 2, g = bg & 3, hh = g * 4 + (wave >> 1), q0 = qb * 64, qs = q0 + 32 * (wave & 1);
    const size_t tok = (size_t)b * SEQ + qs + l32;
    bf16x8 qf[8]; float mfix;
    {
        float ss = 0.f;
        const bf16_t* qp = Q + tok * 2048 + hh * 128 + 8 * hi;
#pragma unroll
        for (int kk = 0; kk < 8; ++kk) { qf[kk] = *(const bf16x8*)(qp + 16 * kk);
#pragma unroll
            for (int i = 0; i < 8; ++i) { const float v = bf2f((unsigned)(unsigned short)qf[kk][i]); ss += v * v; } }
        ss = x32sum(ss);
        const float rs = rsqrtf(ss * (1.0f / 128.0f) + 1e-6f) * (0.08838834764831845f * 1.4426950408889634f);
        const float* qg = qn_g + layer * 128 + 8 * hi; float s2 = 0.f;
#pragma unroll
        for (int kk = 0; kk < 8; ++kk) { float f[8];
#pragma unroll
            for (int i = 0; i < 8; ++i) { f[i] = bf2f((unsigned)(unsigned short)qf[kk][i]) * rs * qg[16 * kk + i]; s2 += f[i] * f[i]; }
            *(LAS bf16x8*)(lds + ATT_Q_OFF + wave * 8192 + kk * 1024 + lane * 16) = pack8(f); }
        s2 = x32sum(s2);
        float gm = fmaxf(fabsf(kn_g[layer * 128 + 2 * lane]), fabsf(kn_g[layer * 128 + 2 * lane + 1]));
#pragma unroll
        for (int o = 1; o < 64; o <<= 1) gm = fmaxf(gm, shx(gm, o, lane));
        mfix = sqrtf(s2) * 11.313708498984761f * gm * 1.01f + 0.01f;
    }
    f32x16 o[4];
#pragma unroll
    for (int d = 0; d < 4; ++d) o[d] = (f32x16){0.f, 0.f, 0.f, 0.f, 0.f, 0.f, 0.f, 0.f, 0.f, 0.f, 0.f, 0.f, 0.f, 0.f, 0.f, 0.f};
    float lrun = 0.f;
    const int nt = qb + 1;
    const bf16_t* kbase = KN + ((size_t)(b * 4 + g) * SEQ) * 128; const bf16_t* vbase = VT + ((size_t)(b * 4 + g) * 32) * 8192;
    u32x4 kst[2], vst[2];
    unsigned koff[2], voff[2];
#pragma unroll
    for (int i = 0; i < 2; ++i) { const int p = tid + 512 * i; koff[i] = (unsigned)(p * 16); voff[i] = (unsigned)(p * 16); }
#define ATT_LOAD(t) do { const char* kb_ = (const char*)(kbase + (size_t)(t) * 8192); const char* vb_ = (const char*)(vbase + (size_t)(t) * 8192); \
        _Pragma("unroll") for (int i = 0; i < 2; ++i) { kst[i] = *(const u32x4*)(kb_ + koff[i]); vst[i] = *(const u32x4*)(vb_ + voff[i]); } } while (0)
#define ATT_STORE(buf) do { _Pragma("unroll") for (int i = 0; i < 2; ++i) { const int p = tid + 512 * i; *(LAS u32x4*)(lds + (buf) * ATT_BUF + ATT_K_OFF + ((p >> 4) * KT_STRIDE + 8 * (p & 15)) * 2) = kst[i]; \
        *(LAS u32x4*)(lds + (buf) * ATT_BUF + ATT_V_OFF + ((p >> 3) * VT_STRIDE + 8 * (p & 7)) * 2) = vst[i]; } } while (0)
    __builtin_amdgcn_sched_barrier(0);
    const char* mbase = (const char*)(MASK + ((size_t)b * SEQ + qs) * 64); const unsigned moff = (unsigned)l32 * 256u;
    u32x2 mwn = *(const u32x2*)(mbase + moff);
    ATT_LOAD(0);
    __syncthreads();
    ATT_STORE(0);
    __syncthreads();
    for (int t = 0; t < nt; ++t) {
        const int cur = t & 1;
        const u32x2 mw = mwn;
        if (t + 1 < nt) { mwn = *(const u32x2*)(mbase + (moff + 8u * (unsigned)(t + 1))); ATT_LOAD(t + 1); }
        float psum = 0.f; bf16x8 pf[2][2];
        const LAS unsigned char* kp = lds + cur * ATT_BUF + ATT_K_OFF + (kperm(l32) * KT_STRIDE + 8 * hi) * 2;
        const LAS unsigned char* vp = lds + cur * ATT_BUF + ATT_V_OFF + (l32 * VT_STRIDE + 8 * hi) * 2;
#define KFR(p, kk) (*(const LAS bf16x8*)(kp + (p) * (32 * KT_STRIDE * 2) + 32 * (kk)))
#define VFR(d, q) (*(const LAS bf16x8*)(vp + (d) * (32 * VT_STRIDE * 2) + 32 * (q)))
        f32x16 c0, c1;
#pragma unroll
        for (int r = 0; r < 16; ++r) { c0[r] = -mfix; c1[r] = -mfix; }
        const LAS unsigned char* qpk = lds + ATT_Q_OFF + wave * 8192 + lane * 16;
#define QFR(kk) (*(const LAS bf16x8*)(qpk + (kk) * 1024))
        bf16x8 fA[4], fB[4], qA[2], qB[2];
#define LDK(F, Qv, i) do { F[0] = KFR(0, 2 * (i)); F[1] = KFR(1, 2 * (i)); F[2] = KFR(0, 2 * (i) + 1); F[3] = KFR(1, 2 * (i) + 1); Qv[0] = QFR(2 * (i)); Qv[1] = QFR(2 * (i) + 1); } while (0)
#define LDV(F, d) do { F[0] = VFR(d, 0); F[1] = VFR(d, 1); F[2] = VFR(d, 2); F[3] = VFR(d, 3); } while (0)
#define MMK(F, Qv) do { c0 = MFMA32(F[0], Qv[0], c0); c1 = MFMA32(F[1], Qv[0], c1); c0 = MFMA32(F[2], Qv[1], c0); c1 = MFMA32(F[3], Qv[1], c1); } while (0)
#define MMV(F, d) do { o[d] = MFMA32(F[0], pf[0][0], o[d]); o[d] = MFMA32(F[1], pf[0][1], o[d]); o[d] = MFMA32(F[2], pf[1][0], o[d]); o[d] = MFMA32(F[3], pf[1][1], o[d]); } while (0)
#define SB() __builtin_amdgcn_sched_barrier(0)
        LDK(fA, qA, 0); SB();
        LDK(fB, qB, 1); SB(); MMK(fA, qA); SB();
        LDK(fA, qA, 2); SB(); MMK(fB, qB); SB();
        LDK(fB, qB, 3); SB(); MMK(fA, qA); SB();
        LDV(fA, 0);     SB(); MMK(fB, qB); SB();
#undef QFR
#pragma unroll
        for (int p = 0; p < 2; ++p) {
            const int wbits = (int)((p ? mw.y : mw.x) >> (8 * hi));
            float f[16];
#pragma unroll
            for (int r = 0; r < 16; ++r) { const float e = __builtin_amdgcn_exp2f(p ? c1[r] : c0[r]); int mb;
                asm("v_bfe_i32 %0, %1, %2, 1" : "=v"(mb) : "v"(wbits), "n"(16 * (r >> 3) + (r & 7)));
                f[r] = __uint_as_float(__float_as_uint(e) & (unsigned)mb); psum += f[r]; }
            pf[p][0] = pack8(f); pf[p][1] = pack8(f + 8);
        }
        lrun += psum;
        SB();
        LDV(fB, 1); SB(); MMV(fA, 0); SB();
        LDV(fA, 2); SB(); MMV(fB, 1); SB();
        LDV(fB, 3); SB(); MMV(fA, 2); SB();
        MMV(fB, 3); SB();
#undef LDK
#undef LDV
#undef MMK
#undef MMV
#undef SB
#undef KFR
#undef VFR
        if (t + 1 < nt) ATT_STORE(cur ^ 1);
        __syncthreads();
    }
#undef ATT_LOAD
#undef ATT_STORE
    lrun = x32sum(lrun);
    const float inv = 1.0f / lrun;
    int ln2 = lane; asm volatile("" : "+v"(ln2));
    LAS unsigned char* stg = lds + wave * 8704;
#pragma unroll
    for (int d = 0; d < 4; ++d)
#pragma unroll
        for (int c4 = 0; c4 < 4; ++c4) {
            f32x4 v; v[0] = o[d][4 * c4] * inv; v[1] = o[d][4 * c4 + 1] * inv; v[2] = o[d][4 * c4 + 2] * inv; v[3] = o[d][4 * c4 + 3] * inv;
            stage_put(stg, ln2, 32 * d + 8 * c4 + 4 * (ln2 >> 5), v);
        }
    stage_flush(stg, ln2, OATT + ((size_t)b * SEQ + qs) * 4096 + hh * 128, 4096);
}

#define XB_TMO      128
#define XB_XCNT(j)  (256  + 64 * (j))
#define XB_XSUB(j)  (1280 + 64 * (j))
#define XB_XGEN(j)  (2304 + 64 * (j))
#define XB_TOP      3328
#define XB_TOPGEN   3392
#define XCD_BAR_WORDS 3456
#define XB_SPIN_CAP (1u << 18)

__device__ __forceinline__ unsigned xb_ld(unsigned* p)              { return __hip_atomic_load(p, __ATOMIC_RELAXED, __HIP_MEMORY_SCOPE_AGENT); }
__device__ __forceinline__ unsigned xb_add(unsigned* p, unsigned v) { return __hip_atomic_fetch_add(p, v, __ATOMIC_RELAXED, __HIP_MEMORY_SCOPE_AGENT); }
__device__ __forceinline__ unsigned xb_xcc_id() { return (unsigned)__builtin_amdgcn_s_getreg((3 << 11) | 20) & 0xFu; }
#define XB_SPIN(cond, bar) do { unsigned _sp = 0; while (cond) { __builtin_amdgcn_s_sleep(1); \
    if ((++_sp & 255u) == 0u) { if (xb_ld(&(bar)[XB_TMO])) break; if (_sp > XB_SPIN_CAP) { atomicAdd(&(bar)[XB_TMO], 1u); break; } } } } while (0)

struct XcdBarrier {
    unsigned* bar; unsigned x;
    volatile LAS unsigned* st;
};

__device__ __forceinline__ XcdBarrier xcd_barrier_post(unsigned* bar, volatile LAS unsigned* st) {
    XcdBarrier b; b.bar = bar; b.x = xb_xcc_id(); b.st = st;
    if (threadIdx.x == 0) (void)xb_add(&bar[XB_XCNT(b.x)], 1u);
    return b;
}
__device__ __forceinline__ void xcd_barrier_complete(unsigned* bar, unsigned x, unsigned& nloc, unsigned& nx) {
    const unsigned G = gridDim.x * gridDim.y * gridDim.z;
    unsigned sum, cnt, mine, sp = 0u;
    for (;;) {
        sum = 0u; cnt = 0u; mine = 0u;
#pragma unroll
        for (unsigned j = 0; j < 16; ++j) { const unsigned c = xb_ld(&bar[XB_XCNT(j)]); sum += c; cnt += (c > 0u) ? 1u : 0u; mine = (j == x) ? c : mine; }
        if (sum == G) break;
        __builtin_amdgcn_s_sleep(1);
        if ((++sp & 255u) == 0u) { if (xb_ld(&bar[XB_TMO])) break; if (sp > XB_SPIN_CAP) { atomicAdd(&bar[XB_TMO], 1u); break; } }
    }
    nloc = mine > 0u ? mine : 1u; nx = cnt > 0u ? cnt : 1u;
}

__device__ __forceinline__ void xcd_barrier(const XcdBarrier& b) {
    asm volatile("s_waitcnt vmcnt(0)" ::: "memory");
    __syncthreads();
    if (threadIdx.x == 0) {
        unsigned* bar = b.bar;
        __builtin_amdgcn_s_waitcnt(0);
        unsigned nloc = b.st[0], nx = b.st[1];
        if (nloc == 0u) { xcd_barrier_complete(bar, b.x, nloc, nx); b.st[0] = nloc; b.st[1] = nx; }
        const unsigned old = xb_add(&bar[XB_XSUB(b.x)], 1u);
        const unsigned gen = old / nloc;
        if (old + 1u == (gen + 1u) * nloc) {
            __builtin_amdgcn_fence(__ATOMIC_RELEASE, "agent");
            asm volatile("s_waitcnt vmcnt(0)" ::: "memory");
            const unsigned og = xb_add(&bar[XB_TOP], 1u);
            const unsigned tg = og / nx;
            if (og + 1u == (tg + 1u) * nx) xb_add(&bar[XB_TOPGEN], 1u);
            else XB_SPIN(xb_ld(&bar[XB_TOPGEN]) == tg, bar);
            __builtin_amdgcn_fence(__ATOMIC_ACQUIRE, "agent");
            xb_add(&bar[XB_XGEN(b.x)], 1u);
            asm volatile("s_waitcnt vmcnt(0)" ::: "memory");
        } else {
            XB_SPIN(xb_ld(&bar[XB_XGEN(b.x)]) == gen, bar);
            __builtin_amdgcn_fence(__ATOMIC_ACQUIRE, "agent");
            asm volatile("s_waitcnt vmcnt(0)" ::: "memory");
        }
    }
    __syncthreads();
}

constexpr int LDS_BYTES = 139264;
__global__ void __launch_bounds__(NTHR, 2) hybrid_fwd(Params P_unused) {
    extern __shared__ __attribute__((aligned(16))) unsigned char lds_raw[];
    cg::grid_group grid = cg::this_grid();
#define FRESH() LAS unsigned char* lds = (LAS unsigned char*)lds_raw; int tid = threadIdx.x; asm volatile("" : "+v"(tid)); const int lane = tid & 63, wave = __builtin_amdgcn_readfirstlane(tid >> 6); \
    int G = gridDim.x, bx = blockIdx.x; asm volatile("" : "+s"(G), "+s"(bx)); const int gw = bx * NWAVE + wave, NGW = G * NWAVE; CP pp = getP(); unsigned char* ws = pp->ws; \
    float* RSS = (float*)(ws + WS_RSS); bf16_t* XB = (bf16_t*)(ws + WS_XB); (void)lane; (void)gw; (void)NGW; (void)RSS; (void)XB; (void)lds;
    {
        FRESH();
        if (tid < 4) ((LAS unsigned*)(lds + LDS_BYTES - 16))[tid] = 0u;
        __syncthreads();
        (void)xcd_barrier_post((unsigned*)(ws + WS_BAR), (volatile LAS unsigned*)(lds + LDS_BYTES - 16));
#ifndef NO_PRO
        for (int rep = 0; rep < REP_PRO; ++rep) prologue(pp, lds, gw, NGW, wave, lane);
#endif
    }
    if (P_unused.out == nullptr) grid.sync();
#define GSYNC() do { LAS unsigned char* lds_ = (LAS unsigned char*)lds_raw; XcdBarrier xb_; xb_.bar = (unsigned*)(getP()->ws + WS_BAR); xb_.x = xb_xcc_id(); xb_.st = (volatile LAS unsigned*)(lds_ + LDS_BYTES - 16); xcd_barrier(xb_); } while (0)
    GSYNC();
#pragma unroll 1
    for (int l = 0; l < NL; ++l) {
        {
            FRESH();
            pg8::Gemm g{XB, (const bf16_t*)(ws + WS_WIN + l * 57 * MiB), NTOK, NMAIN, DM}; pg8::StaticOrder S; S.init(NTOK, NMAIN, G, bx);
            EpiIn E{RSS + (2 * l) * NTOK, ws};
#ifndef NO_G1
            pg8::gemm_phase<EpiIn, pg8::StaticOrder, GA_, GS_>(lds, g, S, E);
#endif
            for (int rb = bx; rb < NTOK / 32; rb += G) tail_block(ws, (const bf16_t*)(ws + WS_WIN + l * 57 * MiB) + (size_t)NMAIN * DM, RSS + (2 * l) * NTOK, lds, rb, wave, lane);
        }
        GSYNC();
        {
            FRESH();
            const bf16_t* KR = (const bf16_t*)(ws + WS_KRAW); bf16_t* KN = (bf16_t*)(ws + WS_KN); const float* kg = pp->kn_g + l * 128;
            for (int rep = 0; rep < REP_P2; ++rep) {
            {
                const int q16 = lane >> 4, c16 = lane & 15;
                const f32x4 kg0 = *(const f32x4*)(kg + 8 * c16), kg1 = *(const f32x4*)(kg + 8 * c16 + 4);
                for (int base = gw; base < NTOK; base += 4 * NGW) {
                    u32x4 kv[4];
#pragma unroll
                    for (int j = 0; j < 4; ++j) { const int st = base + j * NGW; const int pair = st * 4 + q16;
                        kv[j] = (st < NTOK) ? *(const u32x4*)(KR + (size_t)(pair >> 2) * 512 + (pair & 3) * 128 + 8 * c16) : (u32x4){0u, 0u, 0u, 0u}; }
                    __builtin_amdgcn_sched_barrier(0);
#pragma unroll
                    for (int j = 0; j < 4; ++j) { const int st = base + j * NGW; const int pair = st * 4 + q16, row = pair >> 2, g4 = pair & 3;
                        const f32x4 lo = bflo4(kv[j]), hi4 = bfhi4(kv[j]);
                        float ss = ((lo[0] * lo[0] + lo[1] * lo[1]) + (lo[2] * lo[2] + lo[3] * lo[3])) + ((hi4[0] * hi4[0] + hi4[1] * hi4[1]) + (hi4[2] * hi4[2] + hi4[3] * hi4[3]));
                        ss += __int_as_float(__builtin_amdgcn_update_dpp(0, __float_as_int(ss), 0xB1, 0xF, 0xF, true)); ss += __int_as_float(__builtin_amdgcn_update_dpp(0, __float_as_int(ss), 0x4E, 0xF, 0xF, true));
                        ss += __int_as_float(__builtin_amdgcn_update_dpp(0, __float_as_int(ss), 0x141, 0xF, 0xF, true)); ss += __int_as_float(__builtin_amdgcn_update_dpp(0, __float_as_int(ss), 0x140, 0xF, 0xF, true));
                        const float rs = rsqrtf(ss * (1.0f / 128.0f) + 1e-6f);
                        if (st < NTOK) st8bf(KN + ((size_t)((row >> 11) * 4 + g4) * SEQ + (row & 2047)) * 128 + 8 * c16, lo * rs * kg0, hi4 * rs * kg1); }
                }
            }
            {
                const bool bal = (G == 256); const int i = bx & 127, q = i & 63, hb = i >> 6;
                if (bal) { if (bx < 128) rascan_unit(ws, bx, wave, lane); }
                else { for (int u = bx; u < 128; u += G) rascan_unit(ws, u, wave, lane); }
                const int ng = bal ? (bx < 128 ? 1 : 3) : 2 * ((255 - bx) / G + 1);
#pragma unroll 1
                for (int k = 0; k < ng; ++k) {
                    int gid;
                    if (bal) gid = (bx < 128) ? hb * 128 + 127 - q : (k == 0 ? (2 * hb) * 128 + q : (k == 1 ? (2 * hb + 1) * 128 + 63 - q : (2 + hb) * 128 + 64 + q));
                    else { const int kk2 = bx + (k >> 1) * G; gid = (k & 1) ? 511 - kk2 : kk2; }
                    indexer_group(ws, lds, gid, wave, lane);
                }
            }
            }
        }
        GSYNC();
        {
            FRESH();
            for (int rep = 0; rep < REP_P3; ++rep) {
#ifndef NO_ATT
            { const int vb = (G % 8 == 0) ? (bx % 8) * (G / 8) + bx / 8 : bx;
              for (int unit = vb; unit < 512; unit += G) attn_unit(ws, pp->qn_g, pp->kn_g, lds, unit, l, wave, lane); }
#endif
            { const float* gn_g = pp->gn_g; const float* gn_b = pp->gn_b;
              for (int unit = bx; unit < 512; unit += G) rc_unit(ws, gn_g, gn_b, lds, unit, l, wave, lane); }
            }
        }
        GSYNC();
        {
            FRESH();
            pg8::Gemm g{(const bf16_t*)(ws + WS_OATT), (const bf16_t*)(ws + WS_WUPA + l * 16 * MiB), NTOK, DM, 2 * DM}; pg8::StaticOrder S; S.init(NTOK, DM, G, bx);
            EpiGate E{(const bf16_t*)(ws + WS_SGA), (const bf16_t*)(ws + WS_SGB), (bf16_t*)(ws + WS_MERGED)};
#if !defined(NO_GO) && !defined(NO_GA)
            pg8::gemm_phase<EpiGate, pg8::StaticOrder, GA_, GS_>(lds, g, S, E);
#endif
        }
        GSYNC();
        {
            FRESH();
            pg8::Gemm g{(const bf16_t*)(ws + WS_MERGED), (const bf16_t*)(ws + WS_WOUT + l * 8 * MiB), NTOK, DM, DM}; pg8::StaticOrder S; S.init(NTOK, DM, G, bx);
            EpiRes E{l == 0 ? pp->x : (const float*)pp->out, pp->out, XB, RSS + (2 * l + 1) * NTOK};
#if !defined(NO_GO) && !defined(NO_GR)
            pg8::gemm_phase<EpiRes, pg8::StaticOrder, GA_, GS_>(lds, g, S, E);
#endif
        }
        GSYNC();
        {
            FRESH();
            pg8::Gemm g{XB, (const bf16_t*)(ws + WS_WFF1 + l * 32 * MiB), NTOK, DFF, DM}; pg8::StaticOrder S; S.init(NTOK, DFF, G, bx);
            EpiFF1 E{RSS + (2 * l + 1) * NTOK, (bf16_t*)(ws + WS_HFF)};
#if !defined(NO_GO) && !defined(NO_F1)
            pg8::gemm_phase<EpiFF1, pg8::StaticOrder, GA_, GS_>(lds, g, S, E);
#endif
        }
        GSYNC();
        {
            FRESH();
            pg8::Gemm g{(const bf16_t*)(ws + WS_HFF), (const bf16_t*)(ws + WS_WFF2 + l * 32 * MiB), NTOK, DM, DFF}; pg8::StaticOrder S; S.init(NTOK, DM, G, bx);
            EpiRes E{pp->out, pp->out, (l + 1 < NL) ? XB : nullptr, (l + 1 < NL) ? RSS + (2 * l + 2) * NTOK : nullptr};
#if !defined(NO_GO) && !defined(NO_GR)
            pg8::gemm_phase<EpiRes, pg8::StaticOrder, GA_, GS_>(lds, g, S, E);
#endif
        }
        if (l + 1 < NL) GSYNC();
    }
#undef FRESH
}
}

extern "C" void kernel_launch(void* const* d_in, const int* in_sizes, int n_in, void* d_out, int out_size, void* d_ws, size_t ws_size, hipStream_t stream) {
    static int grid = 0;
    if (grid == 0) {
        if (n_in != 13 || out_size != mk::NTOK * mk::DM || ws_size < mk::WS_END) { fprintf(stderr, "kernel_launch: unexpected shapes (n_in %d out %d ws %zu)\n", n_in, out_size, ws_size); grid = -1; return; }
        int dev = 0, cus = 0, per_cu = 0;
        hipGetDevice(&dev); hipDeviceGetAttribute(&cus, hipDeviceAttributeMultiprocessorCount, dev);
        if (hipFuncSetAttribute((const void*)mk::hybrid_fwd, hipFuncAttributeMaxDynamicSharedMemorySize, mk::LDS_BYTES) != hipSuccess) { fprintf(stderr, "kernel_launch: hipFuncSetAttribute failed\n"); grid = -1; return; }
        if (hipOccupancyMaxActiveBlocksPerMultiprocessor(&per_cu, (const void*)mk::hybrid_fwd, mk::NTHR, mk::LDS_BYTES) != hipSuccess || per_cu < 1) { fprintf(stderr, "kernel_launch: occupancy query gave %d\n", per_cu); per_cu = 1; }
        (void)hipGetLastError();
        grid = cus * 1;
        if (grid <= 0) grid = 256;
    }
    if (grid < 0) return;
    mk::Params p{};
    p.x = (const float*)d_in[0]; p.ln1_g = (const float*)d_in[1]; p.w_in = (const float*)d_in[2]; p.qn_g = (const float*)d_in[3]; p.kn_g = (const float*)d_in[4];
    p.gn_g = (const float*)d_in[5]; p.gn_b = (const float*)d_in[6]; p.w_upa = (const float*)d_in[7]; p.w_upr = (const float*)d_in[8]; p.w_out = (const float*)d_in[9];
    p.ln2_g = (const float*)d_in[10]; p.w_ff1 = (const float*)d_in[11]; p.w_ff2 = (const float*)d_in[12];
    p.out = (float*)d_out; p.ws = (unsigned char*)d_ws;
    (void)hipMemsetAsync((unsigned char*)d_ws + mk::WS_BAR, 0, XCD_BAR_WORDS * sizeof(unsigned), stream);
    void* args[] = {&p};
    hipError_t e = hipLaunchCooperativeKernel((const void*)mk::hybrid_fwd, dim3(grid), dim3(mk::NTHR), args, mk::LDS_BYTES, stream);
    if (e != hipSuccess) fprintf(stderr, "kernel_launch: cooperative launch failed: %s (grid %d)\n", hipGetErrorString(e), grid);
}
```

```cpp
#include <hip/hip_runtime.h>
#include <hip/hip_cooperative_groups.h>
#include <cstdio>
#include <cstdint>
#ifndef REP_PRO
#define REP_PRO 1
#endif
#ifndef REP_P2
#define REP_P2 1
#endif
#ifndef REP_P3
#define REP_P3 1
#endif
#ifndef REP_P4
#define REP_P4 1
#endif
#ifndef GA_
#define GA_ true
#define GS_ true
#endif
namespace cg = cooperative_groups;
namespace pg8 {
#define PG8_LAS __attribute__((address_space(3)))
typedef unsigned short bf16_t;
typedef short bf16x8 __attribute__((ext_vector_type(8)));
typedef float f32x4 __attribute__((ext_vector_type(4)));
typedef unsigned u32x4 __attribute__((ext_vector_type(4)));
constexpr int BM = 256, BK = 64, HALF = 128, HTB = HALF * BK * 2  , STAGE_BYTES = 8 * HTB, NXCD = 8, WGM = 8;

__host__ __device__ __forceinline__ int lds_byte(int r, int c) { const int st = (r >> 4) * 2 + (c >> 5), rr = r & 15, cc = c & 31, ob = rr * 64 + cc * 2; return st * 1024 + (ob ^ (((ob >> 9) & 1) << 5)); }
__host__ __device__ __forceinline__ void stage_rc(int b, int& R, int& C) { const int st = b / 1024, sb = b % 1024, swz = sb ^ (((sb >> 9) & 1) << 5); R = (st >> 1) * 16 + swz / 64; C = (st & 1) * 32 + (swz % 64) / 2; }
__host__ __device__ __forceinline__ int perm32(int rho) { const int n = rho >> 4, i = rho & 15; return 8 * (i >> 2) + 4 * n + (i & 3); }

struct Unit { int pm, pn; };
struct Gemm { const bf16_t* A; const bf16_t* Bt; int M, N, K; };

struct StaticOrder {
    int nM, nN, nwg, G, c;
    __host__ __device__ void init(int M, int N, int G_, int c_) { nM = M / BM; nN = N / BM; nwg = nM * nN; G = G_; c = c_; }
    __host__ __device__ bool next(int i, Unit& u) const {
        const long L = (long)i * G + c; if (L >= nwg) return false;
        int wgid = (int)L; { const int q = nwg / NXCD, r = nwg % NXCD, xcd = wgid % NXCD, off = wgid / NXCD; wgid = (xcd < r ? xcd * (q + 1) : r * (q + 1) + (xcd - r) * q) + off; }
        const int nig = WGM * nN, gid = wgid / nig, fm = gid * WGM, gsz = (nM - fm) < WGM ? (nM - fm) : WGM;
        u.pm = fm + ((wgid % nig) % gsz); u.pn = (wgid % nig) / gsz; return true;
    }
    __device__ __forceinline__ void a_ready(const Unit&) const {}
    __device__ __forceinline__ void done(const Unit&) const {}
};

__device__ __forceinline__ unsigned cvt_pk_bf16(float lo, float hi) { unsigned r; asm volatile("v_cvt_pk_bf16_f32 %0, %1, %2" : "=v"(r) : "v"(lo), "v"(hi)); return r; }
template <class Epi, class Sched, bool ALIGN_EPI = false, bool SP2 = false>
__device__ __forceinline__ void gemm_phase(PG8_LAS unsigned char* lds, const Gemm g, const Sched& S, const Epi& E) {
    int tid_ = threadIdx.x; asm volatile("" : "+v"(tid_)); const int tid = tid_, wid = __builtin_amdgcn_readfirstlane(tid >> 6), lane = tid & 63, wr = wid >> 2, wc = wid & 3, fr = lane & 15, fq = lane >> 4;
    const int K = g.K, nt = K / BK;
    unsigned voffA[2], voffB[2];
#pragma unroll
    for (int i = 0; i < 2; ++i) { int R, C; stage_rc(tid * 16 + i * 8192, R, C); const int Rb = Epi::PERM ? ((R & ~31) + perm32(R & 31)) : R;
        voffA[i] = (unsigned)(R * K + C) * 2u; voffB[i] = (unsigned)(Rb * K + C) * 2u; }
    const size_t kstep = (size_t)(BK * 2);
    const size_t hstep = (size_t)HALF * K * 2;
    const size_t tstep = 2 * hstep;
    const unsigned ldsw = (unsigned)wid * 1024u;
    const int aoff = lds_byte(wr * 64 + fr, fq * 8), boff = lds_byte(wc * 32 + fr, fq * 8);
#define PG8_SA(b, h) (((b) * 2 + (h)) * HTB)
#define PG8_SB(b, h) ((4 + (b) * 2 + (h)) * HTB)
#define PG8_STAGE(bufoff, gbase, voff) do { _Pragma("unroll") for (int _i = 0; _i < 2; ++_i) \
        __builtin_amdgcn_global_load_lds((const unsigned*)((const char*)(gbase) + (voff)[_i]), (PG8_LAS unsigned*)(lds + (bufoff) + ldsw + _i * 8192), 16, 0, 0); } while (0)
#define PG8_LDA(dst, b, h) do { _Pragma("unroll") for (int m = 0; m < 4; ++m) _Pragma("unroll") for (int k = 0; k < 2; ++k) dst[m][k] = *(const PG8_LAS bf16x8*)(lds + PG8_SA(b, h) + aoff + m * 2048 + k * 1024); } while (0)
#define PG8_LDB(dst, b, h) do { _Pragma("unroll") for (int n = 0; n < 2; ++n) _Pragma("unroll") for (int k = 0; k < 2; ++k) dst[n][k] = *(const PG8_LAS bf16x8*)(lds + PG8_SB(b, h) + boff + n * 2048 + k * 1024); } while (0)
#define PG8_MMA(ai, bj, At, Bt) do { __builtin_amdgcn_s_setprio(1); _Pragma("unroll") for (int m = 0; m < 4; ++m) _Pragma("unroll") for (int n = 0; n < 2; ++n) _Pragma("unroll") for (int k = 0; k < 2; ++k) \
        acc[ai][bj][m][n] = __builtin_amdgcn_mfma_f32_16x16x32_bf16(Bt[n][k], At[m][k], acc[ai][bj][m][n], 0, 0, 0); __builtin_amdgcn_s_setprio(0); } while (0)
#define PG8_WAIT_V(n) asm volatile("s_waitcnt vmcnt(" #n ")" ::: "memory")
#define PG8_WAIT_L(n) asm volatile("s_waitcnt lgkmcnt(" #n ")" ::: "memory")
#define PG8_BAR __builtin_amdgcn_s_barrier()
#define PG8_SCHED __builtin_amdgcn_sched_barrier(0)
    Unit cur, nxt; int ui = 0;
    if (!S.next(0, cur)) return;
    f32x4 acc[2][2][4][2];
#pragma unroll
    for (int a = 0; a < 2; ++a)
#pragma unroll
        for (int b = 0; b < 2; ++b)
#pragma unroll
            for (int m = 0; m < 4; ++m)
#pragma unroll
                for (int n = 0; n < 2; ++n) acc[a][b][m][n] = (f32x4){0.f, 0.f, 0.f, 0.f};
    bf16x8 At[4][2], B0[2][2], B1[2][2];
    const char* cA = (const char*)g.A + (size_t)cur.pm * tstep; const char* cB = (const char*)g.Bt + (size_t)cur.pn * tstep;
    S.a_ready(cur);
    if constexpr (SP2) {
        PG8_STAGE(PG8_SB(0, 0), cB, voffB); PG8_STAGE(PG8_SB(0, 1), cB + hstep, voffB); PG8_STAGE(PG8_SA(0, 0), cA, voffA); PG8_STAGE(PG8_SA(0, 1), cA + hstep, voffA);
        if (wr == 1) PG8_BAR;
        PG8_WAIT_V(2); PG8_BAR;
        PG8_STAGE(PG8_SB(1, 0), cB + kstep, voffB); PG8_STAGE(PG8_SA(1, 0), cA + kstep, voffA); PG8_STAGE(PG8_SB(1, 1), cB + hstep + kstep, voffB);
        PG8_WAIT_V(6); PG8_BAR;
    } else {
        PG8_STAGE(PG8_SB(0, 0), cB, voffB); PG8_STAGE(PG8_SA(0, 0), cA, voffA); PG8_STAGE(PG8_SB(0, 1), cB + hstep, voffB); PG8_STAGE(PG8_SA(0, 1), cA + hstep, voffA);
        if (wr == 1) PG8_BAR;
        PG8_WAIT_V(4); PG8_BAR;
        PG8_STAGE(PG8_SB(1, 0), cB + kstep, voffB); PG8_STAGE(PG8_SA(1, 0), cA + kstep, voffA); PG8_STAGE(PG8_SB(1, 1), cB + hstep + kstep, voffB);
        PG8_WAIT_V(6); PG8_BAR;
    }
    for (;;) {
        const bool has_next = S.next(ui + 1, nxt);
        const char* nA = has_next ? (const char*)g.A + (size_t)nxt.pm * tstep : cA; const char* nB = has_next ? (const char*)g.Bt + (size_t)nxt.pn * tstep : cB;
        for (int t = 0; t < nt; t += 2) {
            if constexpr (Epi::MID_HOOK) { if (t == (nt >> 1)) E.mid(acc, cur, wr, wc, fr, fq); }
            const bool last = (t == nt - 2);
            const char* a1 = cA + (size_t)(t + 1) * kstep;
            const char* a2 = last ? nA : cA + (size_t)(t + 2) * kstep; const char* b2 = last ? nB : cB + (size_t)(t + 2) * kstep;
            const char* a3 = a2 + kstep; const char* b3 = b2 + kstep;
            if (last && has_next) S.a_ready(nxt);
            if constexpr (SP2) {
            PG8_LDB(B0, 0, 0); PG8_LDB(B1, 0, 1); PG8_SCHED; PG8_LDA(At, 0, 0); PG8_STAGE(PG8_SA(1, 1), a1 + hstep, voffA);
            PG8_WAIT_V(8); PG8_WAIT_L(0); PG8_BAR; PG8_MMA(0, 0, At, B0); PG8_MMA(0, 1, At, B1); PG8_BAR; PG8_SCHED;
            PG8_LDA(At, 0, 1); PG8_STAGE(PG8_SB(0, 0), b2, voffB); PG8_STAGE(PG8_SB(0, 1), b2 + hstep, voffB); PG8_STAGE(PG8_SA(0, 0), a2, voffA);
            PG8_WAIT_V(8); PG8_WAIT_L(0); PG8_BAR; PG8_MMA(1, 0, At, B0); PG8_MMA(1, 1, At, B1); PG8_BAR; PG8_SCHED;
            PG8_LDB(B0, 1, 0); PG8_LDB(B1, 1, 1); PG8_SCHED; PG8_LDA(At, 1, 0); PG8_STAGE(PG8_SA(0, 1), a2 + hstep, voffA);
            PG8_WAIT_V(8); PG8_WAIT_L(0); PG8_BAR; PG8_MMA(0, 0, At, B0); PG8_MMA(0, 1, At, B1); PG8_BAR; PG8_SCHED;
            PG8_LDA(At, 1, 1); PG8_STAGE(PG8_SB(1, 0), b3, voffB); PG8_STAGE(PG8_SB(1, 1), b3 + hstep, voffB); PG8_STAGE(PG8_SA(1, 0), a3, voffA);
            PG8_WAIT_V(8); PG8_WAIT_L(0); PG8_BAR; PG8_MMA(1, 0, At, B0); PG8_MMA(1, 1, At, B1); PG8_BAR; PG8_SCHED;
            } else {
            PG8_LDB(B0, 0, 0); PG8_SCHED; PG8_LDA(At, 0, 0); PG8_STAGE(PG8_SA(1, 1), a1 + hstep, voffA);
            PG8_WAIT_L(8); PG8_BAR; PG8_WAIT_L(0); PG8_MMA(0, 0, At, B0); PG8_BAR; PG8_SCHED;
            PG8_LDB(B1, 0, 1); PG8_STAGE(PG8_SB(0, 0), b2, voffB);
            PG8_BAR; PG8_WAIT_L(0); PG8_MMA(0, 1, At, B1); PG8_BAR;
            PG8_LDA(At, 0, 1); PG8_STAGE(PG8_SA(0, 0), a2, voffA);
            PG8_BAR; PG8_WAIT_L(0); PG8_MMA(1, 0, At, B0); PG8_BAR; PG8_SCHED;
            PG8_STAGE(PG8_SB(0, 1), b2 + hstep, voffB);
            PG8_WAIT_V(6); PG8_BAR; PG8_MMA(1, 1, At, B1); PG8_BAR;
            PG8_LDB(B0, 1, 0); PG8_SCHED; PG8_LDA(At, 1, 0); PG8_STAGE(PG8_SA(0, 1), a2 + hstep, voffA);
            PG8_WAIT_L(8); PG8_BAR; PG8_WAIT_L(0); PG8_MMA(0, 0, At, B0); PG8_BAR; PG8_SCHED;
            PG8_LDB(B1, 1, 1); PG8_STAGE(PG8_SB(1, 0), b3, voffB);
            PG8_BAR; PG8_WAIT_L(0); PG8_MMA(0, 1, At, B1); PG8_BAR;
            PG8_LDA(At, 1, 1); PG8_STAGE(PG8_SA(1, 0), a3, voffA);
            PG8_BAR; PG8_WAIT_L(0); PG8_MMA(1, 0, At, B0); PG8_BAR; PG8_SCHED;
            PG8_STAGE(PG8_SB(1, 1), b3 + hstep, voffB);
            PG8_WAIT_V(6); PG8_BAR; PG8_MMA(1, 1, At, B1); PG8_BAR;
            }
        }
        if constexpr (ALIGN_EPI) { if (wr == 0) PG8_BAR; }
        if constexpr (!Epi::AFTER_DRAIN) { E(acc, cur, wr, wc, fr, fq); S.done(cur); }
        if (!has_next) break;
#pragma unroll
        for (int a = 0; a < 2; ++a)
#pragma unroll
            for (int b = 0; b < 2; ++b)
#pragma unroll
                for (int m = 0; m < 4; ++m)
#pragma unroll
                    for (int n = 0; n < 2; ++n) acc[a][b][m][n] = (f32x4){0.f, 0.f, 0.f, 0.f};
        cur = nxt; cA = nA; cB = nB; ++ui;
        if constexpr (ALIGN_EPI) { if (wr == 1) PG8_BAR; }
    }
    PG8_WAIT_V(0);
    if constexpr (!ALIGN_EPI) { if (wr == 0) PG8_BAR; }
    PG8_BAR;
    if constexpr (Epi::AFTER_DRAIN) { E.fused(acc, cur, wr, wc, fr, fq, lds, wid, lane); S.done(cur); }
#undef PG8_SA
#undef PG8_SB
#undef PG8_STAGE
#undef PG8_LDA
#undef PG8_LDB
#undef PG8_MMA
#undef PG8_WAIT_V
#undef PG8_WAIT_L
#undef PG8_BAR
#undef PG8_SCHED
}
}

namespace mk {
using pg8::bf16_t; using pg8::bf16x8; using pg8::f32x4; using pg8::u32x4; using pg8::Unit;
typedef float f32x16 __attribute__((ext_vector_type(16)));
typedef unsigned u32x2 __attribute__((ext_vector_type(2)));
#define LAS __attribute__((address_space(3)))

constexpr int NB = 4, SEQ = 2048, DM = 2048, NTOK = NB * SEQ, NL = 2, DIN = 14416, NPAD = 14592, DFF = 8192;
constexpr int NTHR = 512, NWAVE = 8, NMAIN = 14336;
constexpr size_t MiB = 1u << 20;
constexpr size_t WS_WIN = 0;
constexpr size_t WS_WUPA = 114 * MiB;
constexpr size_t WS_WUPR = 130 * MiB;
constexpr size_t WS_WOUT = 146 * MiB;
constexpr size_t WS_WFF1 = 162 * MiB;
constexpr size_t WS_WFF2 = 226 * MiB;
constexpr size_t WS_XB = 290 * MiB;
constexpr size_t WS_PROJ = 322 * MiB;
constexpr size_t WS_Q = WS_PROJ, WS_KRAW = WS_Q + 32 * MiB, WS_KN = WS_KRAW + 8 * MiB, WS_VT = WS_KN + 8 * MiB, WS_IQ = WS_VT + 8 * MiB,
                 WS_RQ = WS_IQ + 16 * MiB, WS_RK = WS_RQ + 16 * MiB, WS_RKT = WS_RK + 16 * MiB, WS_RVT = WS_RKT + 16 * MiB, WS_SRG = WS_RVT + 32 * MiB,
                 WS_SGA = WS_SRG + 32 * MiB, WS_SGB = WS_SGA + 32 * MiB, WS_IK = WS_SGB + 32 * MiB, WS_IW = WS_IK + 1 * MiB;
constexpr size_t WS_HFF = WS_PROJ;
constexpr size_t WS_MASK = 572 * MiB;
constexpr size_t WS_U = 574 * MiB;
constexpr size_t WS_MBUF = WS_U;
constexpr size_t WS_RP = 638 * MiB;
constexpr size_t WS_OATT = 670 * MiB;
constexpr size_t WS_ORET = 702 * MiB;
constexpr size_t WS_MERGED = 734 * MiB;
constexpr size_t WS_ROPE = 766 * MiB;
constexpr size_t WS_RSS = 767 * MiB;
constexpr size_t WS_BAR = 767 * MiB + 512 * 1024;
constexpr size_t WS_END = 768 * MiB;
static_assert(WS_IW + 1 * MiB <= WS_MASK, "proj region");

struct Params {
    const float* x; const float* ln1_g; const float* w_in; const float* qn_g; const float* kn_g; const float* gn_g; const float* gn_b;
    const float* w_upa; const float* w_upr; const float* w_out; const float* ln2_g; const float* w_ff1; const float* w_ff2;
    float* out; unsigned char* ws;
};

typedef const __attribute__((address_space(4))) Params* CP;
__device__ __forceinline__ CP getP() { auto k = __builtin_amdgcn_kernarg_segment_ptr(); asm volatile("" : "+s"(k)); return (CP)k; }
__device__ __forceinline__ float bf2f(unsigned h) { return __uint_as_float(h << 16); }
__device__ __forceinline__ unsigned pk2(float lo, float hi) { return pg8::cvt_pk_bf16(lo, hi); }
__device__ __forceinline__ void st4bf(bf16_t* p, f32x4 v) { *(u32x2*)p = (u32x2){pk2(v[0], v[1]), pk2(v[2], v[3])}; }
__device__ __forceinline__ float shx(float v, int o, int lane) { return __int_as_float(__builtin_amdgcn_ds_bpermute((lane ^ o) << 2, __float_as_int(v))); }
__device__ __forceinline__ int shxi(int v, int o, int lane) { return __builtin_amdgcn_ds_bpermute((lane ^ o) << 2, v); }
__device__ __forceinline__ float x32sum(float v) { auto rr = __builtin_amdgcn_permlane32_swap(__float_as_uint(v), __float_as_uint(v), false, false); return __uint_as_float(rr[0]) + __uint_as_float(rr[1]); }
__device__ __forceinline__ float wave_sum(float v, int lane) {
#pragma unroll
    for (int o = 1; o < 32; o <<= 1) v += shx(v, o, lane);
    return x32sum(v);
}
__device__ __forceinline__ int crow(int r, int hi) { return (r & 3) + 8 * (r >> 2) + 4 * hi; }
__device__ __forceinline__ int kperm(int m) { const int a = m & 3, h1 = (m >> 2) & 1, c = m >> 3; return 16 * (c >> 1) + 8 * h1 + 4 * (c & 1) + a; }
#define MFMA32(a, b, c) __builtin_amdgcn_mfma_f32_32x32x16_bf16((a), (b), (c), 0, 0, 0)
__device__ __forceinline__ bf16x8 pack8(const float* f) { u32x4 w; w.x = pk2(f[0], f[1]); w.y = pk2(f[2], f[3]); w.z = pk2(f[4], f[5]); w.w = pk2(f[6], f[7]); return __builtin_bit_cast(bf16x8, w); }

struct MapIdent { __device__ __forceinline__ int operator()(int n) const { return n; } };
struct MapWin {
    __device__ __forceinline__ int operator()(int n) const {
        if (n < 4096) return n;
        if (n < 6144) { const int t = n - 4096, which = t >> 10, tt = t & 1023, h = tt >> 7, lc = tt & 127; return (which ? 5200 : 4176) + h * 128 + (lc >> 1) + 64 * (lc & 1); }
        if (n < 8192) return 6224 + (n - 6144);
        if (n < 10240) return 8272 + (n - 8192);
        if (n < 12288) return 10320 + (n - 10240);
        if (n < 14336) return 12368 + (n - 12288);
        if (n < 14416) return 4096 + (n - 14336);
        return -1;
    }
};
__device__ __forceinline__ void transpose64(const float* __restrict__ W, int K, int N, bf16_t* WT, const float* __restrict__ gk, int k0, int c0, int ncols, int d0, int ds, LAS float* scr, int lane, int ldk = 0, int fragn0 = -1) {
    if (ldk == 0) ldk = K;
    const int lr = lane >> 4, lc4 = (lane & 15) * 4;
    f32x4 v[16];
#pragma unroll
    for (int i = 0; i < 16; ++i) { const int kk = 4 * i + lr; v[i] = (lc4 < ncols) ? __builtin_nontemporal_load((const f32x4*)(W + (size_t)(k0 + kk) * N + c0 + lc4)) : (f32x4){0.f, 0.f, 0.f, 0.f}; }
#pragma unroll
    for (int i = 0; i < 16; ++i) { const int kk = 4 * i + lr; const float g = gk ? gk[k0 + kk] : 1.0f; LAS float* d = scr + kk * 65 + lc4; d[0] = v[i][0] * g; d[1] = v[i][1] * g; d[2] = v[i][2] * g; d[3] = v[i][3] * g; }
    asm volatile("s_waitcnt lgkmcnt(0)" ::: "memory");
    const int c = lane & 7;
#pragma unroll
    for (int j = 0; j < 8; ++j) { const int n = (lane >> 3) + 8 * j; const LAS float* sp = scr + (8 * c) * 65 + n;
        u32x4 o; o.x = pk2(sp[0 * 65], sp[1 * 65]); o.y = pk2(sp[2 * 65], sp[3 * 65]); o.z = pk2(sp[4 * 65], sp[5 * 65]); o.w = pk2(sp[6 * 65], sp[7 * 65]);
        if (fragn0 < 0) { if (n < ncols) *(u32x4*)(WT + (size_t)(d0 + ds * n) * ldk + k0 + 8 * c) = o; }
        else if (n < 32) { const int nn = fragn0 + n, kq = k0 + 8 * c; if (n >= ncols) o = (u32x4){0u, 0u, 0u, 0u};
            *(u32x4*)(WT + ((size_t)(((nn >> 5) * (K >> 4) + (kq >> 4)) * 2 + ((kq >> 3) & 1)) * 32 + (nn & 31)) * 8) = o; } }
    asm volatile("s_waitcnt lgkmcnt(0)" ::: "memory");
}

__device__ __forceinline__ void prologue(CP pp, LAS unsigned char* lds, int gw, int NGW, int wave, int lane) {
    Params P; P.x = pp->x; P.ln1_g = pp->ln1_g; P.w_in = pp->w_in; P.w_upa = pp->w_upa; P.w_upr = pp->w_upr; P.w_out = pp->w_out; P.ln2_g = pp->ln2_g; P.w_ff1 = pp->w_ff1; P.w_ff2 = pp->w_ff2; P.ws = pp->ws; unsigned char* ws = P.ws;
    LAS float* scr = (LAS float*)(lds + wave * 16640);
    constexpr int T_IN = 226, I_IN = 32 * T_IN, I_SQ = 32 * 32, I_F1 = 32 * 128, I_F2 = 128 * 32, I_L = I_IN + 3 * I_SQ + I_F1 + I_F2;
    for (int it = gw; it < NL * I_L; it += NGW) {
        const int itr = NL * I_L - 1 - it;
        const int l = itr / I_L; int r = itr % I_L;
        if (r < I_IN) {
            const int kb = r / T_IN, t = r % T_IN; int c0, d0, ds = 1, nc = 64;
            if (t < 64) { c0 = 64 * t; d0 = c0; }
            else if (t == 64 || t == 65) {
                bf16_t* wt = (bf16_t*)(ws + WS_WIN + l * 57 * MiB) + (size_t)NMAIN * DM;
                transpose64(P.w_in + (size_t)l * DM * DIN, DM, DIN, wt, P.ln1_g + l * DM, 64 * kb, t == 64 ? 4096 : 4160, t == 64 ? 64 : 16, 0, 1, scr, lane, 0, t == 64 ? 0 : 64);
                if (t == 64) transpose64(P.w_in + (size_t)l * DM * DIN, DM, DIN, wt, P.ln1_g + l * DM, 64 * kb, 4096 + 32, 32, 0, 1, scr, lane, 0, 32);
                continue; }
            else if (t < 98) { const int q = t - 66, which = q >> 4, rr = q & 15, h = rr >> 1, half = rr & 1; c0 = (which ? 5200 : 4176) + h * 128 + 64 * half; d0 = (which ? 5120 : 4096) + h * 128 + half; ds = 2; }
            else { const int q = t - 98; c0 = 6224 + 64 * q; d0 = 6144 + 64 * q; }
            transpose64(P.w_in + (size_t)l * DM * DIN, DM, DIN, (bf16_t*)(ws + WS_WIN + l * 57 * MiB), P.ln1_g + l * DM, 64 * kb, c0, nc, d0, ds, scr, lane); continue; }
        r -= I_IN;
        if (r < 3 * I_SQ) { const int w = r / I_SQ, q = r % I_SQ, kb = q >> 5, t = q & 31; const float* src = (w == 0 ? P.w_upa : (w == 1 ? P.w_upr : P.w_out)) + (size_t)l * DM * DM;
            bf16_t* dst = (w == 2) ? (bf16_t*)(ws + WS_WOUT + l * 8 * MiB) : (bf16_t*)(ws + WS_WUPA + l * 16 * MiB) + (w == 1 ? DM : 0);
            transpose64(src, DM, DM, dst, nullptr, 64 * kb, 64 * t, 64, 64 * t, 1, scr, lane, (w == 2) ? DM : 2 * DM); continue; }
        r -= 3 * I_SQ;
        if (r < I_F1) { const int kb = r >> 7, t = r & 127; transpose64(P.w_ff1 + (size_t)l * DM * DFF, DM, DFF, (bf16_t*)(ws + WS_WFF1 + l * 32 * MiB), P.ln2_g + l * DM, 64 * kb, 64 * t, 64, 64 * t, 1, scr, lane); continue; }
        r -= I_F1;
        { const int kb = r >> 5, t = r & 31; transpose64(P.w_ff2 + (size_t)l * DFF * DM, DFF, DM, (bf16_t*)(ws + WS_WFF2 + l * 32 * MiB), nullptr, 64 * kb, 64 * t, 64, 64 * t, 1, scr, lane); }
    }
    bf16_t* XB = (bf16_t*)(ws + WS_XB); float* RSS = (float*)(ws + WS_RSS);
    for (int m = gw; m < NTOK; m += NGW) {
        const f32x4* xr = (const f32x4*)(P.x + (size_t)m * DM) + lane; float ss = 0.f;
#pragma unroll
        for (int j = 0; j < 8; ++j) { const f32x4 v = xr[64 * j]; ss += (v[0] * v[0] + v[1] * v[1]) + (v[2] * v[2] + v[3] * v[3]); st4bf(XB + (size_t)m * DM + 4 * lane + 256 * j, v); }
        ss = wave_sum(ss, lane);
        if (lane == 0) RSS[m] = ss;
    }
    for (int i = gw * 64 + lane; i < 3 * NTOK; i += NGW * 64) RSS[NTOK + i] = 0.f;
    float* rope = (float*)(ws + WS_ROPE);
    for (int i = gw * 64 + lane; i < SEQ * 64; i += NGW * 64) {
        const int pos = i >> 6, fi = i & 63;
        const float invf = (float)exp(-(double)fi * (9.210340371976184 / 64.0));
        const float angf = (float)pos * invf;
        const double a = (double)angf; const double k = rint(a * 0.15915494309189535); const double r = a - k * 6.283185307179586477;
        const double r2 = r * r; double ts = r, ss = r, tc = 1.0, cc = 1.0;
#pragma unroll
        for (int n = 1; n <= 14; ++n) { ts *= -r2 * (1.0 / (double)((2 * n) * (2 * n + 1))); ss += ts; tc *= -r2 * (1.0 / (double)((2 * n - 1) * (2 * n))); cc += tc; }
        rope[2 * i] = (float)cc; rope[2 * i + 1] = (float)ss;
    }
}

#define EPI_ROWS(...) _Pragma("unroll") for (int ai = 0; ai < 2; ++ai) _Pragma("unroll") for (int m = 0; m < 4; ++m) { int row_ = u.pm * 256 + ai * 128 + wr * 64 + m * 16 + fr; asm volatile("" : "+v"(row_) :: "memory"); const int row = row_; __VA_ARGS__ }
#define EPI_COLS8(...) _Pragma("unroll") for (int bj = 0; bj < 2; ++bj) { const int lc = bj * 128 + wc * 32 + 8 * fq; const f32x4 a0 = acc[ai][bj][m][0], a1 = acc[ai][bj][m][1]; __VA_ARGS__ }

__device__ __forceinline__ float sigm(float x) { return __builtin_amdgcn_rcpf(1.0f + __builtin_amdgcn_exp2f(-1.4426950408889634f * x)); }
__device__ __forceinline__ f32x4 sigm4(f32x4 v) { return (f32x4){sigm(v[0]), sigm(v[1]), sigm(v[2]), sigm(v[3])}; }
__device__ __forceinline__ void st8bf(bf16_t* p, f32x4 v0, f32x4 v1) { *(u32x4*)p = (u32x4){pk2(v0[0], v0[1]), pk2(v0[2], v0[3]), pk2(v1[0], v1[1]), pk2(v1[2], v1[3])}; }
__device__ __forceinline__ void st8col(bf16_t* d, int stride, f32x4 v0, f32x4 v1) {
    d[0] = (bf16_t)pk2(v0[0], 0.f); d[stride] = (bf16_t)pk2(v0[1], 0.f); d[2 * stride] = (bf16_t)pk2(v0[2], 0.f); d[3 * stride] = (bf16_t)pk2(v0[3], 0.f);
    d[4 * stride] = (bf16_t)pk2(v1[0], 0.f); d[5 * stride] = (bf16_t)pk2(v1[1], 0.f); d[6 * stride] = (bf16_t)pk2(v1[2], 0.f); d[7 * stride] = (bf16_t)pk2(v1[3], 0.f);
}
__device__ __forceinline__ f32x4 bflo4(u32x4 w) { return (f32x4){bf2f(w.x & 0xffffu), bf2f(w.x >> 16), bf2f(w.y & 0xffffu), bf2f(w.y >> 16)}; }
__device__ __forceinline__ f32x4 bfhi4(u32x4 w) { return (f32x4){bf2f(w.z & 0xffffu), bf2f(w.z >> 16), bf2f(w.w & 0xffffu), bf2f(w.w >> 16)}; }

struct EpiIn {
    static constexpr bool PERM = true, AFTER_DRAIN = false, MID_HOOK = false;
    const float* rss; unsigned char* ws;
    __device__ __forceinline__ void operator()(const f32x4 (&acc)[2][2][4][2], const Unit& u, int wr, int wc, int fr, int fq) const {
        asm volatile("" : "+v"(fr), "+v"(fq));
        const int pn = u.pn;
        bf16_t* Q = (bf16_t*)(ws + WS_Q); bf16_t* KR = (bf16_t*)(ws + WS_KRAW); bf16_t* VT = (bf16_t*)(ws + WS_VT); bf16_t* IQ = (bf16_t*)(ws + WS_IQ);
        bf16_t* RQ = (bf16_t*)(ws + WS_RQ); bf16_t* RK = (bf16_t*)(ws + WS_RK); bf16_t* RKT = (bf16_t*)(ws + WS_RKT); bf16_t* RVT = (bf16_t*)(ws + WS_RVT);
        bf16_t* SRG = (bf16_t*)(ws + WS_SRG); bf16_t* SGA = (bf16_t*)(ws + WS_SGA); bf16_t* SGB = (bf16_t*)(ws + WS_SGB);
        const float* rope = (const float*)(ws + WS_ROPE);
#define RS const float rs = __builtin_amdgcn_rsqf(rss[row] * (1.0f / 2048.0f) + 1e-6f);
        if (pn < 8) { EPI_ROWS(RS EPI_COLS8(st8bf(Q + (size_t)row * 2048 + pn * 256 + lc, a0 * rs, a1 * rs);)) }
        else if (pn < 10) { EPI_ROWS(RS EPI_COLS8(st8bf(KR + (size_t)row * 512 + (pn - 8) * 256 + lc, a0 * rs, a1 * rs);)) }
        else if (pn < 12) { EPI_ROWS(RS const int b = row >> 11, s = row & 2047; EPI_COLS8(const int c = (pn - 10) * 256 + lc;
                st8col(VT + ((((size_t)(b * 4 + (c >> 7)) * 32 + (s >> 6)) * 128 + (c & 127)) * 64 + (s & 63)), 64, a0 * rs, a1 * rs);)) }
        else if (pn < 16) { EPI_ROWS(RS EPI_COLS8(st8bf(IQ + (size_t)row * 1024 + (pn - 12) * 256 + lc, a0 * rs, a1 * rs);)) }
        else if (pn < 24) { const bool isk = pn >= 20; const int cb = (pn - (isk ? 20 : 16)) * 256; const float scl = isk ? 0.08838834764831845f : 1.0f;
            EPI_ROWS(RS const int b = row >> 11, s = row & 2047; EPI_COLS8(const f32x4 v0 = a0 * (rs * scl), v1 = a1 * (rs * scl);
                const float* rp = rope + ((size_t)s * 64 + ((lc & 127) >> 1)) * 2; const f32x4 cA = *(const f32x4*)rp, cB = *(const f32x4*)(rp + 4);
                f32x4 o0, o1; o0[0] = v0[0] * cA[0] - v0[1] * cA[1]; o0[1] = v0[1] * cA[0] + v0[0] * cA[1]; o0[2] = v0[2] * cA[2] - v0[3] * cA[3]; o0[3] = v0[3] * cA[2] + v0[2] * cA[3];
                o1[0] = v1[0] * cB[0] - v1[1] * cB[1]; o1[1] = v1[1] * cB[0] + v1[0] * cB[1]; o1[2] = v1[2] * cB[2] - v1[3] * cB[3]; o1[3] = v1[3] * cB[2] + v1[2] * cB[3];
                const int c = cb + lc, dd = c & 127, ii = s & 127;
                const size_t ub = ((size_t)(b * 8 + (c >> 7)) * 16 + (s >> 7)) * 16384;
                const size_t fo = ub + (ii >> 5) * 4096 + (((dd >> 4) * 2 + ((dd >> 3) & 1)) * 32 + (ii & 31)) * 8;
                if (!isk) st8bf(RQ + fo, o0, o1);
                else { st8bf(RK + fo, o0, o1); st8col(RKT + ub + (dd >> 5) * 4096 + (((ii >> 4) * 2 + ((ii >> 3) & 1)) * 32 + (dd & 31)) * 8 + (ii & 7), 8, o0, o1); })) }
        else if (pn < 32) { EPI_ROWS(RS const int b = row >> 11, s = row & 2047; EPI_COLS8(const int c = (pn - 24) * 256 + lc, ee = c & 255, ii = s & 127;
                st8col(RVT + ((size_t)(b * 8 + (c >> 8)) * 16 + (s >> 7)) * 32768 + (ee >> 5) * 4096 + (((ii >> 4) * 2 + ((ii >> 3) & 1)) * 32 + (ee & 31)) * 8 + (ii & 7), 8, a0 * rs, a1 * rs);)) }
        else if (pn < 40) { EPI_ROWS(RS const int b = row >> 11, s = row & 2047; EPI_COLS8(f32x4 v0 = a0 * rs, v1 = a1 * rs; v0 = v0 * sigm4(v0); v1 = v1 * sigm4(v1);
                const int c = (pn - 32) * 256 + lc, e = c & 255, i = s & 127;
                bf16_t* d = SRG + ((size_t)(b * 8 + (c >> 8)) * 16 + (s >> 7)) * 32768 + (i >> 5) * 8192 + (e >> 7) * 4096 + ((e >> 3) & 15) * 256 + (i & 31) * 4;
                st4bf(d, v0); st4bf(d + 128, v1);)) }
        else { bf16_t* G = (pn < 48) ? SGA : SGB; const int cb = (pn - (pn < 48 ? 40 : 48)) * 256;
            EPI_ROWS(RS EPI_COLS8(st8bf(G + (size_t)row * 2048 + cb + lc, sigm4(a0 * rs), sigm4(a1 * rs));)) }
#undef RS
    }
};
struct EpiGate {
    static constexpr bool PERM = true, AFTER_DRAIN = false, MID_HOOK = true;
    const bf16_t* GA; const bf16_t* GB; bf16_t* merged;
    __device__ __forceinline__ void mid(f32x4 (&acc)[2][2][4][2], const Unit& u, int wr, int wc, int fr, int fq) const {
        asm volatile("s_waitcnt vmcnt(0)" : "+v"(fr), "+v"(fq) :: "memory");
        EPI_ROWS(_Pragma("unroll") for (int bj = 0; bj < 2; ++bj) { const int lc = bj * 128 + wc * 32 + 8 * fq; const size_t off = (size_t)row * 2048 + u.pn * 256 + lc;
            const u32x4 ga = *(const u32x4*)(GA + off); const u32x4 gb = *(const u32x4*)(GB + off);
            const f32x4 gb0 = bflo4(gb), gb1 = bfhi4(gb); f32x4 r0 = bflo4(ga), r1 = bfhi4(ga);
            _Pragma("unroll") for (int k = 0; k < 4; ++k) { r0[k] *= __builtin_amdgcn_rcpf(fmaxf(gb0[k], 1e-30f)); r1[k] *= __builtin_amdgcn_rcpf(fmaxf(gb1[k], 1e-30f)); }
            acc[ai][bj][m][0] = acc[ai][bj][m][0] * r0; acc[ai][bj][m][1] = acc[ai][bj][m][1] * r1; })
        asm volatile("s_waitcnt vmcnt(0)" ::: "memory");
    }
    __device__ __forceinline__ void operator()(const f32x4 (&acc)[2][2][4][2], const Unit& u, int wr, int wc, int fr, int fq) const {
        asm volatile("" : "+v"(fr), "+v"(fq));
        EPI_ROWS(EPI_COLS8(const size_t off = (size_t)row * 2048 + u.pn * 256 + lc; const u32x4 g = *(const u32x4*)(GB + off); st8bf(merged + off, a0 * bflo4(g), a1 * bfhi4(g));))
    }
};
struct EpiRes {
    static constexpr bool PERM = true, AFTER_DRAIN = false, MID_HOOK = false;
    const float* xin; float* xout; bf16_t* xb; float* rss;
    __device__ __forceinline__ void operator()(const f32x4 (&acc)[2][2][4][2], const Unit& u, int wr, int wc, int fr, int fq) const {
        asm volatile("" : "+v"(fr), "+v"(fq));
        EPI_ROWS(float ss = 0.f; EPI_COLS8(const size_t off = (size_t)row * 2048 + u.pn * 256 + lc; const f32x4 o0 = *(const f32x4*)(xin + off) + a0, o1 = *(const f32x4*)(xin + off + 4) + a1;
                *(f32x4*)(xout + off) = o0; *(f32x4*)(xout + off + 4) = o1; if (xb) st8bf(xb + off, o0, o1);
                ss += ((o0[0] * o0[0] + o0[1] * o0[1]) + (o0[2] * o0[2] + o0[3] * o0[3])) + ((o1[0] * o1[0] + o1[1] * o1[1]) + (o1[2] * o1[2] + o1[3] * o1[3]));)
            if (rss) { ss += shx(ss, 16, fr + 16 * fq); ss = x32sum(ss); if (fq == 0) atomicAdd(rss + row, ss); })
    }
};
struct EpiFF1 {
    static constexpr bool PERM = true, AFTER_DRAIN = false, MID_HOOK = false;
    const float* rss; bf16_t* H;
    __device__ __forceinline__ void operator()(const f32x4 (&acc)[2][2][4][2], const Unit& u, int wr, int wc, int fr, int fq) const {
        asm volatile("" : "+v"(fr), "+v"(fq));
        EPI_ROWS(const float rs = __builtin_amdgcn_rsqf(rss[row] * (1.0f / 2048.0f) + 1e-6f); EPI_COLS8(f32x4 v0 = a0 * rs, v1 = a1 * rs;
            v0[0] = fmaxf(v0[0], 0.f); v0[1] = fmaxf(v0[1], 0.f); v0[2] = fmaxf(v0[2], 0.f); v0[3] = fmaxf(v0[3], 0.f); v1[0] = fmaxf(v1[0], 0.f); v1[1] = fmaxf(v1[1], 0.f); v1[2] = fmaxf(v1[2], 0.f); v1[3] = fmaxf(v1[3], 0.f);
            st8bf(H + (size_t)row * DFF + u.pn * 256 + lc, v0 * v0, v1 * v1);))
    }
};

__device__ __forceinline__ void tail_block(unsigned char* ws, const bf16_t* Wt, const float* rss, LAS unsigned char* lds, int rb, int wave, int lane) {
    const bf16_t* XB = (const bf16_t*)(ws + WS_XB); bf16_t* IK = (bf16_t*)(ws + WS_IK); float* IW = (float*)(ws + WS_IW);
    const int hi = lane >> 5, l32 = lane & 31, tid = wave * 64 + lane;
    const bf16_t* ap = XB + (size_t)(32 * rb + l32) * 2048 + 256 * wave + 8 * hi;
    const bf16_t* bp = Wt + (size_t)(16 * wave) * 512 + lane * 8;
    f32x16 acc[3];
#pragma unroll
    for (int nb = 0; nb < 3; ++nb) acc[nb] = (f32x16){0.f, 0.f, 0.f, 0.f, 0.f, 0.f, 0.f, 0.f, 0.f, 0.f, 0.f, 0.f, 0.f, 0.f, 0.f, 0.f};
#pragma unroll
    for (int kb = 0; kb < 4; ++kb) {
        bf16x8 af[4], bfr[3][4];
#pragma unroll
        for (int k4 = 0; k4 < 4; ++k4) { af[k4] = *(const bf16x8*)(ap + 16 * (4 * kb + k4));
#pragma unroll
            for (int nb = 0; nb < 3; ++nb) bfr[nb][k4] = *(const bf16x8*)(bp + (size_t)(nb * 128 + 4 * kb + k4) * 512); }
        __builtin_amdgcn_sched_barrier(0);
#pragma unroll
        for (int k4 = 0; k4 < 4; ++k4)
#pragma unroll
            for (int nb = 0; nb < 3; ++nb) acc[nb] = MFMA32(af[k4], bfr[nb][k4], acc[nb]);
        __builtin_amdgcn_sched_barrier(0);
    }
    LAS float* part = (LAS float*)lds;
#pragma unroll
    for (int nb = 0; nb < 3; ++nb)
#pragma unroll
        for (int r = 0; r < 16; ++r) part[wave * 3072 + crow(r, hi) * 96 + 32 * nb + l32] = acc[nb][r];
    __syncthreads();
#pragma unroll
    for (int i = 0; i < 6; ++i) {
        const int idx = tid + 512 * i, row = idx / 96, col = idx % 96;
        float v = 0.f;
#pragma unroll
        for (int w = 0; w < 8; ++w) v += part[w * 3072 + idx];
        const int grow = 32 * rb + row;
        v *= rsqrtf(rss[grow] * (1.0f / 2048.0f) + 1e-6f);
        if (col < 64) IK[(size_t)grow * 64 + col] = (bf16_t)pk2(v, 0.f);
        else if (col < 80) IW[(size_t)grow * 16 + (col - 64)] = v * 0.25f;
    }
    __syncthreads();
}

__device__ __forceinline__ void indexer_group(unsigned char* ws, LAS unsigned char* lds, int grp, int wave, int lane) {
    const bf16_t* IQ = (const bf16_t*)(ws + WS_IQ); const bf16_t* IK = (const bf16_t*)(ws + WS_IK); const float* IW = (const float*)(ws + WS_IW); unsigned* MASK = (unsigned*)(ws + WS_MASK);
    const int b = grp >> 7, T0 = (grp & 127) * 16, t0 = T0 + 2 * wave, hi = lane >> 5, l32 = lane & 31, tid = wave * 64 + lane;
    const size_t rowbase = (size_t)b * SEQ;
    const int atok = (l32 >> 2) & 1, ahead = 4 * (l32 >> 3) + (l32 & 3);
    const bf16_t* ap = IQ + (rowbase + t0 + atok) * 1024 + ahead * 64 + 8 * hi;
    bf16x8 af[4];
#pragma unroll
    for (int kk = 0; kk < 4; ++kk) af[kk] = *(const bf16x8*)(ap + 16 * kk);
    float w[16];
#pragma unroll
    for (int i = 0; i < 4; ++i) { const f32x4 t = *(const f32x4*)(IW + (rowbase + t0 + hi) * 16 + 4 * i); w[4 * i] = t[0]; w[4 * i + 1] = t[1]; w[4 * i + 2] = t[2]; w[4 * i + 3] = t[3]; }
    const int tq = t0 + hi, nj = (t0 + 1) / 32 + 1, nchunk = ((T0 + 15) / 32 + 1 + 7) / 8;
    u32x4 stg[4];
#define IDX_LOAD(c) do { _Pragma("unroll") for (int i = 0; i < 4; ++i) { const int p = tid + 512 * i; stg[i] = *(const u32x4*)(IK + (rowbase + 256 * (c) + (p >> 3)) * 64 + 8 * (p & 7)); } } while (0)
    IDX_LOAD(0);
    unsigned uk[64];
#pragma unroll
    for (int c = 0; c < 8; ++c) {
        if (c < nchunk) {
            __syncthreads();
#pragma unroll
            for (int i = 0; i < 4; ++i) { const int p = tid + 512 * i; *(LAS u32x4*)(lds + (p >> 3) * 144 + (p & 7) * 16) = stg[i]; }
            __syncthreads();
            if (c + 1 < nchunk) IDX_LOAD(c + 1);
#pragma unroll
            for (int jj = 0; jj < 8; ++jj) { const int j = 8 * c + jj;
                if (j < nj) {
                    const LAS unsigned char* bp = lds + (32 * jj + l32) * 144 + 16 * hi;
                    f32x16 cc = {0.f, 0.f, 0.f, 0.f, 0.f, 0.f, 0.f, 0.f, 0.f, 0.f, 0.f, 0.f, 0.f, 0.f, 0.f, 0.f};
#pragma unroll
                    for (int kk = 0; kk < 4; ++kk) cc = MFMA32(af[kk], *(const LAS bf16x8*)(bp + 32 * kk), cc);
                    float sc = 0.f;
#pragma unroll
                    for (int r = 0; r < 16; ++r) sc += w[r] * fmaxf(cc[r], 0.f);
                    const unsigned bits = __float_as_uint(sc); const unsigned ku = bits ^ ((bits >> 31) ? 0xffffffffu : 0x80000000u);
                    uk[j] = (32 * j + l32 <= tq) ? ku : 0u;
                } else uk[j] = 0u; }
        } else {
#pragma unroll
            for (int jj = 0; jj < 8; ++jj) uk[8 * c + jj] = 0u; }
    }
#undef IDX_LOAD
    unsigned p = 0u; bool done = (tq + 1 <= 256);
    for (int bit = 31; bit >= 0; --bit) {
        if (__all(done)) break;
        const unsigned cand = p | (1u << bit);
        int cnt = 0;
#pragma unroll
        for (int g = 0; g < 8; ++g) if (8 * g < nj) {
#pragma unroll
            for (int jj = 0; jj < 8; ++jj) cnt += (uk[8 * g + jj] >= cand) ? 1 : 0; }
        cnt += __builtin_amdgcn_update_dpp(0, cnt, 0xB1, 0xF, 0xF, true); cnt += __builtin_amdgcn_update_dpp(0, cnt, 0x4E, 0xF, 0xF, true);
        cnt += __builtin_amdgcn_update_dpp(0, cnt, 0x141, 0xF, 0xF, true); cnt += __builtin_amdgcn_update_dpp(0, cnt, 0x140, 0xF, 0xF, true);
        { auto rr = __builtin_amdgcn_permlane16_swap((unsigned)cnt, (unsigned)cnt, false, false); cnt = (int)(rr[0] + rr[1]); }
        if (!done && cnt >= 256) { p = cand; if (cnt == 256) done = true; }
    }
    const unsigned thr = (tq + 1 <= 256) ? 1u : (p > 1u ? p : 1u);
    unsigned alo = 0u, ahi = 0u;
#pragma unroll
    for (int j = 0; j < 64; ++j) { const unsigned long long bal = __ballot(uk[j] >= thr); if (lane == j) { alo = (unsigned)bal; ahi = (unsigned)(bal >> 32); } }
    MASK[(rowbase + t0) * 64 + lane] = alo; MASK[(rowbase + t0 + 1) * 64 + lane] = ahi;
}

__device__ __forceinline__ void ra_unit(unsigned char* ws, int unit, int wave, int lane) {
    const bf16_t* RVT = (const bf16_t*)(ws + WS_RVT); const bf16_t* RKT = (const bf16_t*)(ws + WS_RKT); float* U = (float*)(ws + WS_U);
    const int b = unit >> 7, h = (unit >> 4) & 7, n = unit & 15, s0 = n * 128, eb = wave, hi = lane >> 5, l32 = lane & 31;
    const float lg2 = __log2f(1.0f - exp2f(-5.0f - (float)h));
    const bf16_t* vp = RVT + ((size_t)(b * 2048 + h * 256 + 32 * eb + l32)) * 2048 + s0 + 8 * hi;
    bf16x8 af[8];
#pragma unroll
    for (int kk = 0; kk < 8; ++kk) { const bf16x8 raw = *(const bf16x8*)(vp + 16 * kk); float f[8];
#pragma unroll
        for (int i = 0; i < 8; ++i) f[i] = bf2f((unsigned)(unsigned short)raw[i]) * exp2f(lg2 * (float)(127 - (16 * kk + 8 * hi + i)));
        af[kk] = pack8(f); }
    __builtin_amdgcn_sched_barrier(0);
#pragma unroll
    for (int db = 0; db < 4; ++db) {
        bf16x8 bfr[8];
        const bf16_t* kp = RKT + ((size_t)(b * 1024 + h * 128 + 32 * db + l32)) * 2048 + s0 + 8 * hi;
#pragma unroll
        for (int kk = 0; kk < 8; ++kk) bfr[kk] = *(const bf16x8*)(kp + 16 * kk);
        __builtin_amdgcn_sched_barrier(0);
        f32x16 c = {0.f, 0.f, 0.f, 0.f, 0.f, 0.f, 0.f, 0.f, 0.f, 0.f, 0.f, 0.f, 0.f, 0.f, 0.f, 0.f};
#pragma unroll
        for (int kk = 0; kk < 8; ++kk) c = MFMA32(af[kk], bfr[kk], c);
#pragma unroll
        for (int r = 0; r < 16; ++r) U[(size_t)unit * 32768 + (32 * eb + crow(r, hi)) * 128 + 32 * db + l32] = c[r];
        __builtin_amdgcn_sched_barrier(0);
    }
}
__device__ __forceinline__ void rb_scan(unsigned char* ws, int gtid, int nthr) {
    const float* U = (const float*)(ws + WS_U); bf16_t* RP = (bf16_t*)(ws + WS_RP);
    for (int it = gtid; it < 32 * 8192; it += nthr) {
        const int bh = it >> 13, e4 = (it & 8191) * 4, h = bh & 7;
        const float lg2 = __log2f(1.0f - exp2f(-5.0f - (float)h)); const float cd = exp2f(lg2 * 128.0f);
        f32x4 R = {0.f, 0.f, 0.f, 0.f};
#pragma unroll 4
        for (int n = 0; n < 16; ++n) { const size_t off = ((size_t)(bh * 16 + n)) * 32768 + e4; st4bf(RP + off, R); R = *(const f32x4*)(U + off) + R * cd; }
    }
}
__device__ __forceinline__ void stage_put(LAS unsigned char* stg, int lane, int colgrp4  , f32x4 v) {
    *(LAS u32x2*)(stg + (lane & 31) * 272 + colgrp4 * 2) = (u32x2){pk2(v[0], v[1]), pk2(v[2], v[3])};
}
__device__ __forceinline__ void stage_flush(const LAS unsigned char* stg, int lane, bf16_t* out  , size_t row_stride) {
    asm volatile("s_waitcnt lgkmcnt(0)" ::: "memory");
#pragma unroll
    for (int it = 0; it < 8; ++it) { const int row = it * 4 + (lane >> 4), ch = lane & 15; *(u32x4*)(out + (size_t)row * row_stride + ch * 8) = *(const LAS u32x4*)(stg + row * 272 + ch * 16); }
    asm volatile("s_waitcnt lgkmcnt(0)" ::: "memory");
}
__device__ __forceinline__ void rascan_unit(unsigned char* ws, int unit, int wave, int lane) {
    const bf16_t* RVT = (const bf16_t*)(ws + WS_RVT); const bf16_t* RKT = (const bf16_t*)(ws + WS_RKT); bf16_t* RP = (bf16_t*)(ws + WS_RP);
    const int b = unit >> 5, h = (unit >> 2) & 7, dblk = unit & 3, eb = wave, hi = lane >> 5, l32 = lane & 31;
    const float lg2 = __log2f(1.0f - exp2f(-5.0f - (float)h)); const float cd = exp2f(lg2 * 128.0f);
    float zi[8], zk[8];
#pragma unroll
    for (int i = 0; i < 8; ++i) { zi[i] = exp2f(lg2 * (float)(127 - 8 * hi - i)); zk[i] = exp2f(lg2 * (float)(-16 * i)); }
    const bf16_t* vrow = RVT + ((size_t)(b * 8 + h) * 16) * 32768 + eb * 4096 + lane * 8;
    const bf16_t* krow = RKT + ((size_t)(b * 8 + h) * 16) * 16384 + dblk * 4096 + lane * 8;
    const int dq = 32 * dblk + l32; bf16_t* rpo = RP + ((size_t)(b * 8 + h) * 16) * 32768 + eb * 4096 + (((dq >> 4) * 2 + ((dq >> 3) & 1)) * 32 + 4 * hi) * 8 + (dq & 7);
    f32x16 R = {0.f, 0.f, 0.f, 0.f, 0.f, 0.f, 0.f, 0.f, 0.f, 0.f, 0.f, 0.f, 0.f, 0.f, 0.f, 0.f};
    bf16x8 va[8], ka[8];
#define RS_LOAD(n, V, K) do { _Pragma("unroll") for (int kk = 0; kk < 8; ++kk) { V[kk] = *(const bf16x8*)(vrow + (size_t)(n) * 32768 + 512 * kk); K[kk] = *(const bf16x8*)(krow + (size_t)(n) * 16384 + 512 * kk); } } while (0)
#pragma unroll 1
    for (int n = 0; n < 16; ++n) {
        if (n == 0) RS_LOAD(0, va, ka);
        __builtin_amdgcn_sched_barrier(0);
        f32x16 u_ = {0.f, 0.f, 0.f, 0.f, 0.f, 0.f, 0.f, 0.f, 0.f, 0.f, 0.f, 0.f, 0.f, 0.f, 0.f, 0.f};
#pragma unroll
        for (int kk = 0; kk < 8; ++kk) { float f_[8];
#pragma unroll
            for (int i = 0; i < 8; ++i) f_[i] = bf2f((unsigned)(unsigned short)va[kk][i]) * (zk[kk] * zi[i]);
            u_ = MFMA32(pack8(f_), ka[kk], u_); }
        __builtin_amdgcn_sched_barrier(0);
        if (n + 1 < 16) RS_LOAD(n + 1, va, ka);
        __builtin_amdgcn_sched_barrier(0);
        bf16_t* rp_ = rpo + (size_t)n * 32768;
#pragma unroll
        for (int r = 0; r < 16; ++r) rp_[((r & 3) + 8 * (r >> 2)) * 8] = (bf16_t)pk2(R[r], 0.f);
        R = u_ + R * cd;
        __builtin_amdgcn_sched_barrier(0);
    }
#undef RS_LOAD
#undef RS_STEP
}
__device__ __forceinline__ void rc_unit(unsigned char* ws, const float* gn_g, const float* gn_b, LAS unsigned char* lds, int unit, int layer, int wave, int lane) {
    const bf16_t* RQ = (const bf16_t*)(ws + WS_RQ); const bf16_t* RK = (const bf16_t*)(ws + WS_RK); const bf16_t* RVT = (const bf16_t*)(ws + WS_RVT); const bf16_t* RP = (const bf16_t*)(ws + WS_RP);
    const bf16_t* SRG = (const bf16_t*)(ws + WS_SRG); bf16_t* ORET = (bf16_t*)(ws + WS_OATT) + 2048;
    const int b = unit >> 7, h = (unit >> 4) & 7, n = unit & 15, s0 = n * 128, ib = wave >> 1, eh = wave & 1, hi = lane >> 5, l32 = lane & 31;
    const float lg2 = __log2f(1.0f - exp2f(-5.0f - (float)h));
    const size_t tok = (size_t)b * SEQ + s0 + 32 * ib + l32;
    bf16x8 qf[8];
#pragma unroll
    for (int kk = 0; kk < 8; ++kk) qf[kk] = *(const bf16x8*)(RQ + (size_t)unit * 16384 + ib * 4096 + kk * 512 + lane * 8);
    f32x16 acc[4];
    const int iq = 32 * ib + l32;
    bf16x8 pfr[4][2];
    {
        bf16x8 kf[32];
#pragma unroll
        for (int jb = 0; jb < 4; ++jb) { const bf16_t* kp = RK + (size_t)unit * 16384 + jb * 4096 + (hi * 32 + kperm(l32)) * 8;
#pragma unroll
            for (int kk = 0; kk < 8; ++kk) kf[8 * jb + kk] = *(const bf16x8*)(kp + 512 * kk); }
        __builtin_amdgcn_sched_barrier(0);
#pragma unroll
        for (int jb = 0; jb < 4; ++jb) { f32x16 st = {0.f, 0.f, 0.f, 0.f, 0.f, 0.f, 0.f, 0.f, 0.f, 0.f, 0.f, 0.f, 0.f, 0.f, 0.f, 0.f};
#pragma unroll
            for (int kk = 0; kk < 8; ++kk) st = MFMA32(kf[8 * jb + kk], qf[kk], st);
            float f[16];
#pragma unroll
            for (int r = 0; r < 16; ++r) { const int j = 32 * jb + 16 * (r >> 3) + 8 * hi + (r & 7); const int df = iq - j; f[r] = (df >= 0) ? st[r] * exp2f(lg2 * (float)df) : 0.f; }
            pfr[jb][0] = pack8(f); pfr[jb][1] = pack8(f + 8); }
        __builtin_amdgcn_sched_barrier(0);
    }
    int lnc = lane; asm volatile("" : "+v"(lnc)); const int l32c = lnc & 31;
#pragma unroll
    for (int ep = 0; ep < 2; ++ep) {
        bf16x8 rf[16];
#pragma unroll
        for (int e2 = 0; e2 < 2; ++e2) { const int eb = 4 * eh + 2 * ep + e2; const bf16_t* rp = RP + (size_t)unit * 32768 + eb * 4096 + lnc * 8;
#pragma unroll
            for (int kk = 0; kk < 8; ++kk) rf[8 * e2 + kk] = *(const bf16x8*)(rp + 512 * kk); }
        __builtin_amdgcn_sched_barrier(0);
#pragma unroll
        for (int e2 = 0; e2 < 2; ++e2) { f32x16 c = {0.f, 0.f, 0.f, 0.f, 0.f, 0.f, 0.f, 0.f, 0.f, 0.f, 0.f, 0.f, 0.f, 0.f, 0.f, 0.f};
#pragma unroll
            for (int kk = 0; kk < 8; ++kk) c = MFMA32(rf[8 * e2 + kk], qf[kk], c);
            acc[2 * ep + e2] = c * exp2f(lg2 * (float)(32 * ib + l32c + 1)); }
        __builtin_amdgcn_sched_barrier(0);
    }
    int lnv = lane; asm volatile("" : "+v"(lnv)); const int l32v = lnv & 31, hiv = lnv >> 5;
#pragma unroll
    for (int ep = 0; ep < 2; ++ep) {
        bf16x8 vf[16];
#pragma unroll
        for (int e2 = 0; e2 < 2; ++e2) { const int eb = 4 * eh + 2 * ep + e2; const bf16_t* vp = RVT + (size_t)unit * 32768 + eb * 4096 + lnv * 8;
#pragma unroll
            for (int q = 0; q < 8; ++q) vf[8 * e2 + q] = *(const bf16x8*)(vp + 512 * q); }
        __builtin_amdgcn_sched_barrier(0);
#pragma unroll
        for (int e2 = 0; e2 < 2; ++e2)
#pragma unroll
            for (int q = 0; q < 8; ++q) acc[2 * ep + e2] = MFMA32(vf[8 * e2 + q], pfr[q >> 1][q & 1], acc[2 * ep + e2]);
        __builtin_amdgcn_sched_barrier(0);
    }
    float s1 = 0.f, s2 = 0.f;
#pragma unroll
    for (int el = 0; el < 4; ++el)
#pragma unroll
        for (int r = 0; r < 16; ++r) { const float v = acc[el][r]; s1 += v; s2 += v * v; }
    s1 = x32sum(s1); s2 = x32sum(s2);
    LAS float* xs = (LAS float*)lds;
    __syncthreads();
    if (hi == 0) { xs[(wave * 32 + l32) * 2] = s1; xs[(wave * 32 + l32) * 2 + 1] = s2; }
    __syncthreads();
    s1 += xs[((wave ^ 1) * 32 + l32) * 2]; s2 += xs[((wave ^ 1) * 32 + l32) * 2 + 1];
    const float mu = s1 * (1.0f / 256.0f); const float var = fmaxf(s2 * (1.0f / 256.0f) - mu * mu, 0.f); const float rstd = rsqrtf(var + 1e-6f);
    const float* gg = gn_g + layer * 2048 + h * 256; const float* gb = gn_b + layer * 2048 + h * 256;
    int ln2 = lane; asm volatile("" : "+v"(ln2));
    const int hi2 = ln2 >> 5;
    const bf16_t* sgp = SRG + (size_t)unit * 32768 + ib * 8192 + eh * 4096 + ln2 * 4;
    LAS unsigned char* stg = lds + 4096 + wave * 8704;
#pragma unroll
    for (int el = 0; el < 4; ++el)
#pragma unroll
        for (int c4 = 0; c4 < 4; ++c4) {
            const int e0 = 32 * (4 * eh + el) + 8 * c4 + 4 * hi2;
            const f32x4 g4 = *(const f32x4*)(gg + e0), b4 = *(const f32x4*)(gb + e0); const u32x2 sg = *(const u32x2*)(sgp + (el * 4 + c4) * 256);
            f32x4 o;
            o[0] = ((acc[el][4 * c4 + 0] - mu) * rstd * g4[0] + b4[0]) * bf2f(sg.x & 0xffffu);
            o[1] = ((acc[el][4 * c4 + 1] - mu) * rstd * g4[1] + b4[1]) * bf2f(sg.x >> 16);
            o[2] = ((acc[el][4 * c4 + 2] - mu) * rstd * g4[2] + b4[2]) * bf2f(sg.y & 0xffffu);
            o[3] = ((acc[el][4 * c4 + 3] - mu) * rstd * g4[3] + b4[3]) * bf2f(sg.y >> 16);
            stage_put(stg, ln2, 32 * el + 8 * c4 + 4 * hi2, o);
        }
    stage_flush(stg, ln2, ORET + ((size_t)b * SEQ + s0 + 32 * ib) * 4096 + h * 256 + 128 * eh, 4096);
}

constexpr int KT_STRIDE = 136, VT_STRIDE = 72, ATT_K_OFF = 0, ATT_V_OFF = 64 * KT_STRIDE * 2, ATT_BUF = 64 * KT_STRIDE * 2 + 128 * VT_STRIDE * 2, ATT_Q_OFF = 2 * ATT_BUF;
__device__ __forceinline__ void attn_unit(unsigned char* ws, const float* qn_g, const float* kn_g, LAS unsigned char* lds, int unit, int layer, int wave, int lane) {
    const bf16_t* Q = (const bf16_t*)(ws + WS_Q); const bf16_t* KN = (const bf16_t*)(ws + WS_KN); const bf16_t* VT = (const bf16_t*)(ws + WS_VT); const unsigned* MASK = (const unsigned*)(ws + WS_MASK);
    bf16_t* OATT = (bf16_t*)(ws + WS_OATT);
    const int tid = wave * 64 + lane, hi = lane >> 5, l32 = lane & 31;
    int bg, qb; if (unit < 256) { bg = unit >> 4; qb = unit & 15; } else { bg = (unit - 256) >> 4; qb = 31 - ((unit - 256) & 15); }
    const int b = bg >> 2, g = bg & 3, hh = g * 4 + (wave >> 1), q0 = qb * 64, qs = q0 + 32 * (wave & 1);
    const size_t tok = (size_t)b * SEQ + qs + l32;
    bf16x8 qf[8]; float mfix;
    {
        float ss = 0.f;
        const bf16_t* qp = Q + tok * 2048 + hh * 128 + 8 * hi;
#pragma unroll
        for (int kk = 0; kk < 8; ++kk) { qf[kk] = *(const bf16x8*)(qp + 16 * kk);
#pragma unroll
            for (int i = 0; i < 8; ++i) { const float v = bf2f((unsigned)(unsigned short)qf[kk][i]); ss += v * v; } }
        ss = x32sum(ss);
        const float rs = rsqrtf(ss * (1.0f / 128.0f) + 1e-6f) * (0.08838834764831845f * 1.4426950408889634f);
        const float* qg = qn_g + layer * 128 + 8 * hi; float s2 = 0.f;
#pragma unroll
        for (int kk = 0; kk < 8; ++kk) { float f[8];
#pragma unroll
            for (int i = 0; i < 8; ++i) { f[i] = bf2f((unsigned)(unsigned short)qf[kk][i]) * rs * qg[16 * kk + i]; s2 += f[i] * f[i]; }
            *(LAS bf16x8*)(lds + ATT_Q_OFF + wave * 8192 + kk * 1024 + lane * 16) = pack8(f); }
        s2 = x32sum(s2);
        float gm = fmaxf(fabsf(kn_g[layer * 128 + 2 * lane]), fabsf(kn_g[layer * 128 + 2 * lane + 1]));
#pragma unroll
        for (int o = 1; o < 64; o <<= 1) gm = fmaxf(gm, shx(gm, o, lane));
        mfix = sqrtf(s2) * 11.313708498984761f * gm * 1.01f + 0.01f;
    }
    f32x16 o[4];
#pragma unroll
    for (int d = 0; d < 4; ++d) o[d] = (f32x16){0.f, 0.f, 0.f, 0.f, 0.f, 0.f, 0.f, 0.f, 0.f, 0.f, 0.f, 0.f, 0.f, 0.f, 0.f, 0.f};
    float lrun = 0.f;
    const int nt = qb + 1;
    const bf16_t* kbase = KN + ((size_t)(b * 4 + g) * SEQ) * 128; const bf16_t* vbase = VT + ((size_t)(b * 4 + g) * 32) * 8192;
    u32x4 kst[2], vst[2];
    unsigned koff[2], voff[2];
#pragma unroll
    for (int i = 0; i < 2; ++i) { const int p = tid + 512 * i; koff[i] = (unsigned)(p * 16); voff[i] = (unsigned)(p * 16); }
#define ATT_LOAD(t) do { const char* kb_ = (const char*)(kbase + (size_t)(t) * 8192); const char* vb_ = (const char*)(vbase + (size_t)(t) * 8192); \
        _Pragma("unroll") for (int i = 0; i < 2; ++i) { kst[i] = *(const u32x4*)(kb_ + koff[i]); vst[i] = *(const u32x4*)(vb_ + voff[i]); } } while (0)
#define ATT_STORE(buf) do { _Pragma("unroll") for (int i = 0; i < 2; ++i) { const int p = tid + 512 * i; *(LAS u32x4*)(lds + (buf) * ATT_BUF + ATT_K_OFF + ((p >> 4) * KT_STRIDE + 8 * (p & 15)) * 2) = kst[i]; \
        *(LAS u32x4*)(lds + (buf) * ATT_BUF + ATT_V_OFF + ((p >> 3) * VT_STRIDE + 8 * (p & 7)) * 2) = vst[i]; } } while (0)
    __builtin_amdgcn_sched_barrier(0);
    const char* mbase = (const char*)(MASK + ((size_t)b * SEQ + qs) * 64); const unsigned moff = (unsigned)l32 * 256u;
    u32x2 mwn = *(const u32x2*)(mbase + moff);
    ATT_LOAD(0);
    __syncthreads();
    ATT_STORE(0);
    __syncthreads();
    for (int t = 0; t < nt; ++t) {
        const int cur = t & 1;
        const u32x2 mw = mwn;
        if (t + 1 < nt) { mwn = *(const u32x2*)(mbase + (moff + 8u * (unsigned)(t + 1))); ATT_LOAD(t + 1); }
        float psum = 0.f; bf16x8 pf[2][2];
        const LAS unsigned char* kp = lds + cur * ATT_BUF + ATT_K_OFF + (kperm(l32) * KT_STRIDE + 8 * hi) * 2;
        const LAS unsigned char* vp = lds + cur * ATT_BUF + ATT_V_OFF + (l32 * VT_STRIDE + 8 * hi) * 2;
#define KFR(p, kk) (*(const LAS bf16x8*)(kp + (p) * (32 * KT_STRIDE * 2) + 32 * (kk)))
#define VFR(d, q) (*(const LAS bf16x8*)(vp + (d) * (32 * VT_STRIDE * 2) + 32 * (q)))
        f32x16 c0, c1;
#pragma unroll
        for (int r = 0; r < 16; ++r) { c0[r] = -mfix; c1[r] = -mfix; }
        const LAS unsigned char* qpk = lds + ATT_Q_OFF + wave * 8192 + lane * 16;
#define QFR(kk) (*(const LAS bf16x8*)(qpk + (kk) * 1024))
        bf16x8 fA[4], fB[4], qA[2], qB[2];
#define LDK(F, Qv, i) do { F[0] = KFR(0, 2 * (i)); F[1] = KFR(1, 2 * (i)); F[2] = KFR(0, 2 * (i) + 1); F[3] = KFR(1, 2 * (i) + 1); Qv[0] = QFR(2 * (i)); Qv[1] = QFR(2 * (i) + 1); } while (0)
#define LDV(F, d) do { F[0] = VFR(d, 0); F[1] = VFR(d, 1); F[2] = VFR(d, 2); F[3] = VFR(d, 3); } while (0)
#define MMK(F, Qv) do { c0 = MFMA32(F[0], Qv[0], c0); c1 = MFMA32(F[1], Qv[0], c1); c0 = MFMA32(F[2], Qv[1], c0); c1 = MFMA32(F[3], Qv[1], c1); } while (0)
#define MMV(F, d) do { o[d] = MFMA32(F[0], pf[0][0], o[d]); o[d] = MFMA32(F[1], pf[0][1], o[d]); o[d] = MFMA32(F[2], pf[1][0], o[d]); o[d] = MFMA32(F[3], pf[1][1], o[d]); } while (0)
#define SB() __builtin_amdgcn_sched_barrier(0)
        LDK(fA, qA, 0); SB();
        LDK(fB, qB, 1); SB(); MMK(fA, qA); SB();
        LDK(fA, qA, 2); SB(); MMK(fB, qB); SB();
        LDK(fB, qB, 3); SB(); MMK(fA, qA); SB();
        LDV(fA, 0);     SB(); MMK(fB, qB); SB();
#undef QFR
#pragma unroll
        for (int p = 0; p < 2; ++p) {
            const int wbits = (int)((p ? mw.y : mw.x) >> (8 * hi));
            float f[16];
#pragma unroll
            for (int r = 0; r < 16; ++r) { const float e = __builtin_amdgcn_exp2f(p ? c1[r] : c0[r]); int mb;
                asm("v_bfe_i32 %0, %1, %2, 1" : "=v"(mb) : "v"(wbits), "n"(16 * (r >> 3) + (r & 7)));
                f[r] = __uint_as_float(__float_as_uint(e) & (unsigned)mb); psum += f[r]; }
            pf[p][0] = pack8(f); pf[p][1] = pack8(f + 8);
        }
        lrun += psum;
        SB();
        LDV(fB, 1); SB(); MMV(fA, 0); SB();
        LDV(fA, 2); SB(); MMV(fB, 1); SB();
        LDV(fB, 3); SB(); MMV(fA, 2); SB();
        MMV(fB, 3); SB();
#undef LDK
#undef LDV
#undef MMK
#undef MMV
#undef SB
#undef KFR
#undef VFR
        if (t + 1 < nt) ATT_STORE(cur ^ 1);
        __syncthreads();
    }
#undef ATT_LOAD
#undef ATT_STORE
    lrun = x32sum(lrun);
    const float inv = 1.0f / lrun;
    int ln2 = lane; asm volatile("" : "+v"(ln2));
    LAS unsigned char* stg = lds + wave * 8704;
#pragma unroll
    for (int d = 0; d < 4; ++d)
#pragma unroll
        for (int c4 = 0; c4 < 4; ++c4) {
            f32x4 v; v[0] = o[d][4 * c4] * inv; v[1] = o[d][4 * c4 + 1] * inv; v[2] = o[d][4 * c4 + 2] * inv; v[3] = o[d][4 * c4 + 3] * inv;
            stage_put(stg, ln2, 32 * d + 8 * c4 + 4 * (ln2 >> 5), v);
        }
    stage_flush(stg, ln2, OATT + ((size_t)b * SEQ + qs) * 4096 + hh * 128, 4096);
}

#define XB_TMO      128
#define XB_XCNT(j)  (256  + 64 * (j))
#define XB_XSUB(j)  (1280 + 64 * (j))
#define XB_XGEN(j)  (2304 + 64 * (j))
#define XB_TOP      3328
#define XB_TOPGEN   3392
#define XCD_BAR_WORDS 3456
#define XB_SPIN_CAP (1u << 18)

__device__ __forceinline__ unsigned xb_ld(unsigned* p)              { return __hip_atomic_load(p, __ATOMIC_RELAXED, __HIP_MEMORY_SCOPE_AGENT); }
__device__ __forceinline__ unsigned xb_add(unsigned* p, unsigned v) { return __hip_atomic_fetch_add(p, v, __ATOMIC_RELAXED, __HIP_MEMORY_SCOPE_AGENT); }
__device__ __forceinline__ unsigned xb_xcc_id() { return (unsigned)__builtin_amdgcn_s_getreg((3 << 11) | 20) & 0xFu; }
#define XB_SPIN(cond, bar) do { unsigned _sp = 0; while (cond) { __builtin_amdgcn_s_sleep(1); \
    if ((++_sp & 255u) == 0u) { if (xb_ld(&(bar)[XB_TMO])) break; if (_sp > XB_SPIN_CAP) { atomicAdd(&(bar)[XB_TMO], 1u); break; } } } } while (0)

struct XcdBarrier {
    unsigned* bar; unsigned x;
    volatile LAS unsigned* st;
};

__device__ __forceinline__ XcdBarrier xcd_barrier_post(unsigned* bar, volatile LAS unsigned* st) {
    XcdBarrier b; b.bar = bar; b.x = xb_xcc_id(); b.st = st;
    if (threadIdx.x == 0) (void)xb_add(&bar[XB_XCNT(b.x)], 1u);
    return b;
}
__device__ __forceinline__ void xcd_barrier_complete(unsigned* bar, unsigned x, unsigned& nloc, unsigned& nx) {
    const unsigned G = gridDim.x * gridDim.y * gridDim.z;
    unsigned sum, cnt, mine, sp = 0u;
    for (;;) {
        sum = 0u; cnt = 0u; mine = 0u;
#pragma unroll
        for (unsigned j = 0; j < 16; ++j) { const unsigned c = xb_ld(&bar[XB_XCNT(j)]); sum += c; cnt += (c > 0u) ? 1u : 0u; mine = (j == x) ? c : mine; }
        if (sum == G) break;
        __builtin_amdgcn_s_sleep(1);
        if ((++sp & 255u) == 0u) { if (xb_ld(&bar[XB_TMO])) break; if (sp > XB_SPIN_CAP) { atomicAdd(&bar[XB_TMO], 1u); break; } }
    }
    nloc = mine > 0u ? mine : 1u; nx = cnt > 0u ? cnt : 1u;
}

__device__ __forceinline__ void xcd_barrier(const XcdBarrier& b) {
    asm volatile("s_waitcnt vmcnt(0)" ::: "memory");
    __syncthreads();
    if (threadIdx.x == 0) {
        unsigned* bar = b.bar;
        __builtin_amdgcn_s_waitcnt(0);
        unsigned nloc = b.st[0], nx = b.st[1];
        if (nloc == 0u) { xcd_barrier_complete(bar, b.x, nloc, nx); b.st[0] = nloc; b.st[1] = nx; }
        const unsigned old = xb_add(&bar[XB_XSUB(b.x)], 1u);
        const unsigned gen = old / nloc;
        if (old + 1u == (gen + 1u) * nloc) {
            __builtin_amdgcn_fence(__ATOMIC_RELEASE, "agent");
            asm volatile("s_waitcnt vmcnt(0)" ::: "memory");
            const unsigned og = xb_add(&bar[XB_TOP], 1u);
            const unsigned tg = og / nx;
            if (og + 1u == (tg + 1u) * nx) xb_add(&bar[XB_TOPGEN], 1u);
            else XB_SPIN(xb_ld(&bar[XB_TOPGEN]) == tg, bar);
            __builtin_amdgcn_fence(__ATOMIC_ACQUIRE, "agent");
            xb_add(&bar[XB_XGEN(b.x)], 1u);
            asm volatile("s_waitcnt vmcnt(0)" ::: "memory");
        } else {
            XB_SPIN(xb_ld(&bar[XB_XGEN(b.x)]) == gen, bar);
            __builtin_amdgcn_fence(__ATOMIC_ACQUIRE, "agent");
            asm volatile("s_waitcnt vmcnt(0)" ::: "memory");
        }
    }
    __syncthreads();
}

constexpr int LDS_BYTES = 139264;
__global__ void __launch_bounds__(NTHR, 2) hybrid_fwd(Params P_unused) {
    extern __shared__ __attribute__((aligned(16))) unsigned char lds_raw[];
    cg::grid_group grid = cg::this_grid();
#define FRESH() LAS unsigned char* lds = (LAS unsigned char*)lds_raw; int tid = threadIdx.x; asm volatile("" : "+v"(tid)); const int lane = tid & 63, wave = __builtin_amdgcn_readfirstlane(tid >> 6); \
    int G = gridDim.x, bx = blockIdx.x; asm volatile("" : "+s"(G), "+s"(bx)); const int gw = bx * NWAVE + wave, NGW = G * NWAVE; CP pp = getP(); unsigned char* ws = pp->ws; \
    float* RSS = (float*)(ws + WS_RSS); bf16_t* XB = (bf16_t*)(ws + WS_XB); (void)lane; (void)gw; (void)NGW; (void)RSS; (void)XB; (void)lds;
    {
        FRESH();
        if (tid < 4) ((LAS unsigned*)(lds + LDS_BYTES - 16))[tid] = 0u;
        __syncthreads();
        (void)xcd_barrier_post((unsigned*)(ws + WS_BAR), (volatile LAS unsigned*)(lds + LDS_BYTES - 16));
#ifndef NO_PRO
        for (int rep = 0; rep < REP_PRO; ++rep) prologue(pp, lds, gw, NGW, wave, lane);
#endif
    }
    if (P_unused.out == nullptr) grid.sync();
#define GSYNC() do { LAS unsigned char* lds_ = (LAS unsigned char*)lds_raw; XcdBarrier xb_; xb_.bar = (unsigned*)(getP()->ws + WS_BAR); xb_.x = xb_xcc_id(); xb_.st = (volatile LAS unsigned*)(lds_ + LDS_BYTES - 16); xcd_barrier(xb_); } while (0)
    GSYNC();
#pragma unroll 1
    for (int l = 0; l < NL; ++l) {
        {
            FRESH();
            pg8::Gemm g{XB, (const bf16_t*)(ws + WS_WIN + l * 57 * MiB), NTOK, NMAIN, DM}; pg8::StaticOrder S; S.init(NTOK, NMAIN, G, bx);
            EpiIn E{RSS + (2 * l) * NTOK, ws};
#ifndef NO_G1
            pg8::gemm_phase<EpiIn, pg8::StaticOrder, GA_, GS_>(lds, g, S, E);
#endif
            for (int rb = bx; rb < NTOK / 32; rb += G) tail_block(ws, (const bf16_t*)(ws + WS_WIN + l * 57 * MiB) + (size_t)NMAIN * DM, RSS + (2 * l) * NTOK, lds, rb, wave, lane);
        }
        GSYNC();
        {
            FRESH();
            const bf16_t* KR = (const bf16_t*)(ws + WS_KRAW); bf16_t* KN = (bf16_t*)(ws + WS_KN); const float* kg = pp->kn_g + l * 128;
            for (int rep = 0; rep < REP_P2; ++rep) {
            {
                const int q16 = lane >> 4, c16 = lane & 15;
                const f32x4 kg0 = *(const f32x4*)(kg + 8 * c16), kg1 = *(const f32x4*)(kg + 8 * c16 + 4);
                for (int base = gw; base < NTOK; base += 4 * NGW) {
                    u32x4 kv[4];
#pragma unroll
                    for (int j = 0; j < 4; ++j) { const int st = base + j * NGW; const int pair = st * 4 + q16;
                        kv[j] = (st < NTOK) ? *(const u32x4*)(KR + (size_t)(pair >> 2) * 512 + (pair & 3) * 128 + 8 * c16) : (u32x4){0u, 0u, 0u, 0u}; }
                    __builtin_amdgcn_sched_barrier(0);
#pragma unroll
                    for (int j = 0; j < 4; ++j) { const int st = base + j * NGW; const int pair = st * 4 + q16, row = pair >> 2, g4 = pair & 3;
                        const f32x4 lo = bflo4(kv[j]), hi4 = bfhi4(kv[j]);
                        float ss = ((lo[0] * lo[0] + lo[1] * lo[1]) + (lo[2] * lo[2] + lo[3] * lo[3])) + ((hi4[0] * hi4[0] + hi4[1] * hi4[1]) + (hi4[2] * hi4[2] + hi4[3] * hi4[3]));
                        ss += __int_as_float(__builtin_amdgcn_update_dpp(0, __float_as_int(ss), 0xB1, 0xF, 0xF, true)); ss += __int_as_float(__builtin_amdgcn_update_dpp(0, __float_as_int(ss), 0x4E, 0xF, 0xF, true));
                        ss += __int_as_float(__builtin_amdgcn_update_dpp(0, __float_as_int(ss), 0x141, 0xF, 0xF, true)); ss += __int_as_float(__builtin_amdgcn_update_dpp(0, __float_as_int(ss), 0x140, 0xF, 0xF, true));
                        const float rs = rsqrtf(ss * (1.0f / 128.0f) + 1e-6f);
                        if (st < NTOK) st8bf(KN + ((size_t)((row >> 11) * 4 + g4) * SEQ + (row & 2047)) * 128 + 8 * c16, lo * rs * kg0, hi4 * rs * kg1); }
                }
            }
            {
                const bool bal = (G == 256); const int i = bx & 127, q = i & 63, hb = i >> 6;
                if (bal) { if (bx < 128) rascan_unit(ws, bx, wave, lane); }
                else { for (int u = bx; u < 128; u += G) rascan_unit(ws, u, wave, lane); }
                const int ng = bal ? (bx < 128 ? 1 : 3) : 2 * ((255 - bx) / G + 1);
#pragma unroll 1
                for (int k = 0; k < ng; ++k) {
                    int gid;
                    if (bal) gid = (bx < 128) ? hb * 128 + 127 - q : (k == 0 ? (2 * hb) * 128 + q : (k == 1 ? (2 * hb + 1) * 128 + 63 - q : (2 + hb) * 128 + 64 + q));
                    else { const int kk2 = bx + (k >> 1) * G; gid = (k & 1) ? 511 - kk2 : kk2; }
                    indexer_group(ws, lds, gid, wave, lane);
                }
            }
            }
        }
        GSYNC();
        {
            FRESH();
            for (int rep = 0; rep < REP_P3; ++rep) {
#ifndef NO_ATT
            { const int vb = (G % 8 == 0) ? (bx % 8) * (G / 8) + bx / 8 : bx;
              for (int unit = vb; unit < 512; unit += G) attn_unit(ws, pp->qn_g, pp->kn_g, lds, unit, l, wave, lane); }
#endif
            { const float* gn_g = pp->gn_g; const float* gn_b = pp->gn_b;
              for (int unit = bx; unit < 512; unit += G) rc_unit(ws, gn_g, gn_b, lds, unit, l, wave, lane); }
            }
        }
        GSYNC();
        {
            FRESH();
            pg8::Gemm g{(const bf16_t*)(ws + WS_OATT), (const bf16_t*)(ws + WS_WUPA + l * 16 * MiB), NTOK, DM, 2 * DM}; pg8::StaticOrder S; S.init(NTOK, DM, G, bx);
            EpiGate E{(const bf16_t*)(ws + WS_SGA), (const bf16_t*)(ws + WS_SGB), (bf16_t*)(ws + WS_MERGED)};
#if !defined(NO_GO) && !defined(NO_GA)
            pg8::gemm_phase<EpiGate, pg8::StaticOrder, GA_, GS_>(lds, g, S, E);
#endif
        }
        GSYNC();
        {
            FRESH();
            pg8::Gemm g{(const bf16_t*)(ws + WS_MERGED), (const bf16_t*)(ws + WS_WOUT + l * 8 * MiB), NTOK, DM, DM}; pg8::StaticOrder S; S.init(NTOK, DM, G, bx);
            EpiRes E{l == 0 ? pp->x : (const float*)pp->out, pp->out, XB, RSS + (2 * l + 1) * NTOK};
#if !defined(NO_GO) && !defined(NO_GR)
            pg8::gemm_phase<EpiRes, pg8::StaticOrder, GA_, GS_>(lds, g, S, E);
#endif
        }
        GSYNC();
        {
            FRESH();
            pg8::Gemm g{XB, (const bf16_t*)(ws + WS_WFF1 + l * 32 * MiB), NTOK, DFF, DM}; pg8::StaticOrder S; S.init(NTOK, DFF, G, bx);
            EpiFF1 E{RSS + (2 * l + 1) * NTOK, (bf16_t*)(ws + WS_HFF)};
#if !defined(NO_GO) && !defined(NO_F1)
            pg8::gemm_phase<EpiFF1, pg8::StaticOrder, GA_, GS_>(lds, g, S, E);
#endif
        }
        GSYNC();
        {
            FRESH();
            pg8::Gemm g{(const bf16_t*)(ws + WS_HFF), (const bf16_t*)(ws + WS_WFF2 + l * 32 * MiB), NTOK, DM, DFF}; pg8::StaticOrder S; S.init(NTOK, DM, G, bx);
            EpiRes E{pp->out, pp->out, (l + 1 < NL) ? XB : nullptr, (l + 1 < NL) ? RSS + (2 * l + 2) * NTOK : nullptr};
#if !defined(NO_GO) && !defined(NO_GR)
            pg8::gemm_phase<EpiRes, pg8::StaticOrder, GA_, GS_>(lds, g, S, E);
#endif
        }
        if (l + 1 < NL) GSYNC();
    }
#undef FRESH
}
}

extern "C" void kernel_launch(void* const* d_in, const int* in_sizes, int n_in, void* d_out, int out_size, void* d_ws, size_t ws_size, hipStream_t stream) {
    static int grid = 0;
    if (grid == 0) {
        if (n_in != 13 || out_size != mk::NTOK * mk::DM || ws_size < mk::WS_END) { fprintf(stderr, "kernel_launch: unexpected shapes (n_in %d out %d ws %zu)\n", n_in, out_size, ws_size); grid = -1; return; }
        int dev = 0, cus = 0, per_cu = 0;
        hipGetDevice(&dev); hipDeviceGetAttribute(&cus, hipDeviceAttributeMultiprocessorCount, dev);
        if (hipFuncSetAttribute((const void*)mk::hybrid_fwd, hipFuncAttributeMaxDynamicSharedMemorySize, mk::LDS_BYTES) != hipSuccess) { fprintf(stderr, "kernel_launch: hipFuncSetAttribute failed\n"); grid = -1; return; }
        if (hipOccupancyMaxActiveBlocksPerMultiprocessor(&per_cu, (const void*)mk::hybrid_fwd, mk::NTHR, mk::LDS_BYTES) != hipSuccess || per_cu < 1) { fprintf(stderr, "kernel_launch: occupancy query gave %d\n", per_cu); per_cu = 1; }
        (void)hipGetLastError();
        grid = cus * 1;
        if (grid <= 0) grid = 256;
    }
    if (grid < 0) return;
    mk::Params p{};
    p.x = (const float*)d_in[0]; p.ln1_g = (const float*)d_in[1]; p.w_in = (const float*)d_in[2]; p.qn_g = (const float*)d_in[3]; p.kn_g = (const float*)d_in[4];
    p.gn_g = (const float*)d_in[5]; p.gn_b = (const float*)d_in[6]; p.w_upa = (const float*)d_in[7]; p.w_upr = (const float*)d_in[8]; p.w_out = (const float*)d_in[9];
    p.ln2_g = (const float*)d_in[10]; p.w_ff1 = (const float*)d_in[11]; p.w_ff2 = (const float*)d_in[12];
    p.out = (float*)d_out; p.ws = (unsigned char*)d_ws;
    (void)hipMemsetAsync((unsigned char*)d_ws + mk::WS_BAR, 0, XCD_BAR_WORDS * sizeof(unsigned), stream);
    void* args[] = {&p};
    hipError_t e = hipLaunchCooperativeKernel((const void*)mk::hybrid_fwd, dim3(grid), dim3(mk::NTHR), args, mk::LDS_BYTES, stream);
    if (e != hipSuccess) fprintf(stderr, "kernel_launch: cooperative launch failed: %s (grid %d)\n", hipGetErrorString(e), grid);
}
```

```cpp
#include <hip/hip_runtime.h>
#include <hip/hip_cooperative_groups.h>
#include <cstdio>
#include <cstdint>
#ifndef REP_PRO
#define REP_PRO 1
#endif
#ifndef REP_P2
#define REP_P2 1
#endif
#ifndef REP_P3
#define REP_P3 1
#endif
#ifndef REP_P4
#define REP_P4 1
#endif
#ifndef GA_
#define GA_ true
#define GS_ true
#endif
namespace cg = cooperative_groups;
namespace pg8 {
#define PG8_LAS __attribute__((address_space(3)))
typedef unsigned short bf16_t;
typedef short bf16x8 __attribute__((ext_vector_type(8)));
typedef float f32x4 __attribute__((ext_vector_type(4)));
typedef unsigned u32x4 __attribute__((ext_vector_type(4)));
constexpr int BM = 256, BK = 64, HALF = 128, HTB = HALF * BK * 2  , STAGE_BYTES = 8 * HTB, NXCD = 8, WGM = 8;

__host__ __device__ __forceinline__ int lds_byte(int r, int c) { const int st = (r >> 4) * 2 + (c >> 5), rr = r & 15, cc = c & 31, ob = rr * 64 + cc * 2; return st * 1024 + (ob ^ (((ob >> 9) & 1) << 5)); }
__host__ __device__ __forceinline__ void stage_rc(int b, int& R, int& C) { const int st = b / 1024, sb = b % 1024, swz = sb ^ (((sb >> 9) & 1) << 5); R = (st >> 1) * 16 + swz / 64; C = (st & 1) * 32 + (swz % 64) / 2; }
__host__ __device__ __forceinline__ int perm32(int rho) { const int n = rho >> 4, i = rho & 15; return 8 * (i >> 2) + 4 * n + (i & 3); }

struct Unit { int pm, pn; };
struct Gemm { const bf16_t* A; const bf16_t* Bt; int M, N, K; };

struct StaticOrder {
    int nM, nN, nwg, G, c;
    __host__ __device__ void init(int M, int N, int G_, int c_) { nM = M / BM; nN = N / BM; nwg = nM * nN; G = G_; c = c_; }
    __host__ __device__ bool next(int i, Unit& u) const {
        const long L = (long)i * G + c; if (L >= nwg) return false;
        int wgid = (int)L; { const int q = nwg / NXCD, r = nwg % NXCD, xcd = wgid % NXCD, off = wgid / NXCD; wgid = (xcd < r ? xcd * (q + 1) : r * (q + 1) + (xcd - r) * q) + off; }
        const int nig = WGM * nN, gid = wgid / nig, fm = gid * WGM, gsz = (nM - fm) < WGM ? (nM - fm) : WGM;
        u.pm = fm + ((wgid % nig) % gsz); u.pn = (wgid % nig) / gsz; return true;
    }
    __device__ __forceinline__ void a_ready(const Unit&) const {}
    __device__ __forceinline__ void done(const Unit&) const {}
};

__device__ __forceinline__ unsigned cvt_pk_bf16(float lo, float hi) { unsigned r; asm volatile("v_cvt_pk_bf16_f32 %0, %1, %2" : "=v"(r) : "v"(lo), "v"(hi)); return r; }
template <class Epi, class Sched, bool ALIGN_EPI = false, bool SP2 = false>
__device__ __forceinline__ void gemm_phase(PG8_LAS unsigned char* lds, const Gemm g, const Sched& S, const Epi& E) {
    int tid_ = threadIdx.x; asm volatile("" : "+v"(tid_)); const int tid = tid_, wid = __builtin_amdgcn_readfirstlane(tid >> 6), lane = tid & 63, wr = wid >> 2, wc = wid & 3, fr = lane & 15, fq = lane >> 4;
    const int K = g.K, nt = K / BK;
    unsigned voffA[2], voffB[2];
#pragma unroll
    for (int i = 0; i < 2; ++i) { int R, C; stage_rc(tid * 16 + i * 8192, R, C); const int Rb = Epi::PERM ? ((R & ~31) + perm32(R & 31)) : R;
        voffA[i] = (unsigned)(R * K + C) * 2u; voffB[i] = (unsigned)(Rb * K + C) * 2u; }
    const size_t kstep = (size_t)(BK * 2);
    const size_t hstep = (size_t)HALF * K * 2;
    const size_t tstep = 2 * hstep;
    const unsigned ldsw = (unsigned)wid * 1024u;
    const int aoff = lds_byte(wr * 64 + fr, fq * 8), boff = lds_byte(wc * 32 + fr, fq * 8);
#define PG8_SA(b, h) (((b) * 2 + (h)) * HTB)
#define PG8_SB(b, h) ((4 + (b) * 2 + (h)) * HTB)
#define PG8_STAGE(bufoff, gbase, voff) do { _Pragma("unroll") for (int _i = 0; _i < 2; ++_i) \
        __builtin_amdgcn_global_load_lds((const unsigned*)((const char*)(gbase) + (voff)[_i]), (PG8_LAS unsigned*)(lds + (bufoff) + ldsw + _i * 8192), 16, 0, 0); } while (0)
#define PG8_LDA(dst, b, h) do { _Pragma("unroll") for (int m = 0; m < 4; ++m) _Pragma("unroll") for (int k = 0; k < 2; ++k) dst[m][k] = *(const PG8_LAS bf16x8*)(lds + PG8_SA(b, h) + aoff + m * 2048 + k * 1024); } while (0)
#define PG8_LDB(dst, b, h) do { _Pragma("unroll") for (int n = 0; n < 2; ++n) _Pragma("unroll") for (int k = 0; k < 2; ++k) dst[n][k] = *(const PG8_LAS bf16x8*)(lds + PG8_SB(b, h) + boff + n * 2048 + k * 1024); } while (0)
#define PG8_MMA(ai, bj, At, Bt) do { __builtin_amdgcn_s_setprio(1); _Pragma("unroll") for (int m = 0; m < 4; ++m) _Pragma("unroll") for (int n = 0; n < 2; ++n) _Pragma("unroll") for (int k = 0; k < 2; ++k) \
        acc[ai][bj][m][n] = __builtin_amdgcn_mfma_f32_16x16x32_bf16(Bt[n][k], At[m][k], acc[ai][bj][m][n], 0, 0, 0); __builtin_amdgcn_s_setprio(0); } while (0)
#define PG8_WAIT_V(n) asm volatile("s_waitcnt vmcnt(" #n ")" ::: "memory")
#define PG8_WAIT_L(n) asm volatile("s_waitcnt lgkmcnt(" #n ")" ::: "memory")
#define PG8_BAR __builtin_amdgcn_s_barrier()
#define PG8_SCHED __builtin_amdgcn_sched_barrier(0)
    Unit cur, nxt; int ui = 0;
    if (!S.next(0, cur)) return;
    f32x4 acc[2][2][4][2];
#pragma unroll
    for (int a = 0; a < 2; ++a)
#pragma unroll
        for (int b = 0; b < 2; ++b)
#pragma unroll
            for (int m = 0; m < 4; ++m)
#pragma unroll
                for (int n = 0; n < 2; ++n) acc[a][b][m][n] = (f32x4){0.f, 0.f, 0.f, 0.f};
    bf16x8 At[4][2], B0[2][2], B1[2][2];
    const char* cA = (const char*)g.A + (size_t)cur.pm * tstep; const char* cB = (const char*)g.Bt + (size_t)cur.pn * tstep;
    S.a_ready(cur);
    if constexpr (SP2) {
        PG8_STAGE(PG8_SB(0, 0), cB, voffB); PG8_STAGE(PG8_SB(0, 1), cB + hstep, voffB); PG8_STAGE(PG8_SA(0, 0), cA, voffA); PG8_STAGE(PG8_SA(0, 1), cA + hstep, voffA);
        if (wr == 1) PG8_BAR;
        PG8_WAIT_V(2); PG8_BAR;
        PG8_STAGE(PG8_SB(1, 0), cB + kstep, voffB); PG8_STAGE(PG8_SA(1, 0), cA + kstep, voffA); PG8_STAGE(PG8_SB(1, 1), cB + hstep + kstep, voffB);
        PG8_WAIT_V(6); PG8_BAR;
    } else {
        PG8_STAGE(PG8_SB(0, 0), cB, voffB); PG8_STAGE(PG8_SA(0, 0), cA, voffA); PG8_STAGE(PG8_SB(0, 1), cB + hstep, voffB); PG8_STAGE(PG8_SA(0, 1), cA + hstep, voffA);
        if (wr == 1) PG8_BAR;
        PG8_WAIT_V(4); PG8_BAR;
        PG8_STAGE(PG8_SB(1, 0), cB + kstep, voffB); PG8_STAGE(PG8_SA(1, 0), cA + kstep, voffA); PG8_STAGE(PG8_SB(1, 1), cB + hstep + kstep, voffB);
        PG8_WAIT_V(6); PG8_BAR;
    }
    for (;;) {
        const bool has_next = S.next(ui + 1, nxt);
        const char* nA = has_next ? (const char*)g.A + (size_t)nxt.pm * tstep : cA; const char* nB = has_next ? (const char*)g.Bt + (size_t)nxt.pn * tstep : cB;
        for (int t = 0; t < nt; t += 2) {
            if constexpr (Epi::MID_HOOK) { if (t == (nt >> 1)) E.mid(acc, cur, wr, wc, fr, fq); }
            const bool last = (t == nt - 2);
            const char* a1 = cA + (size_t)(t + 1) * kstep;
            const char* a2 = last ? nA : cA + (size_t)(t + 2) * kstep; const char* b2 = last ? nB : cB + (size_t)(t + 2) * kstep;
            const char* a3 = a2 + kstep; const char* b3 = b2 + kstep;
            if (last && has_next) S.a_ready(nxt);
            if constexpr (SP2) {
            PG8_LDB(B0, 0, 0); PG8_LDB(B1, 0, 1); PG8_SCHED; PG8_LDA(At, 0, 0); PG8_STAGE(PG8_SA(1, 1), a1 + hstep, voffA);
            PG8_WAIT_V(8); PG8_WAIT_L(0); PG8_BAR; PG8_MMA(0, 0, At, B0); PG8_MMA(0, 1, At, B1); PG8_BAR; PG8_SCHED;
            PG8_LDA(At, 0, 1); PG8_STAGE(PG8_SB(0, 0), b2, voffB); PG8_STAGE(PG8_SB(0, 1), b2 + hstep, voffB); PG8_STAGE(PG8_SA(0, 0), a2, voffA);
            PG8_WAIT_V(8); PG8_WAIT_L(0); PG8_BAR; PG8_MMA(1, 0, At, B0); PG8_MMA(1, 1, At, B1); PG8_BAR; PG8_SCHED;
            PG8_LDB(B0, 1, 0); PG8_LDB(B1, 1, 1); PG8_SCHED; PG8_LDA(At, 1, 0); PG8_STAGE(PG8_SA(0, 1), a2 + hstep, voffA);
            PG8_WAIT_V(8); PG8_WAIT_L(0); PG8_BAR; PG8_MMA(0, 0, At, B0); PG8_MMA(0, 1, At, B1); PG8_BAR; PG8_SCHED;
            PG8_LDA(At, 1, 1); PG8_STAGE(PG8_SB(1, 0), b3, voffB); PG8_STAGE(PG8_SB(1, 1), b3 + hstep, voffB); PG8_STAGE(PG8_SA(1, 0), a3, voffA);
            PG8_WAIT_V(8); PG8_WAIT_L(0); PG8_BAR; PG8_MMA(1, 0, At, B0); PG8_MMA(1, 1, At, B1); PG8_BAR; PG8_SCHED;
            } else {
            PG8_LDB(B0, 0, 0); PG8_SCHED; PG8_LDA(At, 0, 0); PG8_STAGE(PG8_SA(1, 1), a1 + hstep, voffA);
            PG8_WAIT_L(8); PG8_BAR; PG8_WAIT_L(0); PG8_MMA(0, 0, At, B0); PG8_BAR; PG8_SCHED;
            PG8_LDB(B1, 0, 1); PG8_STAGE(PG8_SB(0, 0), b2, voffB);
            PG8_BAR; PG8_WAIT_L(0); PG8_MMA(0, 1, At, B1); PG8_BAR;
            PG8_LDA(At, 0, 1); PG8_STAGE(PG8_SA(0, 0), a2, voffA);
            PG8_BAR; PG8_WAIT_L(0); PG8_MMA(1, 0, At, B0); PG8_BAR; PG8_SCHED;
            PG8_STAGE(PG8_SB(0, 1), b2 + hstep, voffB);
            PG8_WAIT_V(6); PG8_BAR; PG8_MMA(1, 1, At, B1); PG8_BAR;
            PG8_LDB(B0, 1, 0); PG8_SCHED; PG8_LDA(At, 1, 0); PG8_STAGE(PG8_SA(0, 1), a2 + hstep, voffA);
            PG8_WAIT_L(8); PG8_BAR; PG8_WAIT_L(0); PG8_MMA(0, 0, At, B0); PG8_BAR; PG8_SCHED;
            PG8_LDB(B1, 1, 1); PG8_STAGE(PG8_SB(1, 0), b3, voffB);
            PG8_BAR; PG8_WAIT_L(0); PG8_MMA(0, 1, At, B1); PG8_BAR;
            PG8_LDA(At, 1, 1); PG8_STAGE(PG8_SA(1, 0), a3, voffA);
            PG8_BAR; PG8_WAIT_L(0); PG8_MMA(1, 0, At, B0); PG8_BAR; PG8_SCHED;
            PG8_STAGE(PG8_SB(1, 1), b3 + hstep, voffB);
            PG8_WAIT_V(6); PG8_BAR; PG8_MMA(1, 1, At, B1); PG8_BAR;
            }
        }
        if constexpr (ALIGN_EPI) { if (wr == 0) PG8_BAR; }
        if constexpr (!Epi::AFTER_DRAIN) { E(acc, cur, wr, wc, fr, fq); S.done(cur); }
        if (!has_next) break;
#pragma unroll
        for (int a = 0; a < 2; ++a)
#pragma unroll
            for (int b = 0; b < 2; ++b)
#pragma unroll
                for (int m = 0; m < 4; ++m)
#pragma unroll
                    for (int n = 0; n < 2; ++n) acc[a][b][m][n] = (f32x4){0.f, 0.f, 0.f, 0.f};
        cur = nxt; cA = nA; cB = nB; ++ui;
        if constexpr (ALIGN_EPI) { if (wr == 1) PG8_BAR; }
    }
    PG8_WAIT_V(0);
    if constexpr (!ALIGN_EPI) { if (wr == 0) PG8_BAR; }
    PG8_BAR;
    if constexpr (Epi::AFTER_DRAIN) { E.fused(acc, cur, wr, wc, fr, fq, lds, wid, lane); S.done(cur); }
#undef PG8_SA
#undef PG8_SB
#undef PG8_STAGE
#undef PG8_LDA
#undef PG8_LDB
#undef PG8_MMA
#undef PG8_WAIT_V
#undef PG8_WAIT_L
#undef PG8_BAR
#undef PG8_SCHED
}
}

namespace mk {
using pg8::bf16_t; using pg8::bf16x8; using pg8::f32x4; using pg8::u32x4; using pg8::Unit;
typedef float f32x16 __attribute__((ext_vector_type(16)));
typedef unsigned u32x2 __attribute__((ext_vector_type(2)));
#define LAS __attribute__((address_space(3)))

constexpr int NB = 4, SEQ = 2048, DM = 2048, NTOK = NB * SEQ, NL = 2, DIN = 14416, NPAD = 14592, DFF = 8192;
constexpr int NTHR = 512, NWAVE = 8, NMAIN = 14336;
constexpr size_t MiB = 1u << 20;
constexpr size_t WS_WIN = 0;
constexpr size_t WS_WUPA = 114 * MiB;
constexpr size_t WS_WUPR = 130 * MiB;
constexpr size_t WS_WOUT = 146 * MiB;
constexpr size_t WS_WFF1 = 162 * MiB;
constexpr size_t WS_WFF2 = 226 * MiB;
constexpr size_t WS_XB = 290 * MiB;
constexpr size_t WS_PROJ = 322 * MiB;
constexpr size_t WS_Q = WS_PROJ, WS_KRAW = WS_Q + 32 * MiB, WS_KN = WS_KRAW + 8 * MiB, WS_VT = WS_KN + 8 * MiB, WS_IQ = WS_VT + 8 * MiB,
                 WS_RQ = WS_IQ + 16 * MiB, WS_RK = WS_RQ + 16 * MiB, WS_RKT = WS_RK + 16 * MiB, WS_RVT = WS_RKT + 16 * MiB, WS_SRG = WS_RVT + 32 * MiB,
                 WS_SGA = WS_SRG + 32 * MiB, WS_SGB = WS_SGA + 32 * MiB, WS_IK = WS_SGB + 32 * MiB, WS_IW = WS_IK + 1 * MiB;
constexpr size_t WS_HFF = WS_PROJ;
constexpr size_t WS_MASK = 572 * MiB;
constexpr size_t WS_U = 574 * MiB;
constexpr size_t WS_MBUF = WS_U;
constexpr size_t WS_RP = 638 * MiB;
constexpr size_t WS_OATT = 670 * MiB;
constexpr size_t WS_ORET = 702 * MiB;
constexpr size_t WS_MERGED = 734 * MiB;
constexpr size_t WS_ROPE = 766 * MiB;
constexpr size_t WS_RSS = 767 * MiB;
constexpr size_t WS_BAR = 767 * MiB + 512 * 1024;
constexpr size_t WS_END = 768 * MiB;
static_assert(WS_IW + 1 * MiB <= WS_MASK, "proj region");

struct Params {
    const float* x; const float* ln1_g; const float* w_in; const float* qn_g; const float* kn_g; const float* gn_g; const float* gn_b;
    const float* w_upa; const float* w_upr; const float* w_out; const float* ln2_g; const float* w_ff1; const float* w_ff2;
    float* out; unsigned char* ws;
};

typedef const __attribute__((address_space(4))) Params* CP;
__device__ __forceinline__ CP getP() { auto k = __builtin_amdgcn_kernarg_segment_ptr(); asm volatile("" : "+s"(k)); return (CP)k; }
__device__ __forceinline__ float bf2f(unsigned h) { return __uint_as_float(h << 16); }
__device__ __forceinline__ unsigned pk2(float lo, float hi) { return pg8::cvt_pk_bf16(lo, hi); }
__device__ __forceinline__ void st4bf(bf16_t* p, f32x4 v) { *(u32x2*)p = (u32x2){pk2(v[0], v[1]), pk2(v[2], v[3])}; }
__device__ __forceinline__ float shx(float v, int o, int lane) { return __int_as_float(__builtin_amdgcn_ds_bpermute((lane ^ o) << 2, __float_as_int(v))); }
__device__ __forceinline__ int shxi(int v, int o, int lane) { return __builtin_amdgcn_ds_bpermute((lane ^ o) << 2, v); }
__device__ __forceinline__ float x32sum(float v) { auto rr = __builtin_amdgcn_permlane32_swap(__float_as_uint(v), __float_as_uint(v), false, false); return __uint_as_float(rr[0]) + __uint_as_float(rr[1]); }
__device__ __forceinline__ float wave_sum(float v, int lane) {
#pragma unroll
    for (int o = 1; o < 32; o <<= 1) v += shx(v, o, lane);
    return x32sum(v);
}
__device__ __forceinline__ int crow(int r, int hi) { return (r & 3) + 8 * (r >> 2) + 4 * hi; }
__device__ __forceinline__ int kperm(int m) { const int a = m & 3, h1 = (m >> 2) & 1, c = m >> 3; return 16 * (c >> 1) + 8 * h1 + 4 * (c & 1) + a; }
#define MFMA32(a, b, c) __builtin_amdgcn_mfma_f32_32x32x16_bf16((a), (b), (c), 0, 0, 0)
__device__ __forceinline__ bf16x8 pack8(const float* f) { u32x4 w; w.x = pk2(f[0], f[1]); w.y = pk2(f[2], f[3]); w.z = pk2(f[4], f[5]); w.w = pk2(f[6], f[7]); return __builtin_bit_cast(bf16x8, w); }

struct MapIdent { __device__ __forceinline__ int operator()(int n) const { return n; } };
struct MapWin {
    __device__ __forceinline__ int operator()(int n) const {
        if (n < 4096) return n;
        if (n < 6144) { const int t = n - 4096, which = t >> 10, tt = t & 1023, h = tt >> 7, lc = tt & 127; return (which ? 5200 : 4176) + h * 128 + (lc >> 1) + 64 * (lc & 1); }
        if (n < 8192) return 6224 + (n - 6144);
        if (n < 10240) return 8272 + (n - 8192);
        if (n < 12288) return 10320 + (n - 10240);
        if (n < 14336) return 12368 + (n - 12288);
        if (n < 14416) return 4096 + (n - 14336);
        return -1;
    }
};
__device__ __forceinline__ void transpose64(const float* __restrict__ W, int K, int N, bf16_t* WT, const float* __restrict__ gk, int k0, int c0, int ncols, int d0, int ds, LAS float* scr, int lane, int ldk = 0, int fragn0 = -1) {
    if (ldk == 0) ldk = K;
    const int lr = lane >> 4, lc4 = (lane & 15) * 4;
    f32x4 v[16];
#pragma unroll
    for (int i = 0; i < 16; ++i) { const int kk = 4 * i + lr; v[i] = (lc4 < ncols) ? __builtin_nontemporal_load((const f32x4*)(W + (size_t)(k0 + kk) * N + c0 + lc4)) : (f32x4){0.f, 0.f, 0.f, 0.f}; }
#pragma unroll
    for (int i = 0; i < 16; ++i) { const int kk = 4 * i + lr; const float g = gk ? gk[k0 + kk] : 1.0f; LAS float* d = scr + kk * 65 + lc4; d[0] = v[i][0] * g; d[1] = v[i][1] * g; d[2] = v[i][2] * g; d[3] = v[i][3] * g; }
    asm volatile("s_waitcnt lgkmcnt(0)" ::: "memory");
    const int c = lane & 7;
#pragma unroll
    for (int j = 0; j < 8; ++j) { const int n = (lane >> 3) + 8 * j; const LAS float* sp = scr + (8 * c) * 65 + n;
        u32x4 o; o.x = pk2(sp[0 * 65], sp[1 * 65]); o.y = pk2(sp[2 * 65], sp[3 * 65]); o.z = pk2(sp[4 * 65], sp[5 * 65]); o.w = pk2(sp[6 * 65], sp[7 * 65]);
        if (fragn0 < 0) { if (n < ncols) *(u32x4*)(WT + (size_t)(d0 + ds * n) * ldk + k0 + 8 * c) = o; }
        else if (n < 32) { const int nn = fragn0 + n, kq = k0 + 8 * c; if (n >= ncols) o = (u32x4){0u, 0u, 0u, 0u};
            *(u32x4*)(WT + ((size_t)(((nn >> 5) * (K >> 4) + (kq >> 4)) * 2 + ((kq >> 3) & 1)) * 32 + (nn & 31)) * 8) = o; } }
    asm volatile("s_waitcnt lgkmcnt(0)" ::: "memory");
}

__device__ __forceinline__ void prologue(CP pp, LAS unsigned char* lds, int gw, int NGW, int wave, int lane) {
    Params P; P.x = pp->x; P.ln1_g = pp->ln1_g; P.w_in = pp->w_in; P.w_upa = pp->w_upa; P.w_upr = pp->w_upr; P.w_out = pp->w_out; P.ln2_g = pp->ln2_g; P.w_ff1 = pp->w_ff1; P.w_ff2 = pp->w_ff2; P.ws = pp->ws; unsigned char* ws = P.ws;
    LAS float* scr = (LAS float*)(lds + wave * 16640);
    constexpr int T_IN = 226, I_IN = 32 * T_IN, I_SQ = 32 * 32, I_F1 = 32 * 128, I_F2 = 128 * 32, I_L = I_IN + 3 * I_SQ + I_F1 + I_F2;
    for (int it = gw; it < NL * I_L; it += NGW) {
        const int itr = NL * I_L - 1 - it;
        const int l = itr / I_L; int r = itr % I_L;
        if (r < I_IN) {
            const int kb = r / T_IN, t = r % T_IN; int c0, d0, ds = 1, nc = 64;
            if (t < 64) { c0 = 64 * t; d0 = c0; }
            else if (t == 64 || t == 65) {
                bf16_t* wt = (bf16_t*)(ws + WS_WIN + l * 57 * MiB) + (size_t)NMAIN * DM;
                transpose64(P.w_in + (size_t)l * DM * DIN, DM, DIN, wt, P.ln1_g + l * DM, 64 * kb, t == 64 ? 4096 : 4160, t == 64 ? 64 : 16, 0, 1, scr, lane, 0, t == 64 ? 0 : 64);
                if (t == 64) transpose64(P.w_in + (size_t)l * DM * DIN, DM, DIN, wt, P.ln1_g + l * DM, 64 * kb, 4096 + 32, 32, 0, 1, scr, lane, 0, 32);
                continue; }
            else if (t < 98) { const int q = t - 66, which = q >> 4, rr = q & 15, h = rr >> 1, half = rr & 1; c0 = (which ? 5200 : 4176) + h * 128 + 64 * half; d0 = (which ? 5120 : 4096) + h * 128 + half; ds = 2; }
            else { const int q = t - 98; c0 = 6224 + 64 * q; d0 = 6144 + 64 * q; }
            transpose64(P.w_in + (size_t)l * DM * DIN, DM, DIN, (bf16_t*)(ws + WS_WIN + l * 57 * MiB), P.ln1_g + l * DM, 64 * kb, c0, nc, d0, ds, scr, lane); continue; }
        r -= I_IN;
        if (r < 3 * I_SQ) { const int w = r / I_SQ, q = r % I_SQ, kb = q >> 5, t = q & 31; const float* src = (w == 0 ? P.w_upa : (w == 1 ? P.w_upr : P.w_out)) + (size_t)l * DM * DM;
            bf16_t* dst = (w == 2) ? (bf16_t*)(ws + WS_WOUT + l * 8 * MiB) : (bf16_t*)(ws + WS_WUPA + l * 16 * MiB) + (w == 1 ? DM : 0);
            transpose64(src, DM, DM, dst, nullptr, 64 * kb, 64 * t, 64, 64 * t, 1, scr, lane, (w == 2) ? DM : 2 * DM); continue; }
        r -= 3 * I_SQ;
        if (r < I_F1) { const int kb = r >> 7, t = r & 127; transpose64(P.w_ff1 + (size_t)l * DM * DFF, DM, DFF, (bf16_t*)(ws + WS_WFF1 + l * 32 * MiB), P.ln2_g + l * DM, 64 * kb, 64 * t, 64, 64 * t, 1, scr, lane); continue; }
        r -= I_F1;
        { const int kb = r >> 5, t = r & 31; transpose64(P.w_ff2 + (size_t)l * DFF * DM, DFF, DM, (bf16_t*)(ws + WS_WFF2 + l * 32 * MiB), nullptr, 64 * kb, 64 * t, 64, 64 * t, 1, scr, lane); }
    }
    bf16_t* XB = (bf16_t*)(ws + WS_XB); float* RSS = (float*)(ws + WS_RSS);
    for (int base = gw; base < NTOK; base += 2 * NGW) {
        f32x4 xv[2][8];
#pragma unroll
        for (int r2 = 0; r2 < 2; ++r2) { const int m = base + r2 * NGW; const f32x4* xr = (const f32x4*)(P.x + (size_t)(m < NTOK ? m : base) * DM) + lane;
#pragma unroll
            for (int j = 0; j < 8; ++j) xv[r2][j] = xr[64 * j]; }
        __builtin_amdgcn_sched_barrier(0);
#pragma unroll
        for (int r2 = 0; r2 < 2; ++r2) { const int m = base + r2 * NGW; float ss = 0.f;
            if (m < NTOK) {
#pragma unroll
                for (int j = 0; j < 8; ++j) { const f32x4 v = xv[r2][j]; ss += (v[0] * v[0] + v[1] * v[1]) + (v[2] * v[2] + v[3] * v[3]); st4bf(XB + (size_t)m * DM + 4 * lane + 256 * j, v); }
                ss = wave_sum(ss, lane);
                if (lane == 0) RSS[m] = ss; } }
    }
    for (int i = gw * 64 + lane; i < 3 * NTOK; i += NGW * 64) RSS[NTOK + i] = 0.f;
    float* rope = (float*)(ws + WS_ROPE);
    for (int i = gw * 64 + lane; i < SEQ * 64; i += NGW * 64) {
        const int pos = i >> 6, fi = i & 63;
        const float invf = (float)exp(-(double)fi * (9.210340371976184 / 64.0));
        const float angf = (float)pos * invf;
        const double a = (double)angf; const double k = rint(a * 0.15915494309189535); const double r = a - k * 6.283185307179586477;
        const double r2 = r * r; double ts = r, ss = r, tc = 1.0, cc = 1.0;
#pragma unroll
        for (int n = 1; n <= 14; ++n) { ts *= -r2 * (1.0 / (double)((2 * n) * (2 * n + 1))); ss += ts; tc *= -r2 * (1.0 / (double)((2 * n - 1) * (2 * n))); cc += tc; }
        rope[2 * i] = (float)cc; rope[2 * i + 1] = (float)ss;
    }
}

#define EPI_ROWS(...) _Pragma("unroll") for (int ai = 0; ai < 2; ++ai) _Pragma("unroll") for (int m = 0; m < 4; ++m) { int row_ = u.pm * 256 + ai * 128 + wr * 64 + m * 16 + fr; asm volatile("" : "+v"(row_) :: "memory"); const int row = row_; __VA_ARGS__ }
#define EPI_COLS8(...) _Pragma("unroll") for (int bj = 0; bj < 2; ++bj) { const int lc = bj * 128 + wc * 32 + 8 * fq; const f32x4 a0 = acc[ai][bj][m][0], a1 = acc[ai][bj][m][1]; __VA_ARGS__ }

__device__ __forceinline__ float sigm(float x) { return __builtin_amdgcn_rcpf(1.0f + __builtin_amdgcn_exp2f(-1.4426950408889634f * x)); }
__device__ __forceinline__ f32x4 sigm4(f32x4 v) { return (f32x4){sigm(v[0]), sigm(v[1]), sigm(v[2]), sigm(v[3])}; }
__device__ __forceinline__ void st8bf(bf16_t* p, f32x4 v0, f32x4 v1) { *(u32x4*)p = (u32x4){pk2(v0[0], v0[1]), pk2(v0[2], v0[3]), pk2(v1[0], v1[1]), pk2(v1[2], v1[3])}; }
__device__ __forceinline__ void st8col(bf16_t* d, int stride, f32x4 v0, f32x4 v1) {
    d[0] = (bf16_t)pk2(v0[0], 0.f); d[stride] = (bf16_t)pk2(v0[1], 0.f); d[2 * stride] = (bf16_t)pk2(v0[2], 0.f); d[3 * stride] = (bf16_t)pk2(v0[3], 0.f);
    d[4 * stride] = (bf16_t)pk2(v1[0], 0.f); d[5 * stride] = (bf16_t)pk2(v1[1], 0.f); d[6 * stride] = (bf16_t)pk2(v1[2], 0.f); d[7 * stride] = (bf16_t)pk2(v1[3], 0.f);
}
__device__ __forceinline__ f32x4 bflo4(u32x4 w) { return (f32x4){bf2f(w.x & 0xffffu), bf2f(w.x >> 16), bf2f(w.y & 0xffffu), bf2f(w.y >> 16)}; }
__device__ __forceinline__ f32x4 bfhi4(u32x4 w) { return (f32x4){bf2f(w.z & 0xffffu), bf2f(w.z >> 16), bf2f(w.w & 0xffffu), bf2f(w.w >> 16)}; }

struct EpiIn {
    static constexpr bool PERM = true, AFTER_DRAIN = false, MID_HOOK = false;
    const float* rss; unsigned char* ws;
    __device__ __forceinline__ void operator()(const f32x4 (&acc)[2][2][4][2], const Unit& u, int wr, int wc, int fr, int fq) const {
        asm volatile("" : "+v"(fr), "+v"(fq));
        const int pn = u.pn;
        bf16_t* Q = (bf16_t*)(ws + WS_Q); bf16_t* KR = (bf16_t*)(ws + WS_KRAW); bf16_t* VT = (bf16_t*)(ws + WS_VT); bf16_t* IQ = (bf16_t*)(ws + WS_IQ);
        bf16_t* RQ = (bf16_t*)(ws + WS_RQ); bf16_t* RK = (bf16_t*)(ws + WS_RK); bf16_t* RKT = (bf16_t*)(ws + WS_RKT); bf16_t* RVT = (bf16_t*)(ws + WS_RVT);
        bf16_t* SRG = (bf16_t*)(ws + WS_SRG); bf16_t* SGA = (bf16_t*)(ws + WS_SGA); bf16_t* SGB = (bf16_t*)(ws + WS_SGB);
        const float* rope = (const float*)(ws + WS_ROPE);
#define RS const float rs = __builtin_amdgcn_rsqf(rss[row] * (1.0f / 2048.0f) + 1e-6f);
        if (pn < 8) { EPI_ROWS(RS EPI_COLS8(st8bf(Q + (size_t)row * 2048 + pn * 256 + lc, a0 * rs, a1 * rs);)) }
        else if (pn < 10) { EPI_ROWS(RS EPI_COLS8(st8bf(KR + (size_t)row * 512 + (pn - 8) * 256 + lc, a0 * rs, a1 * rs);)) }
        else if (pn < 12) { EPI_ROWS(RS const int b = row >> 11, s = row & 2047; EPI_COLS8(const int c = (pn - 10) * 256 + lc;
                st8col(VT + ((((size_t)(b * 4 + (c >> 7)) * 32 + (s >> 6)) * 128 + (c & 127)) * 64 + (s & 63)), 64, a0 * rs, a1 * rs);)) }
        else if (pn < 16) { EPI_ROWS(RS EPI_COLS8(st8bf(IQ + (size_t)row * 1024 + (pn - 12) * 256 + lc, a0 * rs, a1 * rs);)) }
        else if (pn < 24) { const bool isk = pn >= 20; const int cb = (pn - (isk ? 20 : 16)) * 256; const float scl = isk ? 0.08838834764831845f : 1.0f;
            EPI_ROWS(RS const int b = row >> 11, s = row & 2047; EPI_COLS8(const f32x4 v0 = a0 * (rs * scl), v1 = a1 * (rs * scl);
                const float* rp = rope + ((size_t)s * 64 + ((lc & 127) >> 1)) * 2; const f32x4 cA = *(const f32x4*)rp, cB = *(const f32x4*)(rp + 4);
                f32x4 o0, o1; o0[0] = v0[0] * cA[0] - v0[1] * cA[1]; o0[1] = v0[1] * cA[0] + v0[0] * cA[1]; o0[2] = v0[2] * cA[2] - v0[3] * cA[3]; o0[3] = v0[3] * cA[2] + v0[2] * cA[3];
                o1[0] = v1[0] * cB[0] - v1[1] * cB[1]; o1[1] = v1[1] * cB[0] + v1[0] * cB[1]; o1[2] = v1[2] * cB[2] - v1[3] * cB[3]; o1[3] = v1[3] * cB[2] + v1[2] * cB[3];
                const int c = cb + lc, dd = c & 127, ii = s & 127;
                const size_t ub = ((size_t)(b * 8 + (c >> 7)) * 16 + (s >> 7)) * 16384;
                const size_t fo = ub + (ii >> 5) * 4096 + (((dd >> 4) * 2 + ((dd >> 3) & 1)) * 32 + (ii & 31)) * 8;
                if (!isk) st8bf(RQ + fo, o0, o1);
                else { st8bf(RK + fo, o0, o1); st8col(RKT + ub + (dd >> 5) * 4096 + (((ii >> 4) * 2 + ((ii >> 3) & 1)) * 32 + (dd & 31)) * 8 + (ii & 7), 8, o0, o1); })) }
        else if (pn < 32) { EPI_ROWS(RS const int b = row >> 11, s = row & 2047; EPI_COLS8(const int c = (pn - 24) * 256 + lc, ee = c & 255, ii = s & 127;
                st8col(RVT + ((size_t)(b * 8 + (c >> 8)) * 16 + (s >> 7)) * 32768 + (ee >> 5) * 4096 + (((ii >> 4) * 2 + ((ii >> 3) & 1)) * 32 + (ee & 31)) * 8 + (ii & 7), 8, a0 * rs, a1 * rs);)) }
        else if (pn < 40) { EPI_ROWS(RS const int b = row >> 11, s = row & 2047; EPI_COLS8(f32x4 v0 = a0 * rs, v1 = a1 * rs; v0 = v0 * sigm4(v0); v1 = v1 * sigm4(v1);
                const int c = (pn - 32) * 256 + lc, e = c & 255, i = s & 127;
                bf16_t* d = SRG + ((size_t)(b * 8 + (c >> 8)) * 16 + (s >> 7)) * 32768 + (i >> 5) * 8192 + (e >> 7) * 4096 + ((e >> 3) & 15) * 256 + (i & 31) * 4;
                st4bf(d, v0); st4bf(d + 128, v1);)) }
        else { bf16_t* G = (pn < 48) ? SGA : SGB; const int cb = (pn - (pn < 48 ? 40 : 48)) * 256;
            EPI_ROWS(RS EPI_COLS8(st8bf(G + (size_t)row * 2048 + cb + lc, sigm4(a0 * rs), sigm4(a1 * rs));)) }
#undef RS
    }
};
struct EpiGate {
    static constexpr bool PERM = true, AFTER_DRAIN = false, MID_HOOK = true;
    const bf16_t* GA; const bf16_t* GB; bf16_t* merged;
    __device__ __forceinline__ void mid(f32x4 (&acc)[2][2][4][2], const Unit& u, int wr, int wc, int fr, int fq) const {
        asm volatile("s_waitcnt vmcnt(0)" : "+v"(fr), "+v"(fq) :: "memory");
        EPI_ROWS(_Pragma("unroll") for (int bj = 0; bj < 2; ++bj) { const int lc = bj * 128 + wc * 32 + 8 * fq; const size_t off = (size_t)row * 2048 + u.pn * 256 + lc;
            const u32x4 ga = *(const u32x4*)(GA + off); const u32x4 gb = *(const u32x4*)(GB + off);
            const f32x4 gb0 = bflo4(gb), gb1 = bfhi4(gb); f32x4 r0 = bflo4(ga), r1 = bfhi4(ga);
            _Pragma("unroll") for (int k = 0; k < 4; ++k) { r0[k] *= __builtin_amdgcn_rcpf(fmaxf(gb0[k], 1e-30f)); r1[k] *= __builtin_amdgcn_rcpf(fmaxf(gb1[k], 1e-30f)); }
            acc[ai][bj][m][0] = acc[ai][bj][m][0] * r0; acc[ai][bj][m][1] = acc[ai][bj][m][1] * r1; })
        asm volatile("s_waitcnt vmcnt(0)" ::: "memory");
    }
    __device__ __forceinline__ void operator()(const f32x4 (&acc)[2][2][4][2], const Unit& u, int wr, int wc, int fr, int fq) const {
        asm volatile("" : "+v"(fr), "+v"(fq));
        EPI_ROWS(EPI_COLS8(const size_t off = (size_t)row * 2048 + u.pn * 256 + lc; const u32x4 g = *(const u32x4*)(GB + off); st8bf(merged + off, a0 * bflo4(g), a1 * bfhi4(g));))
    }
};
struct EpiRes {
    static constexpr bool PERM = true, AFTER_DRAIN = false, MID_HOOK = false;
    const float* xin; float* xout; bf16_t* xb; float* rss;
    __device__ __forceinline__ void operator()(const f32x4 (&acc)[2][2][4][2], const Unit& u, int wr, int wc, int fr, int fq) const {
        asm volatile("" : "+v"(fr), "+v"(fq));
        EPI_ROWS(float ss = 0.f; EPI_COLS8(const size_t off = (size_t)row * 2048 + u.pn * 256 + lc; const f32x4 o0 = *(const f32x4*)(xin + off) + a0, o1 = *(const f32x4*)(xin + off + 4) + a1;
                *(f32x4*)(xout + off) = o0; *(f32x4*)(xout + off + 4) = o1; if (xb) st8bf(xb + off, o0, o1);
                ss += ((o0[0] * o0[0] + o0[1] * o0[1]) + (o0[2] * o0[2] + o0[3] * o0[3])) + ((o1[0] * o1[0] + o1[1] * o1[1]) + (o1[2] * o1[2] + o1[3] * o1[3]));)
            if (rss) { ss += shx(ss, 16, fr + 16 * fq); ss = x32sum(ss); if (fq == 0) atomicAdd(rss + row, ss); })
    }
};
struct EpiFF1 {
    static constexpr bool PERM = true, AFTER_DRAIN = false, MID_HOOK = false;
    const float* rss; bf16_t* H;
    __device__ __forceinline__ void operator()(const f32x4 (&acc)[2][2][4][2], const Unit& u, int wr, int wc, int fr, int fq) const {
        asm volatile("" : "+v"(fr), "+v"(fq));
        EPI_ROWS(const float rs = __builtin_amdgcn_rsqf(rss[row] * (1.0f / 2048.0f) + 1e-6f); EPI_COLS8(f32x4 v0 = a0 * rs, v1 = a1 * rs;
            v0[0] = fmaxf(v0[0], 0.f); v0[1] = fmaxf(v0[1], 0.f); v0[2] = fmaxf(v0[2], 0.f); v0[3] = fmaxf(v0[3], 0.f); v1[0] = fmaxf(v1[0], 0.f); v1[1] = fmaxf(v1[1], 0.f); v1[2] = fmaxf(v1[2], 0.f); v1[3] = fmaxf(v1[3], 0.f);
            st8bf(H + (size_t)row * DFF + u.pn * 256 + lc, v0 * v0, v1 * v1);))
    }
};

__device__ __forceinline__ void tail_block(unsigned char* ws, const bf16_t* Wt, const float* rss, LAS unsigned char* lds, int rb, int wave, int lane) {
    const bf16_t* XB = (const bf16_t*)(ws + WS_XB); bf16_t* IK = (bf16_t*)(ws + WS_IK); float* IW = (float*)(ws + WS_IW);
    const int hi = lane >> 5, l32 = lane & 31, tid = wave * 64 + lane;
    const bf16_t* ap = XB + (size_t)(32 * rb + l32) * 2048 + 256 * wave + 8 * hi;
    const bf16_t* bp = Wt + (size_t)(16 * wave) * 512 + lane * 8;
    f32x16 acc[3];
#pragma unroll
    for (int nb = 0; nb < 3; ++nb) acc[nb] = (f32x16){0.f, 0.f, 0.f, 0.f, 0.f, 0.f, 0.f, 0.f, 0.f, 0.f, 0.f, 0.f, 0.f, 0.f, 0.f, 0.f};
#pragma unroll
    for (int kb = 0; kb < 4; ++kb) {
        bf16x8 af[4], bfr[3][4];
#pragma unroll
        for (int k4 = 0; k4 < 4; ++k4) { af[k4] = *(const bf16x8*)(ap + 16 * (4 * kb + k4));
#pragma unroll
            for (int nb = 0; nb < 3; ++nb) bfr[nb][k4] = *(const bf16x8*)(bp + (size_t)(nb * 128 + 4 * kb + k4) * 512); }
        __builtin_amdgcn_sched_barrier(0);
#pragma unroll
        for (int k4 = 0; k4 < 4; ++k4)
#pragma unroll
            for (int nb = 0; nb < 3; ++nb) acc[nb] = MFMA32(af[k4], bfr[nb][k4], acc[nb]);
        __builtin_amdgcn_sched_barrier(0);
    }
    LAS float* part = (LAS float*)lds;
#pragma unroll
    for (int nb = 0; nb < 3; ++nb)
#pragma unroll
        for (int r = 0; r < 16; ++r) part[wave * 3072 + crow(r, hi) * 96 + 32 * nb + l32] = acc[nb][r];
    __syncthreads();
#pragma unroll
    for (int i = 0; i < 6; ++i) {
        const int idx = tid + 512 * i, row = idx / 96, col = idx % 96;
        float v = 0.f;
#pragma unroll
        for (int w = 0; w < 8; ++w) v += part[w * 3072 + idx];
        const int grow = 32 * rb + row;
        v *= rsqrtf(rss[grow] * (1.0f / 2048.0f) + 1e-6f);
        if (col < 64) IK[(size_t)grow * 64 + col] = (bf16_t)pk2(v, 0.f);
        else if (col < 80) IW[(size_t)grow * 16 + (col - 64)] = v * 0.25f;
    }
    __syncthreads();
}

__device__ __forceinline__ void indexer_group(unsigned char* ws, LAS unsigned char* lds, int grp, int wave, int lane) {
    const bf16_t* IQ = (const bf16_t*)(ws + WS_IQ); const bf16_t* IK = (const bf16_t*)(ws + WS_IK); const float* IW = (const float*)(ws + WS_IW); unsigned* MASK = (unsigned*)(ws + WS_MASK);
    const int b = grp >> 7, T0 = (grp & 127) * 16, t0 = T0 + 2 * wave, hi = lane >> 5, l32 = lane & 31, tid = wave * 64 + lane;
    const size_t rowbase = (size_t)b * SEQ;
    const int atok = (l32 >> 2) & 1, ahead = 4 * (l32 >> 3) + (l32 & 3);
    const bf16_t* ap = IQ + (rowbase + t0 + atok) * 1024 + ahead * 64 + 8 * hi;
    bf16x8 af[4];
#pragma unroll
    for (int kk = 0; kk < 4; ++kk) af[kk] = *(const bf16x8*)(ap + 16 * kk);
    float w[16];
#pragma unroll
    for (int i = 0; i < 4; ++i) { const f32x4 t = *(const f32x4*)(IW + (rowbase + t0 + hi) * 16 + 4 * i); w[4 * i] = t[0]; w[4 * i + 1] = t[1]; w[4 * i + 2] = t[2]; w[4 * i + 3] = t[3]; }
    const int tq = t0 + hi, nj = (t0 + 1) / 32 + 1, nchunk = ((T0 + 15) / 32 + 1 + 7) / 8;
    u32x4 stg[4];
#define IDX_LOAD(c) do { _Pragma("unroll") for (int i = 0; i < 4; ++i) { const int p = tid + 512 * i; stg[i] = *(const u32x4*)(IK + (rowbase + 256 * (c) + (p >> 3)) * 64 + 8 * (p & 7)); } } while (0)
    IDX_LOAD(0);
    unsigned uk[64];
#pragma unroll
    for (int c = 0; c < 8; ++c) {
        if (c < nchunk) {
            __syncthreads();
#pragma unroll
            for (int i = 0; i < 4; ++i) { const int p = tid + 512 * i; *(LAS u32x4*)(lds + (p >> 3) * 144 + (p & 7) * 16) = stg[i]; }
            __syncthreads();
            if (c + 1 < nchunk) IDX_LOAD(c + 1);
#pragma unroll
            for (int jj = 0; jj < 8; ++jj) { const int j = 8 * c + jj;
                if (j < nj) {
                    const LAS unsigned char* bp = lds + (32 * jj + l32) * 144 + 16 * hi;
                    f32x16 cc = {0.f, 0.f, 0.f, 0.f, 0.f, 0.f, 0.f, 0.f, 0.f, 0.f, 0.f, 0.f, 0.f, 0.f, 0.f, 0.f};
#pragma unroll
                    for (int kk = 0; kk < 4; ++kk) cc = MFMA32(af[kk], *(const LAS bf16x8*)(bp + 32 * kk), cc);
                    float sc = 0.f;
#pragma unroll
                    for (int r = 0; r < 16; ++r) sc += w[r] * fmaxf(cc[r], 0.f);
                    const unsigned bits = __float_as_uint(sc); const unsigned ku = bits ^ ((bits >> 31) ? 0xffffffffu : 0x80000000u);
                    uk[j] = (32 * j + l32 <= tq) ? ku : 0u;
                } else uk[j] = 0u; }
        } else {
#pragma unroll
            for (int jj = 0; jj < 8; ++jj) uk[8 * c + jj] = 0u; }
    }
#undef IDX_LOAD
    unsigned p = 0u; bool done = (tq + 1 <= 256);
    for (int bit = 31; bit >= 0; --bit) {
        if (__all(done)) break;
        const unsigned cand = p | (1u << bit);
        int cnt = 0;
#pragma unroll
        for (int g = 0; g < 8; ++g) if (8 * g < nj) {
#pragma unroll
            for (int jj = 0; jj < 8; ++jj) cnt += (uk[8 * g + jj] >= cand) ? 1 : 0; }
        cnt += __builtin_amdgcn_update_dpp(0, cnt, 0xB1, 0xF, 0xF, true); cnt += __builtin_amdgcn_update_dpp(0, cnt, 0x4E, 0xF, 0xF, true);
        cnt += __builtin_amdgcn_update_dpp(0, cnt, 0x141, 0xF, 0xF, true); cnt += __builtin_amdgcn_update_dpp(0, cnt, 0x140, 0xF, 0xF, true);
        { auto rr = __builtin_amdgcn_permlane16_swap((unsigned)cnt, (unsigned)cnt, false, false); cnt = (int)(rr[0] + rr[1]); }
        if (!done && cnt >= 256) { p = cand; if (cnt == 256) done = true; }
    }
    const unsigned thr = (tq + 1 <= 256) ? 1u : (p > 1u ? p : 1u);
    unsigned alo = 0u, ahi = 0u;
#pragma unroll
    for (int j = 0; j < 64; ++j) { const unsigned long long bal = __ballot(uk[j] >= thr); if (lane == j) { alo = (unsigned)bal; ahi = (unsigned)(bal >> 32); } }
    MASK[(rowbase + t0) * 64 + lane] = alo; MASK[(rowbase + t0 + 1) * 64 + lane] = ahi;
}

__device__ __forceinline__ void ra_unit(unsigned char* ws, int unit, int wave, int lane) {
    const bf16_t* RVT = (const bf16_t*)(ws + WS_RVT); const bf16_t* RKT = (const bf16_t*)(ws + WS_RKT); float* U = (float*)(ws + WS_U);
    const int b = unit >> 7, h = (unit >> 4) & 7, n = unit & 15, s0 = n * 128, eb = wave, hi = lane >> 5, l32 = lane & 31;
    const float lg2 = __log2f(1.0f - exp2f(-5.0f - (float)h));
    const bf16_t* vp = RVT + ((size_t)(b * 2048 + h * 256 + 32 * eb + l32)) * 2048 + s0 + 8 * hi;
    bf16x8 af[8];
#pragma unroll
    for (int kk = 0; kk < 8; ++kk) { const bf16x8 raw = *(const bf16x8*)(vp + 16 * kk); float f[8];
#pragma unroll
        for (int i = 0; i < 8; ++i) f[i] = bf2f((unsigned)(unsigned short)raw[i]) * exp2f(lg2 * (float)(127 - (16 * kk + 8 * hi + i)));
        af[kk] = pack8(f); }
    __builtin_amdgcn_sched_barrier(0);
#pragma unroll
    for (int db = 0; db < 4; ++db) {
        bf16x8 bfr[8];
        const bf16_t* kp = RKT + ((size_t)(b * 1024 + h * 128 + 32 * db + l32)) * 2048 + s0 + 8 * hi;
#pragma unroll
        for (int kk = 0; kk < 8; ++kk) bfr[kk] = *(const bf16x8*)(kp + 16 * kk);
        __builtin_amdgcn_sched_barrier(0);
        f32x16 c = {0.f, 0.f, 0.f, 0.f, 0.f, 0.f, 0.f, 0.f, 0.f, 0.f, 0.f, 0.f, 0.f, 0.f, 0.f, 0.f};
#pragma unroll
        for (int kk = 0; kk < 8; ++kk) c = MFMA32(af[kk], bfr[kk], c);
#pragma unroll
        for (int r = 0; r < 16; ++r) U[(size_t)unit * 32768 + (32 * eb + crow(r, hi)) * 128 + 32 * db + l32] = c[r];
        __builtin_amdgcn_sched_barrier(0);
    }
}
__device__ __forceinline__ void rb_scan(unsigned char* ws, int gtid, int nthr) {
    const float* U = (const float*)(ws + WS_U); bf16_t* RP = (bf16_t*)(ws + WS_RP);
    for (int it = gtid; it < 32 * 8192; it += nthr) {
        const int bh = it >> 13, e4 = (it & 8191) * 4, h = bh & 7;
        const float lg2 = __log2f(1.0f - exp2f(-5.0f - (float)h)); const float cd = exp2f(lg2 * 128.0f);
        f32x4 R = {0.f, 0.f, 0.f, 0.f};
#pragma unroll 4
        for (int n = 0; n < 16; ++n) { const size_t off = ((size_t)(bh * 16 + n)) * 32768 + e4; st4bf(RP + off, R); R = *(const f32x4*)(U + off) + R * cd; }
    }
}
__device__ __forceinline__ void stage_put(LAS unsigned char* stg, int lane, int colgrp4  , f32x4 v) {
    *(LAS u32x2*)(stg + (lane & 31) * 272 + colgrp4 * 2) = (u32x2){pk2(v[0], v[1]), pk2(v[2], v[3])};
}
__device__ __forceinline__ void stage_flush(const LAS unsigned char* stg, int lane, bf16_t* out  , size_t row_stride) {
    asm volatile("s_waitcnt lgkmcnt(0)" ::: "memory");
#pragma unroll
    for (int it = 0; it < 8; ++it) { const int row = it * 4 + (lane >> 4), ch = lane & 15; *(u32x4*)(out + (size_t)row * row_stride + ch * 8) = *(const LAS u32x4*)(stg + row * 272 + ch * 16); }
    asm volatile("s_waitcnt lgkmcnt(0)" ::: "memory");
}
__device__ __forceinline__ void rascan_unit(unsigned char* ws, int unit, int wave, int lane) {
    const bf16_t* RVT = (const bf16_t*)(ws + WS_RVT); const bf16_t* RKT = (const bf16_t*)(ws + WS_RKT); bf16_t* RP = (bf16_t*)(ws + WS_RP);
    const int b = unit >> 5, h = (unit >> 2) & 7, dblk = unit & 3, eb = wave, hi = lane >> 5, l32 = lane & 31;
    const float lg2 = __log2f(1.0f - exp2f(-5.0f - (float)h)); const float cd = exp2f(lg2 * 128.0f);
    float zi[8], zk[8];
#pragma unroll
    for (int i = 0; i < 8; ++i) { zi[i] = exp2f(lg2 * (float)(127 - 8 * hi - i)); zk[i] = exp2f(lg2 * (float)(-16 * i)); }
    const bf16_t* vrow = RVT + ((size_t)(b * 8 + h) * 16) * 32768 + eb * 4096 + lane * 8;
    const bf16_t* krow = RKT + ((size_t)(b * 8 + h) * 16) * 16384 + dblk * 4096 + lane * 8;
    const int dq = 32 * dblk + l32; bf16_t* rpo = RP + ((size_t)(b * 8 + h) * 16) * 32768 + eb * 4096 + (((dq >> 4) * 2 + ((dq >> 3) & 1)) * 32 + 4 * hi) * 8 + (dq & 7);
    f32x16 R = {0.f, 0.f, 0.f, 0.f, 0.f, 0.f, 0.f, 0.f, 0.f, 0.f, 0.f, 0.f, 0.f, 0.f, 0.f, 0.f};
    bf16x8 va[8], ka[8];
#define RS_LOAD(n, V, K) do { _Pragma("unroll") for (int kk = 0; kk < 8; ++kk) { V[kk] = *(const bf16x8*)(vrow + (size_t)(n) * 32768 + 512 * kk); K[kk] = *(const bf16x8*)(krow + (size_t)(n) * 16384 + 512 * kk); } } while (0)
#pragma unroll 1
    for (int n = 0; n < 16; ++n) {
        if (n == 0) RS_LOAD(0, va, ka);
        __builtin_amdgcn_sched_barrier(0);
        f32x16 u_ = {0.f, 0.f, 0.f, 0.f, 0.f, 0.f, 0.f, 0.f, 0.f, 0.f, 0.f, 0.f, 0.f, 0.f, 0.f, 0.f};
#pragma unroll
        for (int kk = 0; kk < 8; ++kk) { float f_[8];
#pragma unroll
            for (int i = 0; i < 8; ++i) f_[i] = bf2f((unsigned)(unsigned short)va[kk][i]) * (zk[kk] * zi[i]);
            u_ = MFMA32(pack8(f_), ka[kk], u_); }
        __builtin_amdgcn_sched_barrier(0);
        if (n + 1 < 16) RS_LOAD(n + 1, va, ka);
        __builtin_amdgcn_sched_barrier(0);
        bf16_t* rp_ = rpo + (size_t)n * 32768;
#pragma unroll
        for (int r = 0; r < 16; ++r) rp_[((r & 3) + 8 * (r >> 2)) * 8] = (bf16_t)pk2(R[r], 0.f);
        R = u_ + R * cd;
        __builtin_amdgcn_sched_barrier(0);
    }
#undef RS_LOAD
#undef RS_STEP
}
__device__ __forceinline__ void rc_unit(unsigned char* ws, const float* gn_g, const float* gn_b, LAS unsigned char* lds, int unit, int layer, int wave, int lane) {
    const bf16_t* RQ = (const bf16_t*)(ws + WS_RQ); const bf16_t* RK = (const bf16_t*)(ws + WS_RK); const bf16_t* RVT = (const bf16_t*)(ws + WS_RVT); const bf16_t* RP = (const bf16_t*)(ws + WS_RP);
    const bf16_t* SRG = (const bf16_t*)(ws + WS_SRG); bf16_t* ORET = (bf16_t*)(ws + WS_OATT) + 2048;
    const int b = unit >> 7, h = (unit >> 4) & 7, n = unit & 15, s0 = n * 128, ib = wave >> 1, eh = wave & 1, hi = lane >> 5, l32 = lane & 31;
    const float lg2 = __log2f(1.0f - exp2f(-5.0f - (float)h));
    const size_t tok = (size_t)b * SEQ + s0 + 32 * ib + l32;
    bf16x8 qf[8];
#pragma unroll
    for (int kk = 0; kk < 8; ++kk) qf[kk] = *(const bf16x8*)(RQ + (size_t)unit * 16384 + ib * 4096 + kk * 512 + lane * 8);
    f32x16 acc[4];
    const int iq = 32 * ib + l32;
    bf16x8 pfr[4][2];
    {
        bf16x8 kf[32];
#pragma unroll
        for (int jb = 0; jb < 4; ++jb) { const bf16_t* kp = RK + (size_t)unit * 16384 + jb * 4096 + (hi * 32 + kperm(l32)) * 8;
#pragma unroll
            for (int kk = 0; kk < 8; ++kk) kf[8 * jb + kk] = *(const bf16x8*)(kp + 512 * kk); }
        __builtin_amdgcn_sched_barrier(0);
#pragma unroll
        for (int jb = 0; jb < 4; ++jb) { f32x16 st = {0.f, 0.f, 0.f, 0.f, 0.f, 0.f, 0.f, 0.f, 0.f, 0.f, 0.f, 0.f, 0.f, 0.f, 0.f, 0.f};
#pragma unroll
            for (int kk = 0; kk < 8; ++kk) st = MFMA32(kf[8 * jb + kk], qf[kk], st);
            float f[16];
#pragma unroll
            for (int r = 0; r < 16; ++r) { const int j = 32 * jb + 16 * (r >> 3) + 8 * hi + (r & 7); const int df = iq - j; f[r] = (df >= 0) ? st[r] * exp2f(lg2 * (float)df) : 0.f; }
            pfr[jb][0] = pack8(f); pfr[jb][1] = pack8(f + 8); }
        __builtin_amdgcn_sched_barrier(0);
    }
    int lnc = lane; asm volatile("" : "+v"(lnc)); const int l32c = lnc & 31;
#pragma unroll
    for (int ep = 0; ep < 2; ++ep) {
        bf16x8 rf[16];
#pragma unroll
        for (int e2 = 0; e2 < 2; ++e2) { const int eb = 4 * eh + 2 * ep + e2; const bf16_t* rp = RP + (size_t)unit * 32768 + eb * 4096 + lnc * 8;
#pragma unroll
            for (int kk = 0; kk < 8; ++kk) rf[8 * e2 + kk] = *(const bf16x8*)(rp + 512 * kk); }
        __builtin_amdgcn_sched_barrier(0);
#pragma unroll
        for (int e2 = 0; e2 < 2; ++e2) { f32x16 c = {0.f, 0.f, 0.f, 0.f, 0.f, 0.f, 0.f, 0.f, 0.f, 0.f, 0.f, 0.f, 0.f, 0.f, 0.f, 0.f};
#pragma unroll
            for (int kk = 0; kk < 8; ++kk) c = MFMA32(rf[8 * e2 + kk], qf[kk], c);
            acc[2 * ep + e2] = c * exp2f(lg2 * (float)(32 * ib + l32c + 1)); }
        __builtin_amdgcn_sched_barrier(0);
    }
    int lnv = lane; asm volatile("" : "+v"(lnv)); const int l32v = lnv & 31, hiv = lnv >> 5;
#pragma unroll
    for (int ep = 0; ep < 2; ++ep) {
        bf16x8 vf[16];
#pragma unroll
        for (int e2 = 0; e2 < 2; ++e2) { const int eb = 4 * eh + 2 * ep + e2; const bf16_t* vp = RVT + (size_t)unit * 32768 + eb * 4096 + lnv * 8;
#pragma unroll
            for (int q = 0; q < 8; ++q) vf[8 * e2 + q] = *(const bf16x8*)(vp + 512 * q); }
        __builtin_amdgcn_sched_barrier(0);
#pragma unroll
        for (int e2 = 0; e2 < 2; ++e2)
#pragma unroll
            for (int q = 0; q < 8; ++q) acc[2 * ep + e2] = MFMA32(vf[8 * e2 + q], pfr[q >> 1][q & 1], acc[2 * ep + e2]);
        __builtin_amdgcn_sched_barrier(0);
    }
    float s1 = 0.f, s2 = 0.f;
#pragma unroll
    for (int el = 0; el < 4; ++el)
#pragma unroll
        for (int r = 0; r < 16; ++r) { const float v = acc[el][r]; s1 += v; s2 += v * v; }
    s1 = x32sum(s1); s2 = x32sum(s2);
    LAS float* xs = (LAS float*)lds;
    __syncthreads();
    if (hi == 0) { xs[(wave * 32 + l32) * 2] = s1; xs[(wave * 32 + l32) * 2 + 1] = s2; }
    __syncthreads();
    s1 += xs[((wave ^ 1) * 32 + l32) * 2]; s2 += xs[((wave ^ 1) * 32 + l32) * 2 + 1];
    const float mu = s1 * (1.0f / 256.0f); const float var = fmaxf(s2 * (1.0f / 256.0f) - mu * mu, 0.f); const float rstd = rsqrtf(var + 1e-6f);
    const float* gg = gn_g + layer * 2048 + h * 256; const float* gb = gn_b + layer * 2048 + h * 256;
    int ln2 = lane; asm volatile("" : "+v"(ln2));
    const int hi2 = ln2 >> 5;
    const bf16_t* sgp = SRG + (size_t)unit * 32768 + ib * 8192 + eh * 4096 + ln2 * 4;
    LAS unsigned char* stg = lds + 4096 + wave * 8704;
#pragma unroll
    for (int el = 0; el < 4; ++el)
#pragma unroll
        for (int c4 = 0; c4 < 4; ++c4) {
            const int e0 = 32 * (4 * eh + el) + 8 * c4 + 4 * hi2;
            const f32x4 g4 = *(const f32x4*)(gg + e0), b4 = *(const f32x4*)(gb + e0); const u32x2 sg = *(const u32x2*)(sgp + (el * 4 + c4) * 256);
            f32x4 o;
            o[0] = ((acc[el][4 * c4 + 0] - mu) * rstd * g4[0] + b4[0]) * bf2f(sg.x & 0xffffu);
            o[1] = ((acc[el][4 * c4 + 1] - mu) * rstd * g4[1] + b4[1]) * bf2f(sg.x >> 16);
            o[2] = ((acc[el][4 * c4 + 2] - mu) * rstd * g4[2] + b4[2]) * bf2f(sg.y & 0xffffu);
            o[3] = ((acc[el][4 * c4 + 3] - mu) * rstd * g4[3] + b4[3]) * bf2f(sg.y >> 16);
            stage_put(stg, ln2, 32 * el + 8 * c4 + 4 * hi2, o);
        }
    stage_flush(stg, ln2, ORET + ((size_t)b * SEQ + s0 + 32 * ib) * 4096 + h * 256 + 128 * eh, 4096);
}

constexpr int KT_STRIDE = 136, VT_STRIDE = 72, ATT_K_OFF = 0, ATT_V_OFF = 64 * KT_STRIDE * 2, ATT_BUF = 64 * KT_STRIDE * 2 + 128 * VT_STRIDE * 2, ATT_Q_OFF = 2 * ATT_BUF;
__device__ __forceinline__ void attn_unit(unsigned char* ws, const float* qn_g, const float* kn_g, LAS unsigned char* lds, int unit, int layer, int wave, int lane) {
    const bf16_t* Q = (const bf16_t*)(ws + WS_Q); const bf16_t* KN = (const bf16_t*)(ws + WS_KN); const bf16_t* VT = (const bf16_t*)(ws + WS_VT); const unsigned* MASK = (const unsigned*)(ws + WS_MASK);
    bf16_t* OATT = (bf16_t*)(ws + WS_OATT);
    const int tid = wave * 64 + lane, hi = lane >> 5, l32 = lane & 31;
    int bg, qb; if (unit < 256) { bg = unit >> 4; qb = unit & 15; } else { bg = (unit - 256) >> 4; qb = 31 - ((unit - 256) & 15); }
    const int b = bg >> 2, g = bg & 3, hh = g * 4 + (wave >> 1), q0 = qb * 64, qs = q0 + 32 * (wave & 1);
    const size_t tok = (size_t)b * SEQ + qs + l32;
    bf16x8 qf[8]; float mfix;
    {
        float ss = 0.f;
        const bf16_t* qp = Q + tok * 2048 + hh * 128 + 8 * hi;
#pragma unroll
        for (int kk = 0; kk < 8; ++kk) { qf[kk] = *(const bf16x8*)(qp + 16 * kk);
#pragma unroll
            for (int i = 0; i < 8; ++i) { const float v = bf2f((unsigned)(unsigned short)qf[kk][i]); ss += v * v; } }
        ss = x32sum(ss);
        const float rs = rsqrtf(ss * (1.0f / 128.0f) + 1e-6f) * (0.08838834764831845f * 1.4426950408889634f);
        const float* qg = qn_g + layer * 128 + 8 * hi; float s2 = 0.f;
#pragma unroll
        for (int kk = 0; kk < 8; ++kk) { float f[8];
#pragma unroll
            for (int i = 0; i < 8; ++i) { f[i] = bf2f((unsigned)(unsigned short)qf[kk][i]) * rs * qg[16 * kk + i]; s2 += f[i] * f[i]; }
            *(LAS bf16x8*)(lds + ATT_Q_OFF + wave * 8192 + kk * 1024 + lane * 16) = pack8(f); }
        s2 = x32sum(s2);
        float gm = fmaxf(fabsf(kn_g[layer * 128 + 2 * lane]), fabsf(kn_g[layer * 128 + 2 * lane + 1]));
#pragma unroll
        for (int o = 1; o < 64; o <<= 1) gm = fmaxf(gm, shx(gm, o, lane));
        mfix = sqrtf(s2) * 11.313708498984761f * gm * 1.01f + 0.01f;
    }
    f32x16 o[4];
#pragma unroll
    for (int d = 0; d < 4; ++d) o[d] = (f32x16){0.f, 0.f, 0.f, 0.f, 0.f, 0.f, 0.f, 0.f, 0.f, 0.f, 0.f, 0.f, 0.f, 0.f, 0.f, 0.f};
    float lrun = 0.f;
    const int nt = qb + 1;
    const bf16_t* kbase = KN + ((size_t)(b * 4 + g) * SEQ) * 128; const bf16_t* vbase = VT + ((size_t)(b * 4 + g) * 32) * 8192;
    u32x4 kst[2], vst[2];
    unsigned koff[2], voff[2];
#pragma unroll
    for (int i = 0; i < 2; ++i) { const int p = tid + 512 * i; koff[i] = (unsigned)(p * 16); voff[i] = (unsigned)(p * 16); }
#define ATT_LOAD(t) do { const char* kb_ = (const char*)(kbase + (size_t)(t) * 8192); const char* vb_ = (const char*)(vbase + (size_t)(t) * 8192); \
        _Pragma("unroll") for (int i = 0; i < 2; ++i) { kst[i] = *(const u32x4*)(kb_ + koff[i]); vst[i] = *(const u32x4*)(vb_ + voff[i]); } } while (0)
#define ATT_STORE(buf) do { _Pragma("unroll") for (int i = 0; i < 2; ++i) { const int p = tid + 512 * i; *(LAS u32x4*)(lds + (buf) * ATT_BUF + ATT_K_OFF + ((p >> 4) * KT_STRIDE + 8 * (p & 15)) * 2) = kst[i]; \
        *(LAS u32x4*)(lds + (buf) * ATT_BUF + ATT_V_OFF + ((p >> 3) * VT_STRIDE + 8 * (p & 7)) * 2) = vst[i]; } } while (0)
    __builtin_amdgcn_sched_barrier(0);
    const char* mbase = (const char*)(MASK + ((size_t)b * SEQ + qs) * 64); const unsigned moff = (unsigned)l32 * 256u;
    u32x2 mwn = *(const u32x2*)(mbase + moff);
    ATT_LOAD(0);
    __syncthreads();
    ATT_STORE(0);
    __syncthreads();
    for (int t = 0; t < nt; ++t) {
        const int cur = t & 1;
        const u32x2 mw = mwn;
        if (t + 1 < nt) { mwn = *(const u32x2*)(mbase + (moff + 8u * (unsigned)(t + 1))); ATT_LOAD(t + 1); }
        float psum = 0.f; bf16x8 pf[2][2];
        const LAS unsigned char* kp = lds + cur * ATT_BUF + ATT_K_OFF + (kperm(l32) * KT_STRIDE + 8 * hi) * 2;
        const LAS unsigned char* vp = lds + cur * ATT_BUF + ATT_V_OFF + (l32 * VT_STRIDE + 8 * hi) * 2;
#define KFR(p, kk) (*(const LAS bf16x8*)(kp + (p) * (32 * KT_STRIDE * 2) + 32 * (kk)))
#define VFR(d, q) (*(const LAS bf16x8*)(vp + (d) * (32 * VT_STRIDE * 2) + 32 * (q)))
        f32x16 c0, c1;
#pragma unroll
        for (int r = 0; r < 16; ++r) { c0[r] = -mfix; c1[r] = -mfix; }
        const LAS unsigned char* qpk = lds + ATT_Q_OFF + wave * 8192 + lane * 16;
#define QFR(kk) (*(const LAS bf16x8*)(qpk + (kk) * 1024))
        bf16x8 fA[4], fB[4], qA[2], qB[2];
#define LDK(F, Qv, i) do { F[0] = KFR(0, 2 * (i)); F[1] = KFR(1, 2 * (i)); F[2] = KFR(0, 2 * (i) + 1); F[3] = KFR(1, 2 * (i) + 1); Qv[0] = QFR(2 * (i)); Qv[1] = QFR(2 * (i) + 1); } while (0)
#define LDV(F, d) do { F[0] = VFR(d, 0); F[1] = VFR(d, 1); F[2] = VFR(d, 2); F[3] = VFR(d, 3); } while (0)
#define MMK(F, Qv) do { c0 = MFMA32(F[0], Qv[0], c0); c1 = MFMA32(F[1], Qv[0], c1); c0 = MFMA32(F[2], Qv[1], c0); c1 = MFMA32(F[3], Qv[1], c1); } while (0)
#define MMV(F, d) do { o[d] = MFMA32(F[0], pf[0][0], o[d]); o[d] = MFMA32(F[1], pf[0][1], o[d]); o[d] = MFMA32(F[2], pf[1][0], o[d]); o[d] = MFMA32(F[3], pf[1][1], o[d]); } while (0)
#define SB() __builtin_amdgcn_sched_barrier(0)
        LDK(fA, qA, 0); SB();
        LDK(fB, qB, 1); SB(); MMK(fA, qA); SB();
        LDK(fA, qA, 2); SB(); MMK(fB, qB); SB();
        LDK(fB, qB, 3); SB(); MMK(fA, qA); SB();
        LDV(fA, 0);     SB(); MMK(fB, qB); SB();
#undef QFR
#pragma unroll
        for (int p = 0; p < 2; ++p) {
            const int wbits = (int)((p ? mw.y : mw.x) >> (8 * hi));
            float f[16];
#pragma unroll
            for (int r = 0; r < 16; ++r) { const float e = __builtin_amdgcn_exp2f(p ? c1[r] : c0[r]); int mb;
                asm("v_bfe_i32 %0, %1, %2, 1" : "=v"(mb) : "v"(wbits), "n"(16 * (r >> 3) + (r & 7)));
                f[r] = __uint_as_float(__float_as_uint(e) & (unsigned)mb); psum += f[r]; }
            pf[p][0] = pack8(f); pf[p][1] = pack8(f + 8);
        }
        lrun += psum;
        SB();
        LDV(fB, 1); SB(); MMV(fA, 0); SB();
        LDV(fA, 2); SB(); MMV(fB, 1); SB();
        LDV(fB, 3); SB(); MMV(fA, 2); SB();
        MMV(fB, 3); SB();
#undef LDK
#undef LDV
#undef MMK
#undef MMV
#undef SB
#undef KFR
#undef VFR
        if (t + 1 < nt) ATT_STORE(cur ^ 1);
        __syncthreads();
    }
#undef ATT_LOAD
#undef ATT_STORE
    lrun = x32sum(lrun);
    const float inv = 1.0f / lrun;
    int ln2 = lane; asm volatile("" : "+v"(ln2));
    LAS unsigned char* stg = lds + wave * 8704;
#pragma unroll
    for (int d = 0; d < 4; ++d)
#pragma unroll
        for (int c4 = 0; c4 < 4; ++c4) {
            f32x4 v; v[0] = o[d][4 * c4] * inv; v[1] = o[d][4 * c4 + 1] * inv; v[2] = o[d][4 * c4 + 2] * inv; v[3] = o[d][4 * c4 + 3] * inv;
            stage_put(stg, ln2, 32 * d + 8 * c4 + 4 * (ln2 >> 5), v);
        }
    stage_flush(stg, ln2, OATT + ((size_t)b * SEQ + qs) * 4096 + hh * 128, 4096);
}

#define XB_TMO      128
#define XB_XCNT(j)  (256  + 64 * (j))
#define XB_XSUB(j)  (1280 + 64 * (j))
#define XB_XGEN(j)  (2304 + 64 * (j))
#define XB_TOP      3328
#define XB_TOPGEN   3392
#define XCD_BAR_WORDS 3456
#define XB_SPIN_CAP (1u << 18)

__device__ __forceinline__ unsigned xb_ld(unsigned* p)              { return __hip_atomic_load(p, __ATOMIC_RELAXED, __HIP_MEMORY_SCOPE_AGENT); }
__device__ __forceinline__ unsigned xb_add(unsigned* p, unsigned v) { return __hip_atomic_fetch_add(p, v, __ATOMIC_RELAXED, __HIP_MEMORY_SCOPE_AGENT); }
__device__ __forceinline__ unsigned xb_xcc_id() { return (unsigned)__builtin_amdgcn_s_getreg((3 << 11) | 20) & 0xFu; }
#define XB_SPIN(cond, bar) do { unsigned _sp = 0; while (cond) { __builtin_amdgcn_s_sleep(1); \
    if ((++_sp & 255u) == 0u) { if (xb_ld(&(bar)[XB_TMO])) break; if (_sp > XB_SPIN_CAP) { atomicAdd(&(bar)[XB_TMO], 1u); break; } } } } while (0)

struct XcdBarrier {
    unsigned* bar; unsigned x;
    volatile LAS unsigned* st;
};

__device__ __forceinline__ XcdBarrier xcd_barrier_post(unsigned* bar, volatile LAS unsigned* st) {
    XcdBarrier b; b.bar = bar; b.x = xb_xcc_id(); b.st = st;
    if (threadIdx.x == 0) (void)xb_add(&bar[XB_XCNT(b.x)], 1u);
    return b;
}
__device__ __forceinline__ void xcd_barrier_complete(unsigned* bar, unsigned x, unsigned& nloc, unsigned& nx) {
    const unsigned G = gridDim.x * gridDim.y * gridDim.z;
    unsigned sum, cnt, mine, sp = 0u;
    for (;;) {
        sum = 0u; cnt = 0u; mine = 0u;
#pragma unroll
        for (unsigned j = 0; j < 16; ++j) { const unsigned c = xb_ld(&bar[XB_XCNT(j)]); sum += c; cnt += (c > 0u) ? 1u : 0u; mine = (j == x) ? c : mine; }
        if (sum == G) break;
        __builtin_amdgcn_s_sleep(1);
        if ((++sp & 255u) == 0u) { if (xb_ld(&bar[XB_TMO])) break; if (sp > XB_SPIN_CAP) { atomicAdd(&bar[XB_TMO], 1u); break; } }
    }
    nloc = mine > 0u ? mine : 1u; nx = cnt > 0u ? cnt : 1u;
}

__device__ __forceinline__ void xcd_barrier(const XcdBarrier& b) {
    asm volatile("s_waitcnt vmcnt(0)" ::: "memory");
    __syncthreads();
    if (threadIdx.x == 0) {
        unsigned* bar = b.bar;
        __builtin_amdgcn_s_waitcnt(0);
        unsigned nloc = b.st[0], nx = b.st[1];
        if (nloc == 0u) { xcd_barrier_complete(bar, b.x, nloc, nx); b.st[0] = nloc; b.st[1] = nx; }
        const unsigned old = xb_add(&bar[XB_XSUB(b.x)], 1u);
        const unsigned gen = old / nloc;
        if (old + 1u == (gen + 1u) * nloc) {
            __builtin_amdgcn_fence(__ATOMIC_RELEASE, "agent");
            asm volatile("s_waitcnt vmcnt(0)" ::: "memory");
            const unsigned og = xb_add(&bar[XB_TOP], 1u);
            const unsigned tg = og / nx;
            if (og + 1u == (tg + 1u) * nx) xb_add(&bar[XB_TOPGEN], 1u);
            else XB_SPIN(xb_ld(&bar[XB_TOPGEN]) == tg, bar);
            __builtin_amdgcn_fence(__ATOMIC_ACQUIRE, "agent");
            xb_add(&bar[XB_XGEN(b.x)], 1u);
            asm volatile("s_waitcnt vmcnt(0)" ::: "memory");
        } else {
            XB_SPIN(xb_ld(&bar[XB_XGEN(b.x)]) == gen, bar);
            __builtin_amdgcn_fence(__ATOMIC_ACQUIRE, "agent");
            asm volatile("s_waitcnt vmcnt(0)" ::: "memory");
        }
    }
    __syncthreads();
}

constexpr int LDS_BYTES = 139264;
__global__ void __launch_bounds__(NTHR, 2) hybrid_fwd(Params P_unused) {
    extern __shared__ __attribute__((aligned(16))) unsigned char lds_raw[];
    cg::grid_group grid = cg::this_grid();
#define FRESH() LAS unsigned char* lds = (LAS unsigned char*)lds_raw; int tid = threadIdx.x; asm volatile("" : "+v"(tid)); const int lane = tid & 63, wave = __builtin_amdgcn_readfirstlane(tid >> 6); \
    int G = gridDim.x, bx = blockIdx.x; asm volatile("" : "+s"(G), "+s"(bx)); const int gw = bx * NWAVE + wave, NGW = G * NWAVE; CP pp = getP(); unsigned char* ws = pp->ws; \
    float* RSS = (float*)(ws + WS_RSS); bf16_t* XB = (bf16_t*)(ws + WS_XB); (void)lane; (void)gw; (void)NGW; (void)RSS; (void)XB; (void)lds;
    {
        FRESH();
        if (tid < 4) ((LAS unsigned*)(lds + LDS_BYTES - 16))[tid] = 0u;
        __syncthreads();
        (void)xcd_barrier_post((unsigned*)(ws + WS_BAR), (volatile LAS unsigned*)(lds + LDS_BYTES - 16));
#ifndef NO_PRO
        for (int rep = 0; rep < REP_PRO; ++rep) prologue(pp, lds, gw, NGW, wave, lane);
#endif
    }
    if (P_unused.out == nullptr) grid.sync();
#define GSYNC() do { LAS unsigned char* lds_ = (LAS unsigned char*)lds_raw; XcdBarrier xb_; xb_.bar = (unsigned*)(getP()->ws + WS_BAR); xb_.x = xb_xcc_id(); xb_.st = (volatile LAS unsigned*)(lds_ + LDS_BYTES - 16); xcd_barrier(xb_); } while (0)
    GSYNC();
#pragma unroll 1
    for (int l = 0; l < NL; ++l) {
        {
            FRESH();
            pg8::Gemm g{XB, (const bf16_t*)(ws + WS_WIN + l * 57 * MiB), NTOK, NMAIN, DM}; pg8::StaticOrder S; S.init(NTOK, NMAIN, G, bx);
            EpiIn E{RSS + (2 * l) * NTOK, ws};
#ifndef NO_G1
            pg8::gemm_phase<EpiIn, pg8::StaticOrder, GA_, GS_>(lds, g, S, E);
#endif
            for (int rb = bx; rb < NTOK / 32; rb += G) tail_block(ws, (const bf16_t*)(ws + WS_WIN + l * 57 * MiB) + (size_t)NMAIN * DM, RSS + (2 * l) * NTOK, lds, rb, wave, lane);
        }
        GSYNC();
        {
            FRESH();
            const bf16_t* KR = (const bf16_t*)(ws + WS_KRAW); bf16_t* KN = (bf16_t*)(ws + WS_KN); const float* kg = pp->kn_g + l * 128;
            for (int rep = 0; rep < REP_P2; ++rep) {
            {
                const int q16 = lane >> 4, c16 = lane & 15;
                const f32x4 kg0 = *(const f32x4*)(kg + 8 * c16), kg1 = *(const f32x4*)(kg + 8 * c16 + 4);
                for (int base = gw; base < NTOK; base += 4 * NGW) {
                    u32x4 kv[4];
#pragma unroll
                    for (int j = 0; j < 4; ++j) { const int st = base + j * NGW; const int pair = st * 4 + q16;
                        kv[j] = (st < NTOK) ? *(const u32x4*)(KR + (size_t)(pair >> 2) * 512 + (pair & 3) * 128 + 8 * c16) : (u32x4){0u, 0u, 0u, 0u}; }
                    __builtin_amdgcn_sched_barrier(0);
#pragma unroll
                    for (int j = 0; j < 4; ++j) { const int st = base + j * NGW; const int pair = st * 4 + q16, row = pair >> 2, g4 = pair & 3;
                        const f32x4 lo = bflo4(kv[j]), hi4 = bfhi4(kv[j]);
                        float ss = ((lo[0] * lo[0] + lo[1] * lo[1]) + (lo[2] * lo[2] + lo[3] * lo[3])) + ((hi4[0] * hi4[0] + hi4[1] * hi4[1]) + (hi4[2] * hi4[2] + hi4[3] * hi4[3]));
                        ss += __int_as_float(__builtin_amdgcn_update_dpp(0, __float_as_int(ss), 0xB1, 0xF, 0xF, true)); ss += __int_as_float(__builtin_amdgcn_update_dpp(0, __float_as_int(ss), 0x4E, 0xF, 0xF, true));
                        ss += __int_as_float(__builtin_amdgcn_update_dpp(0, __float_as_int(ss), 0x141, 0xF, 0xF, true)); ss += __int_as_float(__builtin_amdgcn_update_dpp(0, __float_as_int(ss), 0x140, 0xF, 0xF, true));
                        const float rs = rsqrtf(ss * (1.0f / 128.0f) + 1e-6f);
                        if (st < NTOK) st8bf(KN + ((size_t)((row >> 11) * 4 + g4) * SEQ + (row & 2047)) * 128 + 8 * c16, lo * rs * kg0, hi4 * rs * kg1); }
                }
            }
            {
                const bool bal = (G == 256); const int i = bx & 127, q = i & 63, hb = i >> 6;
                if (bal) { if (bx < 128) rascan_unit(ws, bx, wave, lane); }
                else { for (int u = bx; u < 128; u += G) rascan_unit(ws, u, wave, lane); }
                const int ng = bal ? (bx < 128 ? 1 : 3) : 2 * ((255 - bx) / G + 1);
#pragma unroll 1
                for (int k = 0; k < ng; ++k) {
                    int gid;
                    if (bal) gid = (bx < 128) ? hb * 128 + 127 - q : (k == 0 ? (2 * hb) * 128 + q : (k == 1 ? (2 * hb + 1) * 128 + 63 - q : (2 + hb) * 128 + 64 + q));
                    else { const int kk2 = bx + (k >> 1) * G; gid = (k & 1) ? 511 - kk2 : kk2; }
                    indexer_group(ws, lds, gid, wave, lane);
                }
            }
            }
        }
        GSYNC();
        {
            FRESH();
            for (int rep = 0; rep < REP_P3; ++rep) {
#ifndef NO_ATT
            { const int vb = (G % 8 == 0) ? (bx % 8) * (G / 8) + bx / 8 : bx;
              for (int unit = vb; unit < 512; unit += G) attn_unit(ws, pp->qn_g, pp->kn_g, lds, unit, l, wave, lane); }
#endif
            { const float* gn_g = pp->gn_g; const float* gn_b = pp->gn_b;
              for (int unit = bx; unit < 512; unit += G) rc_unit(ws, gn_g, gn_b, lds, unit, l, wave, lane); }
            }
        }
        GSYNC();
        {
            FRESH();
            pg8::Gemm g{(const bf16_t*)(ws + WS_OATT), (const bf16_t*)(ws + WS_WUPA + l * 16 * MiB), NTOK, DM, 2 * DM}; pg8::StaticOrder S; S.init(NTOK, DM, G, bx);
            EpiGate E{(const bf16_t*)(ws + WS_SGA), (const bf16_t*)(ws + WS_SGB), (bf16_t*)(ws + WS_MERGED)};
#if !defined(NO_GO) && !defined(NO_GA)
            pg8::gemm_phase<EpiGate, pg8::StaticOrder, GA_, GS_>(lds, g, S, E);
#endif
        }
        GSYNC();
        {
            FRESH();
            pg8::Gemm g{(const bf16_t*)(ws + WS_MERGED), (const bf16_t*)(ws + WS_WOUT + l * 8 * MiB), NTOK, DM, DM}; pg8::StaticOrder S; S.init(NTOK, DM, G, bx);
            EpiRes E{l == 0 ? pp->x : (const float*)pp->out, pp->out, XB, RSS + (2 * l + 1) * NTOK};
#if !defined(NO_GO) && !defined(NO_GR)
            pg8::gemm_phase<EpiRes, pg8::StaticOrder, GA_, GS_>(lds, g, S, E);
#endif
        }
        GSYNC();
        {
            FRESH();
            pg8::Gemm g{XB, (const bf16_t*)(ws + WS_WFF1 + l * 32 * MiB), NTOK, DFF, DM}; pg8::StaticOrder S; S.init(NTOK, DFF, G, bx);
            EpiFF1 E{RSS + (2 * l + 1) * NTOK, (bf16_t*)(ws + WS_HFF)};
#if !defined(NO_GO) && !defined(NO_F1)
            pg8::gemm_phase<EpiFF1, pg8::StaticOrder, GA_, GS_>(lds, g, S, E);
#endif
        }
        GSYNC();
        {
            FRESH();
            pg8::Gemm g{(const bf16_t*)(ws + WS_HFF), (const bf16_t*)(ws + WS_WFF2 + l * 32 * MiB), NTOK, DM, DFF}; pg8::StaticOrder S; S.init(NTOK, DM, G, bx);
            EpiRes E{pp->out, pp->out, (l + 1 < NL) ? XB : nullptr, (l + 1 < NL) ? RSS + (2 * l + 2) * NTOK : nullptr};
#if !defined(NO_GO) && !defined(NO_GR)
            pg8::gemm_phase<EpiRes, pg8::StaticOrder, GA_, GS_>(lds, g, S, E);
#endif
        }
        if (l + 1 < NL) GSYNC();
    }
#undef FRESH
}
}

extern "C" void kernel_launch(void* const* d_in, const int* in_sizes, int n_in, void* d_out, int out_size, void* d_ws, size_t ws_size, hipStream_t stream) {
    static int grid = 0;
    if (grid == 0) {
        if (n_in != 13 || out_size != mk::NTOK * mk::DM || ws_size < mk::WS_END) { fprintf(stderr, "kernel_launch: unexpected shapes (n_in %d out %d ws %zu)\n", n_in, out_size, ws_size); grid = -1; return; }
        int dev = 0, cus = 0, per_cu = 0;
        hipGetDevice(&dev); hipDeviceGetAttribute(&cus, hipDeviceAttributeMultiprocessorCount, dev);
        if (hipFuncSetAttribute((const void*)mk::hybrid_fwd, hipFuncAttributeMaxDynamicSharedMemorySize, mk::LDS_BYTES) != hipSuccess) { fprintf(stderr, "kernel_launch: hipFuncSetAttribute failed\n"); grid = -1; return; }
        if (hipOccupancyMaxActiveBlocksPerMultiprocessor(&per_cu, (const void*)mk::hybrid_fwd, mk::NTHR, mk::LDS_BYTES) != hipSuccess || per_cu < 1) { fprintf(stderr, "kernel_launch: occupancy query gave %d\n", per_cu); per_cu = 1; }
        (void)hipGetLastError();
        grid = cus * 1;
        if (grid <= 0) grid = 256;
    }
    if (grid < 0) return;
    mk::Params p{};
    p.x = (const float*)d_in[0]; p.ln1_g = (const float*)d_in[1]; p.w_in = (const float*)d_in[2]; p.qn_g = (const float*)d_in[3]; p.kn_g = (const float*)d_in[4];
    p.gn_g = (const float*)d_in[5]; p.gn_b = (const float*)d_in[6]; p.w_upa = (const float*)d_in[7]; p.w_upr = (const float*)d_in[8]; p.w_out = (const float*)d_in[9];
    p.ln2_g = (const float*)d_in[10]; p.w_ff1 = (const float*)d_in[11]; p.w_ff2 = (const float*)d_in[12];
    p.out = (float*)d_out; p.ws = (unsigned char*)d_ws;
    (void)hipMemsetAsync((unsigned char*)d_ws + mk::WS_BAR, 0, XCD_BAR_WORDS * sizeof(unsigned), stream);
    void* args[] = {&p};
    hipError_t e = hipLaunchCooperativeKernel((const void*)mk::hybrid_fwd, dim3(grid), dim3(mk::NTHR), args, mk::LDS_BYTES, stream);
    if (e != hipSuccess) fprintf(stderr, "kernel_launch: cooperative launch failed: %s (grid %d)\n", hipGetErrorString(e), grid);
}
```
